# Optimizing an MI355X kernel written in HIP

```python
import math
import jax
import jax.numpy as jnp
from jax import lax
import numpy as np

D_MODEL = 2048
BATCH = 2
SEQ = 4096
DEPTH = 4
DEC_BATCH = 8
DEC_SEQ = 4
PAST_LEN = 16384
PAGE_SIZE = 128

N_MIXERS = 3
N_A_LAYERS = (DEPTH + 2) // 3
N_B_LAYERS = (DEPTH + 1) // 3
N_C_LAYERS = DEPTH // 3
DN_ALPHA = (2.0 * DEPTH) ** 0.25
DN_BETA = (8.0 * DEPTH) ** -0.25
LN_EPS = 1e-5
RMS_EPS = 1e-6
D_FF = 5632
CHUNK = 64

A_WINDOWS = (128, 512, 2048)
A_DILATIONS = (1, 4, 16)
A_GROUPS = 3
A_HEADS = 8
A_HEAD_DIM = 128
A_ROT_DIM = A_HEAD_DIM // 4
A_SPAN = 128
A_BLOCK = 128
ROPE_THETA = 500000.0
A_QKV = 3 * A_GROUPS * A_HEADS * A_HEAD_DIM

B_QK_HEADS = 16
B_V_HEADS = 32
B_HEAD_DIM = 128
B_CONV = 4
B_KEY_DIM = B_QK_HEADS * B_HEAD_DIM
B_VAL_DIM = B_V_HEADS * B_HEAD_DIM
B_CONV_DIM = 2 * B_KEY_DIM + B_VAL_DIM
B_IN = B_CONV_DIM + B_VAL_DIM + 2 * B_V_HEADS

C_D_INNER = 2 * D_MODEL
C_HEAD_DIM = 64
C_HEADS = C_D_INNER // C_HEAD_DIM
C_GROUPS = 8
C_D_STATE = 128
C_CONV = 4
C_CONV_DIM = C_D_INNER + 2 * C_GROUPS * C_D_STATE
C_IN = C_D_INNER + C_CONV_DIM + C_HEADS

kernel_name = 'hybrid_dilated_delta_ssd_macaron_step'

F32 = jnp.float32


def layer_norm(x, g, b):
    xf = x.astype(F32)
    mu = jnp.mean(xf, -1, keepdims=True)
    xc = xf - mu
    var = jnp.mean(xc * xc, -1, keepdims=True)
    return (xc * lax.rsqrt(var + LN_EPS) * g.astype(F32) + b.astype(F32)).astype(x.dtype)


def post_norm(x, f, g, b):
    return layer_norm(DN_ALPHA * x + f, g, b)


def swiglu(x, w_gu, w_down):
    gate, up = jnp.split(x @ w_gu, 2, axis=-1)
    return (jax.nn.silu(gate) * up) @ w_down


def causal_conv(u, prev, w):
    K = w.shape[0]
    T = u.shape[1]
    full = jnp.concatenate([prev.astype(u.dtype), u], axis=1)
    out = full[:, 0:T] * w[0]
    for j in range(1, K):
        out = out + full[:, j:j + T] * w[j]
    return out, full[:, T:]


def _pad_time(t, tp):
    return jnp.pad(t, [(0, 0), (0, tp - t.shape[1])] + [(0, 0)] * (t.ndim - 2))


def _chunk(t, c):
    bn, tp = t.shape[:2]
    return jnp.moveaxis(t.reshape(bn, tp // c, c, *t.shape[2:]), 1, 0)


def rope_partial(x, pos):
    half = A_ROT_DIM // 2
    inv_freq = ROPE_THETA ** (-jnp.arange(half, dtype=F32) / half)
    ang = pos.astype(F32)[:, None] * inv_freq[None, :]
    cos = jnp.cos(ang)[:, None, :]
    sin = jnp.sin(ang)[:, None, :]
    xr = x[..., :A_ROT_DIM].astype(F32)
    x1, x2 = xr[..., :half], xr[..., half:]
    rot = jnp.concatenate([x1 * cos - x2 * sin, x2 * cos + x1 * sin], -1).astype(x.dtype)
    return jnp.concatenate([rot, x[..., A_ROT_DIM:]], -1)


def a_project(x, pos, w_qkv):
    bn, t, _ = x.shape
    qkv = (x @ w_qkv).reshape(bn, t, 3, A_GROUPS * A_HEADS, A_HEAD_DIM)
    q = rope_partial(qkv[:, :, 0], pos)
    k = rope_partial(qkv[:, :, 1], pos)
    v = qkv[:, :, 2]
    split = lambda z: z.reshape(bn, t, A_GROUPS, A_HEADS, A_HEAD_DIM)
    return split(q), split(k), split(v)


def _attend(s, mask):
    s = jnp.where(mask, s, -jnp.inf)
    m = jnp.max(s, -1, keepdims=True)
    p = jnp.exp(s - m)
    l = jnp.sum(p, -1, keepdims=True)
    return p / l, (m + jnp.log(l))[..., 0]


def dilated_group_prompt(q, k, v, dil):
    bn, t, h, dh = q.shape
    period = dil * A_BLOCK
    tp = -(-t // period) * period
    L = tp // dil
    nb = L // A_BLOCK

    def by_stride(z):
        z = _pad_time(z, tp).reshape(bn, L, dil, h, dh).transpose(0, 2, 1, 3, 4)
        return z.reshape(bn, dil, nb, A_BLOCK, h, dh)

    def with_prev(z):
        prev = jnp.pad(z, ((0, 0), (0, 0), (1, 0), (0, 0), (0, 0), (0, 0)))[:, :, :-1]
        return jnp.concatenate([prev, z], axis=3)

    qb = by_stride(q)
    kk = with_prev(by_stride(k))
    vv = with_prev(by_stride(v))
    s = jnp.einsum('brnqhd,brnkhd->brnhqk', qb, kk, preferred_element_type=F32) * (A_HEAD_DIM ** -0.5)
    qi = jnp.arange(A_BLOCK)[:, None]
    ki = jnp.arange(2 * A_BLOCK)[None, :]
    dist = A_BLOCK + qi - ki
    band = (dist >= 0) & (dist <= A_SPAN)
    has_prev = (jnp.arange(nb) > 0)[:, None, None] | (ki >= A_BLOCK)[None]
    mask = (band[None] & has_prev)[:, None]
    p, lse = _attend(s, mask)
    o = jnp.einsum('brnhqk,brnkhd->brnqhd', p, vv.astype(F32))
    o = o.reshape(bn, dil, L, h, dh).transpose(0, 2, 1, 3, 4).reshape(bn, tp, h, dh)[:, :t]
    lse = lse.transpose(0, 1, 2, 4, 3).reshape(bn, dil, L, h).transpose(0, 2, 1, 3).reshape(bn, tp, h)[:, :t]
    return o, lse


def dilated_group_sample(q, k_all, v_all, dil):
    t = q.shape[1]
    wb = k_all.shape[1] - t
    idx = wb + jnp.arange(t)[:, None] - dil * jnp.arange(A_SPAN + 1)[None, :]
    valid = idx >= 0
    idx = jnp.maximum(idx, 0)
    kg = k_all[:, idx]
    vg = v_all[:, idx]
    s = jnp.einsum('bthd,btkhd->bhtk', q, kg, preferred_element_type=F32) * (A_HEAD_DIM ** -0.5)
    p, lse = _attend(s, valid[None, None])
    o = jnp.einsum('bhtk,btkhd->bthd', p, vg.astype(F32))
    return o, lse.transpose(0, 2, 1)


def a_merge(outs, lses, w_o, dtype):
    o = jnp.stack(outs)
    wts = jax.nn.softmax(jnp.stack(lses), axis=0)
    o = jnp.einsum('gbthd,gbth->bthd', o, wts)
    bn, t = o.shape[:2]
    return o.reshape(bn, t, A_HEADS * A_HEAD_DIM).astype(dtype) @ w_o


def mixer_a_prompt(x, w_qkv, w_o):
    t = x.shape[1]
    q, k, v = a_project(x, jnp.arange(t), w_qkv)
    outs, lses, rows = [], [], []
    for g in range(A_GROUPS):
        o, lse = dilated_group_prompt(q[:, :, g], k[:, :, g], v[:, :, g], A_DILATIONS[g])
        outs.append(o)
        lses.append(lse)
        keep = min(A_WINDOWS[g], t)
        rows.append(jnp.stack([k[:, t - keep:, g], v[:, t - keep:, g]], axis=2))
    return a_merge(outs, lses, w_o, x.dtype), rows


def mixer_a_sample(x, bufs, w_qkv, w_o):
    t = x.shape[1]
    q, k, v = a_project(x, PAST_LEN + jnp.arange(t), w_qkv)
    outs, lses, rows = [], [], []
    for g in range(A_GROUPS):
        buf = bufs[g]
        wb = buf.shape[1]
        k_all = jnp.concatenate([buf[:, :, 0], k[:, :, g].astype(buf.dtype)], axis=1)
        v_all = jnp.concatenate([buf[:, :, 1], v[:, :, g].astype(buf.dtype)], axis=1)
        o, lse = dilated_group_sample(q[:, :, g], k_all, v_all, A_DILATIONS[g])
        outs.append(o)
        lses.append(lse)
        rows.append(jnp.stack([k_all, v_all], axis=2)[:, t:t + wb])
    return a_merge(outs, lses, w_o, x.dtype), rows


def l2norm(z):
    zf = z.astype(F32)
    return zf * lax.rsqrt(jnp.sum(zf * zf, -1, keepdims=True) + 1e-6)


def gated_delta_chunked(q, k, v, g, beta, s0):
    bn, t, h, dk = q.shape
    c = min(CHUNK, t)
    tp = -(-t // c) * c
    q = q * dk ** -0.5
    xs = [_chunk(_pad_time(z, tp), c) for z in (q, k, v, g, beta)]
    xs[3] = jnp.cumsum(xs[3], axis=2)
    ii = jnp.arange(c)[:, None]
    jj = jnp.arange(c)[None, :]
    incl = ii >= jj
    strict = ii > jj
    eye = jnp.eye(c, dtype=F32)

    def step(S, inp):
        q_c, k_c, v_c, g_c, b_c = inp
        gh = g_c.transpose(0, 2, 1)
        decay = jnp.exp(jnp.where(incl, gh[..., :, None] - gh[..., None, :], -jnp.inf))
        kb = k_c * b_c[..., None]
        lmat = jnp.where(strict, jnp.einsum('bihd,bjhd->bhij', kb, k_c) * decay, 0.0)
        rhs = jnp.concatenate([v_c * b_c[..., None], kb * jnp.exp(g_c)[..., None]], -1).transpose(0, 2, 1, 3)
        sol = lax.linalg.triangular_solve(lmat + eye, rhs, left_side=True, lower=True, unit_diagonal=True)
        dv = v_c.shape[-1]
        u, w = sol[..., :dv], sol[..., dv:]
        v_new = u - jnp.einsum('bhcd,bhde->bhce', w, S)
        qk = jnp.where(incl, jnp.einsum('bihd,bjhd->bhij', q_c, k_c) * decay, 0.0)
        o = (jnp.einsum('bihd,bhde->bihe', q_c * jnp.exp(g_c)[..., None], S)
             + jnp.einsum('bhij,bhje->bihe', qk, v_new))
        k_dec = k_c * jnp.exp(g_c[:, -1:] - g_c)[..., None]
        S = S * jnp.exp(gh[..., -1])[..., None, None] + jnp.einsum('bchd,bhce->bhde', k_dec, v_new)
        return S, o

    S, o = lax.scan(step, s0, tuple(xs))
    o = jnp.moveaxis(o, 0, 1).reshape(bn, tp, h, -1)[:, :t]
    return o, S


def mixer_b(x, s0, conv0, w_in, conv_w, a_log, dt_bias, norm_w, w_out):
    bn, t, _ = x.shape
    qkv, z, b_raw, a_raw = jnp.split(x @ w_in, [B_CONV_DIM, B_CONV_DIM + B_VAL_DIM,
                                                B_CONV_DIM + B_VAL_DIM + B_V_HEADS], axis=-1)
    qkv, conv_new = causal_conv(qkv, conv0, conv_w)
    qkv = jax.nn.silu(qkv)
    q, k, v = jnp.split(qkv, [B_KEY_DIM, 2 * B_KEY_DIM], axis=-1)
    rep = B_V_HEADS // B_QK_HEADS
    q = jnp.repeat(l2norm(q.reshape(bn, t, B_QK_HEADS, B_HEAD_DIM)), rep, axis=2)
    k = jnp.repeat(l2norm(k.reshape(bn, t, B_QK_HEADS, B_HEAD_DIM)), rep, axis=2)
    v = v.reshape(bn, t, B_V_HEADS, B_HEAD_DIM).astype(F32)
    beta = jax.nn.sigmoid(b_raw.astype(F32))
    g = -jnp.exp(a_log.astype(F32)) * jax.nn.softplus(a_raw.astype(F32) + dt_bias.astype(F32))
    o, s_new = gated_delta_chunked(q, k, v, g, beta, s0.astype(F32))
    o = o * lax.rsqrt(jnp.mean(o * o, -1, keepdims=True) + RMS_EPS) * norm_w.astype(F32)
    o = o * jax.nn.silu(z.reshape(bn, t, B_V_HEADS, B_HEAD_DIM).astype(F32))
    y = o.reshape(bn, t, B_VAL_DIM).astype(x.dtype) @ w_out
    return y, s_new, conv_new


def ssd_chunked(x, dt, a, bm, cm, h0):
    bn, t = x.shape[:2]
    c = min(CHUNK, t)
    tp = -(-t // c) * c
    la = dt * a
    xs = [_chunk(_pad_time(z, tp), c) for z in (x, dt, la, bm, cm)]
    xs[2] = jnp.cumsum(xs[2], axis=2)
    tri = (jnp.arange(c)[:, None] >= jnp.arange(c)[None, :])[None, :, :, None, None]

    def step(h, inp):
        x_c, dt_c, acs, b_c, c_c = inp
        decay = jnp.exp(jnp.where(tri, acs[:, :, None] - acs[:, None, :], -jnp.inf))
        cb = jnp.einsum('bign,bjgn->bijg', c_c, b_c)
        y = jnp.einsum('bijg,bijgh,bjghp->bighp', cb, decay, dt_c[..., None] * x_c)
        y = y + jnp.einsum('bign,bghpn->bighp', c_c, h) * jnp.exp(acs)[..., None]
        w_end = jnp.exp(acs[:, -1:] - acs) * dt_c
        h = (h * jnp.exp(acs[:, -1])[..., None, None]
             + jnp.einsum('bjgn,bjghp->bghpn', b_c, w_end[..., None] * x_c))
        return h, y

    h, y = lax.scan(step, h0, tuple(xs))
    y = jnp.moveaxis(y, 0, 1).reshape(bn, tp, *x.shape[2:])[:, :t]
    return y, h


def mixer_c(x, h0, conv0, w_in, conv_w, conv_b, dt_bias, a_log, d_skip, norm_w, w_out):
    bn, t, _ = x.shape
    hg = C_HEADS // C_GROUPS
    z, xbc, dt = jnp.split(x @ w_in, [C_D_INNER, C_D_INNER + C_CONV_DIM], axis=-1)
    xbc, conv_new = causal_conv(xbc, conv0, conv_w)
    xbc = jax.nn.silu(xbc + conv_b)
    xs, bm, cm = jnp.split(xbc, [C_D_INNER, C_D_INNER + C_GROUPS * C_D_STATE], axis=-1)
    xs = xs.reshape(bn, t, C_GROUPS, hg, C_HEAD_DIM).astype(F32)
    bm = bm.reshape(bn, t, C_GROUPS, C_D_STATE).astype(F32)
    cm = cm.reshape(bn, t, C_GROUPS, C_D_STATE).astype(F32)
    dt = jax.nn.softplus(dt.astype(F32) + dt_bias.astype(F32)).reshape(bn, t, C_GROUPS, hg)
    a = -jnp.exp(a_log.astype(F32)).reshape(C_GROUPS, hg)
    h0 = h0.astype(F32).reshape(bn, C_GROUPS, hg, C_HEAD_DIM, C_D_STATE)
    y, h_new = ssd_chunked(xs, dt, a, bm, cm, h0)
    y = y + d_skip.astype(F32).reshape(C_GROUPS, hg)[..., None] * xs
    y = y.reshape(bn, t, C_D_INNER) * jax.nn.silu(z.astype(F32))
    yg = y.reshape(bn, t, C_GROUPS, C_D_INNER // C_GROUPS)
    yg = yg * lax.rsqrt(jnp.mean(yg * yg, -1, keepdims=True) + RMS_EPS)
    y = yg.reshape(bn, t, C_D_INNER) * norm_w.astype(F32)
    out = y.astype(x.dtype) @ w_out
    return out, h_new.reshape(bn, C_HEADS, C_HEAD_DIM, C_D_STATE), conv_new


def setup_inputs(seed: int = 0) -> dict:
    key = jax.random.key(seed)
    ks = list(jax.random.split(key, 40))

    def nrm(shape, scale):
        return scale * jax.random.normal(ks.pop(), shape, F32)

    def dt_bias(shape):
        u = jax.random.uniform(ks.pop(), shape, F32)
        dt = jnp.exp(u * (math.log(0.1) - math.log(0.001)) + math.log(0.001))
        return dt + jnp.log(-jnp.expm1(-dt))

    def a_log(shape):
        return jnp.log(jax.random.uniform(ks.pop(), shape, F32, 1.0, 16.0))

    d = D_MODEL
    inp = {}
    inp['x_prompt'] = nrm((BATCH, SEQ, d), 1.0)
    inp['x_sample'] = nrm((DEC_BATCH, DEC_SEQ, d), 1.0)
    for w in A_WINDOWS:
        inp['cache_a_kv_w%d' % w] = nrm((N_A_LAYERS, DEC_BATCH, min(w, PAST_LEN), 2, A_HEADS, A_HEAD_DIM), 1.0)
    inp['state_b_ssm'] = nrm((N_B_LAYERS, DEC_BATCH, B_V_HEADS, B_HEAD_DIM, B_HEAD_DIM), 0.1)
    inp['state_b_conv'] = nrm((N_B_LAYERS, DEC_BATCH, B_CONV - 1, B_CONV_DIM), 1.0)
    inp['state_c_ssm'] = nrm((N_C_LAYERS, DEC_BATCH, C_HEADS, C_HEAD_DIM, C_D_STATE), 0.1)
    inp['state_c_conv'] = nrm((N_C_LAYERS, DEC_BATCH, C_CONV - 1, C_CONV_DIM), 1.0)
    inp['ln_g'] = 1.0 + nrm((DEPTH, 3, d), 0.02)
    inp['ln_b'] = nrm((DEPTH, 3, d), 0.02)
    inp['ffn1_w_gu'] = nrm((DEPTH, d, 2 * D_FF), d ** -0.5)
    inp['ffn1_w_down'] = nrm((DEPTH, D_FF, d), DN_BETA * D_FF ** -0.5)
    inp['ffn2_w_gu'] = nrm((DEPTH, d, 2 * D_FF), d ** -0.5)
    inp['ffn2_w_down'] = nrm((DEPTH, D_FF, d), DN_BETA * D_FF ** -0.5)
    inp['a_w_qkv'] = nrm((N_A_LAYERS, d, A_QKV), d ** -0.5)
    inp['a_w_o'] = nrm((N_A_LAYERS, A_HEADS * A_HEAD_DIM, d), DN_BETA * (A_HEADS * A_HEAD_DIM) ** -0.5)
    inp['b_w_in'] = nrm((N_B_LAYERS, d, B_IN), d ** -0.5)
    inp['b_conv_w'] = nrm((N_B_LAYERS, B_CONV, B_CONV_DIM), B_CONV ** -0.5)
    inp['b_a_log'] = a_log((N_B_LAYERS, B_V_HEADS))
    inp['b_dt_bias'] = dt_bias((N_B_LAYERS, B_V_HEADS))
    inp['b_norm_w'] = 1.0 + nrm((N_B_LAYERS, B_HEAD_DIM), 0.02)
    inp['b_w_out'] = nrm((N_B_LAYERS, B_VAL_DIM, d), DN_BETA * B_VAL_DIM ** -0.5)
    inp['c_w_in'] = nrm((N_C_LAYERS, d, C_IN), d ** -0.5)
    inp['c_conv_w'] = nrm((N_C_LAYERS, C_CONV, C_CONV_DIM), C_CONV ** -0.5)
    inp['c_conv_b'] = nrm((N_C_LAYERS, C_CONV_DIM), 0.02)
    inp['c_dt_bias'] = dt_bias((N_C_LAYERS, C_HEADS))
    inp['c_a_log'] = a_log((N_C_LAYERS, C_HEADS))
    inp['c_d'] = 1.0 + nrm((N_C_LAYERS, C_HEADS), 0.1)
    inp['c_norm_w'] = 1.0 + nrm((N_C_LAYERS, C_D_INNER), 0.02)
    inp['c_w_out'] = nrm((N_C_LAYERS, C_D_INNER, d), DN_BETA * C_D_INNER ** -0.5)
    return inp


def reference(x_prompt, x_sample, cache_a_kv_w128, cache_a_kv_w512, cache_a_kv_w2048,
              state_b_ssm, state_b_conv, state_c_ssm, state_c_conv,
              ln_g, ln_b, ffn1_w_gu, ffn1_w_down, ffn2_w_gu, ffn2_w_down,
              a_w_qkv, a_w_o,
              b_w_in, b_conv_w, b_a_log, b_dt_bias, b_norm_w, b_w_out,
              c_w_in, c_conv_w, c_conv_b, c_dt_bias, c_a_log, c_d, c_norm_w, c_w_out):
    a_bufs = (cache_a_kv_w128, cache_a_kv_w512, cache_a_kv_w2048)
    out_dtype = x_prompt.dtype
    xp, xs = x_prompt, x_sample
    bp = xp.shape[0]
    a_p = [[] for _ in range(A_GROUPS)]
    a_s = [[] for _ in range(A_GROUPS)]
    b_ssm_p, b_ssm_s, b_conv_p, b_conv_s = [], [], [], []
    c_ssm_p, c_ssm_s, c_conv_p, c_conv_s = [], [], [], []
    for i in range(DEPTH):
        kind, j = i % N_MIXERS, i // N_MIXERS
        xp = post_norm(xp, 0.5 * swiglu(xp, ffn1_w_gu[i], ffn1_w_down[i]), ln_g[i, 0], ln_b[i, 0])
        xs = post_norm(xs, 0.5 * swiglu(xs, ffn1_w_gu[i], ffn1_w_down[i]), ln_g[i, 0], ln_b[i, 0])
        if kind == 0:
            mp, rows_p = mixer_a_prompt(xp, a_w_qkv[j], a_w_o[j])
            ms, rows_s = mixer_a_sample(xs, [buf[j] for buf in a_bufs], a_w_qkv[j], a_w_o[j])
            for g in range(A_GROUPS):
                a_p[g].append(rows_p[g])
                a_s[g].append(rows_s[g])
        elif kind == 1:
            s0 = jnp.zeros((bp, B_V_HEADS, B_HEAD_DIM, B_HEAD_DIM), F32)
            cv0 = jnp.zeros((bp, B_CONV - 1, B_CONV_DIM), xp.dtype)
            mp, sp, cp = mixer_b(xp, s0, cv0, b_w_in[j], b_conv_w[j], b_a_log[j], b_dt_bias[j], b_norm_w[j], b_w_out[j])
            ms, ss, cs = mixer_b(xs, state_b_ssm[j], state_b_conv[j], b_w_in[j], b_conv_w[j], b_a_log[j],
                                 b_dt_bias[j], b_norm_w[j], b_w_out[j])
            b_ssm_p.append(sp)
            b_ssm_s.append(ss)
            b_conv_p.append(cp)
            b_conv_s.append(cs)
        else:
            h0 = jnp.zeros((bp, C_HEADS, C_HEAD_DIM, C_D_STATE), F32)
            cv0 = jnp.zeros((bp, C_CONV - 1, C_CONV_DIM), xp.dtype)
            mp, hp, cp = mixer_c(xp, h0, cv0, c_w_in[j], c_conv_w[j], c_conv_b[j], c_dt_bias[j], c_a_log[j],
                                 c_d[j], c_norm_w[j], c_w_out[j])
            ms, hs, cs = mixer_c(xs, state_c_ssm[j], state_c_conv[j], c_w_in[j], c_conv_w[j], c_conv_b[j],
                                 c_dt_bias[j], c_a_log[j], c_d[j], c_norm_w[j], c_w_out[j])
            c_ssm_p.append(hp)
            c_ssm_s.append(hs)
            c_conv_p.append(cp)
            c_conv_s.append(cs)
        xp = post_norm(xp, mp, ln_g[i, 1], ln_b[i, 1])
        xs = post_norm(xs, ms, ln_g[i, 1], ln_b[i, 1])
        xp = post_norm(xp, 0.5 * swiglu(xp, ffn2_w_gu[i], ffn2_w_down[i]), ln_g[i, 2], ln_b[i, 2])
        xs = post_norm(xs, 0.5 * swiglu(xs, ffn2_w_gu[i], ffn2_w_down[i]), ln_g[i, 2], ln_b[i, 2])

    st = lambda lst: jnp.stack(lst).astype(out_dtype)
    return (xp, xs,
            st(a_p[0]), st(a_s[0]), st(a_p[1]), st(a_s[1]), st(a_p[2]), st(a_s[2]),
            st(b_ssm_p), st(b_ssm_s), st(b_conv_p), st(b_conv_s),
            st(c_ssm_p), st(c_ssm_s), st(c_conv_p), st(c_conv_s))
```

```cpp
#include <hip/hip_runtime.h>
#include <cstdio>
#include <cstdint>
#ifndef MK_MULTI
#define MK_MULTI 0
#endif
namespace pg8 {
#define PG8_LAS __attribute__((address_space(3)))
typedef unsigned short bf16_t;
typedef short bf16x8 __attribute__((ext_vector_type(8)));
typedef float f32x4 __attribute__((ext_vector_type(4)));
typedef unsigned u32x4 __attribute__((ext_vector_type(4)));
constexpr int BM = 256, BK = 64, HALF = 128, HTB = HALF * BK * 2  , STAGE_BYTES = 8 * HTB, NXCD = 8, WGM = 8;

__host__ __device__ __forceinline__ int lds_byte(int r, int c) { const int st = (r >> 4) * 2 + (c >> 5), rr = r & 15, cc = c & 31, ob = rr * 64 + cc * 2; return st * 1024 + (ob ^ (((ob >> 9) & 1) << 5)); }
__host__ __device__ __forceinline__ void stage_rc(int b, int& R, int& C) { const int st = b / 1024, sb = b % 1024, swz = sb ^ (((sb >> 9) & 1) << 5); R = (st >> 1) * 16 + swz / 64; C = (st & 1) * 32 + (swz % 64) / 2; }
__host__ __device__ __forceinline__ int perm32(int rho) { const int n = rho >> 4, i = rho & 15; return 8 * (i >> 2) + 4 * n + (i & 3); }

struct Unit { int pm, pn; };
struct Gemm { const bf16_t* A; const bf16_t* Bt; int M, N, K; };

struct StaticOrder {
    int nM, nN, nwg, G, c;
    __host__ __device__ void init(int M, int N, int G_, int c_) { nM = M / BM; nN = N / BM; nwg = nM * nN; G = G_; c = c_; }
    __host__ __device__ bool next(int i, Unit& u) const {
        const long L = (long)i * G + c; if (L >= nwg) return false;
        int wgid = (int)L; { const int q = nwg / NXCD, r = nwg % NXCD, xcd = wgid % NXCD, off = wgid / NXCD; wgid = (xcd < r ? xcd * (q + 1) : r * (q + 1) + (xcd - r) * q) + off; }
        const int nig = WGM * nN, gid = wgid / nig, fm = gid * WGM, gsz = (nM - fm) < WGM ? (nM - fm) : WGM;
        u.pm = fm + ((wgid % nig) % gsz); u.pn = (wgid % nig) / gsz; return true;
    }
    __device__ __forceinline__ void a_ready(const Unit&) const {}
    __device__ __forceinline__ void done(const Unit&) const {}
};


template <class Epi, class Sched, bool ALIGN_EPI = false, bool SP2 = false>
__device__ __forceinline__ void gemm_phase(PG8_LAS unsigned char* lds, const Gemm g, const Sched& S, const Epi& E, const int tid) {
    const int wid = __builtin_amdgcn_readfirstlane(tid >> 6), lane = tid & 63, wr = wid >> 2, wc = wid & 3, fr = lane & 15, fq = lane >> 4;
    const int K = g.K, nt = K / BK;
    unsigned voffA[2], voffB[2];
#pragma unroll
    for (int i = 0; i < 2; ++i) { int R, C; stage_rc(tid * 16 + i * 8192, R, C); const int Rb = Epi::PERM ? ((R & ~31) + perm32(R & 31)) : R;
        voffA[i] = (unsigned)(R * K + C) * 2u; voffB[i] = (unsigned)(Rb * K + C) * 2u; }
    const size_t kstep = (size_t)(BK * 2);
    const size_t hstep = (size_t)HALF * K * 2;
    const size_t tstep = 2 * hstep;
    const unsigned ldsw = (unsigned)wid * 1024u;
    const int aoff = lds_byte(wr * 64 + fr, fq * 8), boff = lds_byte(wc * 32 + fr, fq * 8);
#define PG8_SA(b, h) (((b) * 2 + (h)) * HTB)
#define PG8_SB(b, h) ((4 + (b) * 2 + (h)) * HTB)
#define PG8_STAGE(bufoff, gbase, voff) do { _Pragma("unroll") for (int _i = 0; _i < 2; ++_i) \
        __builtin_amdgcn_global_load_lds((const unsigned*)((const char*)(gbase) + (voff)[_i]), (PG8_LAS unsigned*)(lds + (bufoff) + ldsw + _i * 8192), 16, 0, 0); } while (0)
#define PG8_LDA(dst, b, h) do { _Pragma("unroll") for (int m = 0; m < 4; ++m) _Pragma("unroll") for (int k = 0; k < 2; ++k) dst[m][k] = *(const PG8_LAS bf16x8*)(lds + PG8_SA(b, h) + aoff + m * 2048 + k * 1024); } while (0)
#define PG8_LDB(dst, b, h) do { _Pragma("unroll") for (int n = 0; n < 2; ++n) _Pragma("unroll") for (int k = 0; k < 2; ++k) dst[n][k] = *(const PG8_LAS bf16x8*)(lds + PG8_SB(b, h) + boff + n * 2048 + k * 1024); } while (0)
#define PG8_MMA(ai, bj, At, Bt) do { __builtin_amdgcn_s_setprio(1); _Pragma("unroll") for (int m = 0; m < 4; ++m) _Pragma("unroll") for (int n = 0; n < 2; ++n) _Pragma("unroll") for (int k = 0; k < 2; ++k) \
        acc[ai][bj][m][n] = __builtin_amdgcn_mfma_f32_16x16x32_bf16(Bt[n][k], At[m][k], acc[ai][bj][m][n], 0, 0, 0); __builtin_amdgcn_s_setprio(0); } while (0)
#define PG8_WAIT_V(n) asm volatile("s_waitcnt vmcnt(" #n ")" ::: "memory")
#define PG8_WAIT_L(n) asm volatile("s_waitcnt lgkmcnt(" #n ")" ::: "memory")
#define PG8_BAR __builtin_amdgcn_s_barrier()
#define PG8_SCHED __builtin_amdgcn_sched_barrier(0)
    Unit cur, nxt; int ui = 0;
    if (!S.next(0, cur)) return;
    f32x4 acc[2][2][4][2];
#pragma unroll
    for (int a = 0; a < 2; ++a)
#pragma unroll
        for (int b = 0; b < 2; ++b)
#pragma unroll
            for (int m = 0; m < 4; ++m)
#pragma unroll
                for (int n = 0; n < 2; ++n) acc[a][b][m][n] = (f32x4){0.f, 0.f, 0.f, 0.f};
    bf16x8 At[4][2], B0[2][2], B1[2][2];
    const char* cA = (const char*)g.A + (size_t)cur.pm * tstep; const char* cB = (const char*)g.Bt + (size_t)cur.pn * tstep;
    S.a_ready(cur);
    if constexpr (SP2) {
        PG8_STAGE(PG8_SB(0, 0), cB, voffB); PG8_STAGE(PG8_SB(0, 1), cB + hstep, voffB); PG8_STAGE(PG8_SA(0, 0), cA, voffA); PG8_STAGE(PG8_SA(0, 1), cA + hstep, voffA);
        if (wr == 1) PG8_BAR;
        PG8_WAIT_V(2); PG8_BAR;
        PG8_STAGE(PG8_SB(1, 0), cB + kstep, voffB); PG8_STAGE(PG8_SA(1, 0), cA + kstep, voffA); PG8_STAGE(PG8_SB(1, 1), cB + hstep + kstep, voffB);
        PG8_WAIT_V(6); PG8_BAR;
    } else {
        PG8_STAGE(PG8_SB(0, 0), cB, voffB); PG8_STAGE(PG8_SA(0, 0), cA, voffA); PG8_STAGE(PG8_SB(0, 1), cB + hstep, voffB); PG8_STAGE(PG8_SA(0, 1), cA + hstep, voffA);
        if (wr == 1) PG8_BAR;
        PG8_WAIT_V(4); PG8_BAR;
        PG8_STAGE(PG8_SB(1, 0), cB + kstep, voffB); PG8_STAGE(PG8_SA(1, 0), cA + kstep, voffA); PG8_STAGE(PG8_SB(1, 1), cB + hstep + kstep, voffB);
        PG8_WAIT_V(6); PG8_BAR;
    }
    for (;;) {
        const bool has_next = S.next(ui + 1, nxt);
        const char* nA = has_next ? (const char*)g.A + (size_t)nxt.pm * tstep : cA; const char* nB = has_next ? (const char*)g.Bt + (size_t)nxt.pn * tstep : cB;
        for (int t = 0; t < nt; t += 2) {
            const bool last = (t == nt - 2);
            const char* a1 = cA + (size_t)(t + 1) * kstep;
            const char* a2 = last ? nA : cA + (size_t)(t + 2) * kstep; const char* b2 = last ? nB : cB + (size_t)(t + 2) * kstep;
            const char* a3 = a2 + kstep; const char* b3 = b2 + kstep;
            if (last && has_next) S.a_ready(nxt);
            if constexpr (SP2) {
            PG8_LDB(B0, 0, 0); PG8_LDB(B1, 0, 1); PG8_SCHED; PG8_LDA(At, 0, 0); PG8_STAGE(PG8_SA(1, 1), a1 + hstep, voffA);
            PG8_WAIT_V(8); PG8_WAIT_L(0); PG8_BAR; PG8_MMA(0, 0, At, B0); PG8_MMA(0, 1, At, B1); PG8_BAR; PG8_SCHED;
            PG8_LDA(At, 0, 1); PG8_STAGE(PG8_SB(0, 0), b2, voffB); PG8_STAGE(PG8_SB(0, 1), b2 + hstep, voffB); PG8_STAGE(PG8_SA(0, 0), a2, voffA);
            PG8_WAIT_V(8); PG8_WAIT_L(0); PG8_BAR; PG8_MMA(1, 0, At, B0); PG8_MMA(1, 1, At, B1); PG8_BAR; PG8_SCHED;
            PG8_LDB(B0, 1, 0); PG8_LDB(B1, 1, 1); PG8_SCHED; PG8_LDA(At, 1, 0); PG8_STAGE(PG8_SA(0, 1), a2 + hstep, voffA);
            PG8_WAIT_V(8); PG8_WAIT_L(0); PG8_BAR; PG8_MMA(0, 0, At, B0); PG8_MMA(0, 1, At, B1); PG8_BAR; PG8_SCHED;
            PG8_LDA(At, 1, 1); PG8_STAGE(PG8_SB(1, 0), b3, voffB); PG8_STAGE(PG8_SB(1, 1), b3 + hstep, voffB); PG8_STAGE(PG8_SA(1, 0), a3, voffA);
            PG8_WAIT_V(8); PG8_WAIT_L(0); PG8_BAR; PG8_MMA(1, 0, At, B0); PG8_MMA(1, 1, At, B1); PG8_BAR; PG8_SCHED;
            } else {
            PG8_LDB(B0, 0, 0); PG8_SCHED; PG8_LDA(At, 0, 0); PG8_STAGE(PG8_SA(1, 1), a1 + hstep, voffA);
            PG8_WAIT_L(8); PG8_BAR; PG8_WAIT_L(0); PG8_MMA(0, 0, At, B0); PG8_BAR; PG8_SCHED;
            PG8_LDB(B1, 0, 1); PG8_STAGE(PG8_SB(0, 0), b2, voffB);
            PG8_BAR; PG8_WAIT_L(0); PG8_MMA(0, 1, At, B1); PG8_BAR;
            PG8_LDA(At, 0, 1); PG8_STAGE(PG8_SA(0, 0), a2, voffA);
            PG8_BAR; PG8_WAIT_L(0); PG8_MMA(1, 0, At, B0); PG8_BAR; PG8_SCHED;
            PG8_STAGE(PG8_SB(0, 1), b2 + hstep, voffB);
            PG8_WAIT_V(6); PG8_BAR; PG8_MMA(1, 1, At, B1); PG8_BAR;
            PG8_LDB(B0, 1, 0); PG8_SCHED; PG8_LDA(At, 1, 0); PG8_STAGE(PG8_SA(0, 1), a2 + hstep, voffA);
            PG8_WAIT_L(8); PG8_BAR; PG8_WAIT_L(0); PG8_MMA(0, 0, At, B0); PG8_BAR; PG8_SCHED;
            PG8_LDB(B1, 1, 1); PG8_STAGE(PG8_SB(1, 0), b3, voffB);
            PG8_BAR; PG8_WAIT_L(0); PG8_MMA(0, 1, At, B1); PG8_BAR;
            PG8_LDA(At, 1, 1); PG8_STAGE(PG8_SA(1, 0), a3, voffA);
            PG8_BAR; PG8_WAIT_L(0); PG8_MMA(1, 0, At, B0); PG8_BAR; PG8_SCHED;
            PG8_STAGE(PG8_SB(1, 1), b3 + hstep, voffB);
            PG8_WAIT_V(6); PG8_BAR; PG8_MMA(1, 1, At, B1); PG8_BAR;
            }
        }
        if constexpr (ALIGN_EPI) { if (wr == 0) PG8_BAR; }
        if constexpr (!Epi::AFTER_DRAIN) { E(acc, cur, wr, wc, fr, fq); S.done(cur); }
        if (!has_next) break;
#pragma unroll
        for (int a = 0; a < 2; ++a)
#pragma unroll
            for (int b = 0; b < 2; ++b)
#pragma unroll
                for (int m = 0; m < 4; ++m)
#pragma unroll
                    for (int n = 0; n < 2; ++n) acc[a][b][m][n] = (f32x4){0.f, 0.f, 0.f, 0.f};
        cur = nxt; cA = nA; cB = nB; ++ui;
        if constexpr (ALIGN_EPI) { if (wr == 1) PG8_BAR; }
    }
    PG8_WAIT_V(0);
    if constexpr (!ALIGN_EPI) { if (wr == 0) PG8_BAR; }
    PG8_BAR;
    if constexpr (Epi::AFTER_DRAIN) { E.fused(acc, cur, wr, wc, fr, fq, lds, wid, lane); S.done(cur); }
#undef PG8_SA
#undef PG8_SB
#undef PG8_STAGE
#undef PG8_LDA
#undef PG8_LDB
#undef PG8_MMA
#undef PG8_WAIT_V
#undef PG8_WAIT_L
#undef PG8_BAR
#undef PG8_SCHED
}
}
#define GAS __attribute__((address_space(1)))
#define LAS __attribute__((address_space(3)))
typedef unsigned short bf16;
typedef unsigned char uchar;
typedef float f32x4 __attribute__((ext_vector_type(4)));
typedef float f32x2 __attribute__((ext_vector_type(2)));
typedef float f32x16 __attribute__((ext_vector_type(16)));
typedef short bf16x8 __attribute__((ext_vector_type(8)));
typedef short s16x4 __attribute__((ext_vector_type(4)));
typedef unsigned u32x4 __attribute__((ext_vector_type(4)));
typedef unsigned u32x2 __attribute__((ext_vector_type(2)));
typedef __bf16 hbf16x2 __attribute__((ext_vector_type(2)));
#define DI __device__ __forceinline__

DI unsigned pk2(float a, float b) { f32x2 v = {a, b}; hbf16x2 r = __builtin_convertvector(v, hbf16x2); return __builtin_bit_cast(unsigned, r); }
DI float bf2f(unsigned short b) { return __uint_as_float(((unsigned)b) << 16); }
DI float bflo(unsigned u) { return __uint_as_float(u << 16); }
DI float bfhi(unsigned u) { return __uint_as_float(u & 0xffff0000u); }
DI u32x2 pk4(f32x4 v) { u32x2 r; r.x = pk2(v[0], v[1]); r.y = pk2(v[2], v[3]); return r; }
DI float wave_sum(float v) {
#pragma unroll
    for (int o = 1; o < 64; o <<= 1) v += __shfl_xor(v, o);
    return v;
}
DI float wave_max(float v) {
#pragma unroll
    for (int o = 1; o < 64; o <<= 1) v = fmaxf(v, __shfl_xor(v, o));
    return v;
}
DI float silu_f(float x) { return x / (1.f + __expf(-x)); }
DI float sigmoid_f(float x) { return 1.f / (1.f + __expf(-x)); }
DI float softplus_f(float x) { return x > 20.f ? x : log1pf(__expf(x)); }
DI int crow(int r, int h) { return (r & 3) + 8 * (r >> 2) + 4 * h; }
template <class T> DI T ldg(const void* base, unsigned off) { return *(const T*)((const char*)base + off); }
template <class T> DI void stg(void* base, unsigned off, T v) { *(T*)((char*)base + off) = v; }

constexpr int DM = 2048, TP = 4096, NBP = 2, MP = NBP * TP, MS = 32, MALL = MP + MS, DFF = 5632, NGU = 2 * DFF;
constexpr int AQKV = 9216, BIN = 12352, BINM = 12288, CIN = 10304, CINM = 10240;
constexpr float DN_ALPHA = 1.6817928305074290f;
constexpr float LN_EPS = 1e-5f, RMS_EPS = 1e-6f;
constexpr int PASTLEN = 16384;

constexpr size_t O_YP = 0, O_YS = O_YP + (size_t)MP * DM, O_A128P = O_YS + (size_t)MS * DM,
    O_A128S = O_A128P + 1048576, O_A512P = O_A128S + 4194304, O_A512S = O_A512P + 4194304, O_A2048P = O_A512S + 16777216,
    O_A2048S = O_A2048P + 16777216, O_BSSMP = O_A2048S + 67108864, O_BSSMS = O_BSSMP + 1048576, O_BCONVP = O_BSSMS + 4194304,
    O_BCONVS = O_BCONVP + 49152, O_CSSMP = O_BCONVS + 196608, O_CSSMS = O_CSSMP + 1048576, O_CCONVP = O_CSSMS + 4194304,
    O_CCONVS = O_CCONVP + 36864, O_END = O_CCONVS + 147456;

constexpr size_t MiB = 1u << 20;
constexpr size_t WS_CTL = 0, CTL_ZERO_BYTES = 1 * MiB;
constexpr size_t WS_ROPE = 1 * MiB;
constexpr size_t WS_ZS = 2 * MiB, ZS_ONE = (size_t)MS * DM * 4;
constexpr size_t WS_W = 8 * MiB;
constexpr size_t GU_BYTES = (size_t)NGU * DM * 2, DN_BYTES = (size_t)DM * DFF * 2, FFN_BYTES = GU_BYTES + DN_BYTES;
constexpr size_t WS_WA = WS_W + 8 * FFN_BYTES, AQ_BYTES = (size_t)AQKV * DM * 2, AO_BYTES = (size_t)DM * 1024 * 2, A_BYTES = AQ_BYTES + AO_BYTES;
constexpr size_t WS_WB = WS_WA + 2 * A_BYTES, BI_BYTES = (size_t)BIN * DM * 2, BO_BYTES = (size_t)DM * 4096 * 2;
constexpr size_t WS_WC = WS_WB + BI_BYTES + BO_BYTES, CI_BYTES = (size_t)CIN * DM * 2, CO_BYTES = BO_BYTES;
constexpr size_t WS_XB = WS_WC + CI_BYTES + CO_BYTES;
constexpr size_t WS_ZP = WS_XB + (size_t)MALL * DM * 2;
constexpr size_t WS_H = WS_ZP + (size_t)MP * DM * 4;
constexpr size_t WS_MIX = WS_H + (size_t)MALL * DFF * 2;
constexpr size_t MA_QKV = WS_MIX, MA_QKVS = MA_QKV + (size_t)MP * AQKV * 2, MA_OG = MA_QKVS + (size_t)MS * AQKV * 4,
    MA_LSE = MA_OG + (size_t)3 * MP * 1024 * 2, MA_O = MA_LSE + (size_t)3 * MP * 8 * 4, MA_END = MA_O + (size_t)MALL * 1024 * 2;
constexpr size_t MB_PB = WS_MIX, MB_EB = MB_PB + (size_t)MP * BINM * 2, MB_PBS = MB_EB + (size_t)MP * 64 * 4, MB_WG = MB_PBS + (size_t)MS * BIN * 4,
    MB_UG = MB_WG + (size_t)MP * 32 * 128 * 2, MB_QG = MB_UG + (size_t)MP * 32 * 128 * 2, MB_KG = MB_QG + (size_t)MP * 16 * 128 * 2,
    MB_QKG = MB_KG + (size_t)MP * 16 * 128 * 2, MB_GCG = MB_QKG + (size_t)2 * 32 * 64 * 64 * 64 * 2, MB_YB = MB_GCG + (size_t)MP * 32 * 4,
    MB_END = MB_YB + (size_t)MALL * 4096 * 2;
constexpr size_t MC_PC = WS_MIX, MC_EC = MC_PC + (size_t)MP * CINM * 2, MC_PCS = MC_EC + (size_t)MP * 64 * 4, MC_SS = MC_PCS + (size_t)MS * CIN * 4,
    MC_YC = MC_SS + (size_t)MP * 64 * 4, MC_END = MC_YC + (size_t)MALL * 4096 * 2;
constexpr size_t WS_END = (MB_END > MA_END ? (MB_END > MC_END ? MB_END : MC_END) : (MA_END > MC_END ? MA_END : MC_END));
static_assert(MA_QKVS % 256 == 0 && MA_OG % 256 == 0 && MA_O % 256 == 0 && MB_EB % 256 == 0 && MB_WG % 256 == 0 && MB_YB % 256 == 0 && MC_YC % 256 == 0 && WS_MIX % 256 == 0, "alignment");

constexpr int CW_BAR = 4096;
constexpr int SCR_BYTES = 143360, MISC_OFF = SCR_BYTES, LDS_BYTES = 147456;
constexpr int NWAVES = 8;

struct WDesc { const float* src; bf16* dst; int K, N, mode, item0; };
constexpr int NWD = 24;
struct Args { const float* in[31]; float* out; unsigned char* ws; WDesc wd[NWD]; int nitems; int pad; };

struct Frame {
    LAS uchar* lds;
    int tid, lane, wave, G, gw, NGW, bid;
};
#define XB_TMO      128
#define XB_XCNT(j)  (256  + 64 * (j))
#define XB_XSUB(j)  (1280 + 64 * (j))
#define XB_XGEN(j)  (2304 + 64 * (j))
#define XB_TOP      3328
#define XB_TOPGEN   3392
#define XCD_BAR_WORDS 3456
#define XB_SPIN_CAP (1u << 18)

__device__ __forceinline__ unsigned xb_ld(unsigned* p)              { return __hip_atomic_load(p, __ATOMIC_RELAXED, __HIP_MEMORY_SCOPE_AGENT); }
__device__ __forceinline__ unsigned xb_add(unsigned* p, unsigned v) { return __hip_atomic_fetch_add(p, v, __ATOMIC_RELAXED, __HIP_MEMORY_SCOPE_AGENT); }
__device__ __forceinline__ unsigned xb_xcc_id() { return (unsigned)__builtin_amdgcn_s_getreg((3 << 11) | 20) & 0xFu; }
#define XB_SPIN(cond, bar) do { unsigned _sp = 0; while (cond) { __builtin_amdgcn_s_sleep(1); \
    if ((++_sp & 255u) == 0u) { if (xb_ld(&(bar)[XB_TMO])) break; if (_sp > XB_SPIN_CAP) { atomicAdd(&(bar)[XB_TMO], 1u); break; } } } } while (0)

struct XcdBarrier {
    unsigned* bar; unsigned x;
    volatile LAS unsigned* st;
};

__device__ __forceinline__ XcdBarrier xcd_barrier_post(unsigned* bar, volatile LAS unsigned* st) {
    XcdBarrier b; b.bar = bar; b.x = xb_xcc_id(); b.st = st;
    if (threadIdx.x == 0) (void)xb_add(&bar[XB_XCNT(b.x)], 1u);
    return b;
}
__device__ __forceinline__ void xcd_barrier_complete(unsigned* bar, unsigned x, unsigned& nloc, unsigned& nx) {
    const unsigned G = gridDim.x * gridDim.y * gridDim.z;
    unsigned sum, cnt, mine, sp = 0u;
    for (;;) {
        sum = 0u; cnt = 0u; mine = 0u;
#pragma unroll
        for (unsigned j = 0; j < 16; ++j) { const unsigned c = xb_ld(&bar[XB_XCNT(j)]); sum += c; cnt += (c > 0u) ? 1u : 0u; mine = (j == x) ? c : mine; }
        if (sum == G) break;
        __builtin_amdgcn_s_sleep(1);
        if ((++sp & 255u) == 0u) { if (xb_ld(&bar[XB_TMO])) break; if (sp > XB_SPIN_CAP) { atomicAdd(&bar[XB_TMO], 1u); break; } }
    }
    nloc = mine > 0u ? mine : 1u; nx = cnt > 0u ? cnt : 1u;
}

__device__ __forceinline__ void xcd_barrier(const XcdBarrier& b) {
    asm volatile("s_waitcnt vmcnt(0)" ::: "memory");
    __syncthreads();
    if (threadIdx.x == 0) {
        unsigned* bar = b.bar;
        __builtin_amdgcn_s_waitcnt(0);
        unsigned nloc = b.st[0], nx = b.st[1];
        if (nloc == 0u) { xcd_barrier_complete(bar, b.x, nloc, nx); b.st[0] = nloc; b.st[1] = nx; }
        const unsigned old = xb_add(&bar[XB_XSUB(b.x)], 1u);
        const unsigned gen = old / nloc;
        if (old + 1u == (gen + 1u) * nloc) {
            __builtin_amdgcn_fence(__ATOMIC_RELEASE, "agent");
            asm volatile("s_waitcnt vmcnt(0)" ::: "memory");
            const unsigned og = xb_add(&bar[XB_TOP], 1u);
            const unsigned tg = og / nx;
            if (og + 1u == (tg + 1u) * nx) xb_add(&bar[XB_TOPGEN], 1u);
            else XB_SPIN(xb_ld(&bar[XB_TOPGEN]) == tg, bar);
            __builtin_amdgcn_fence(__ATOMIC_ACQUIRE, "agent");
            xb_add(&bar[XB_XGEN(b.x)], 1u);
            asm volatile("s_waitcnt vmcnt(0)" ::: "memory");
        } else {
            XB_SPIN(xb_ld(&bar[XB_XGEN(b.x)]) == gen, bar);
            __builtin_amdgcn_fence(__ATOMIC_ACQUIRE, "agent");
            asm volatile("s_waitcnt vmcnt(0)" ::: "memory");
        }
    }
    __syncthreads();
}
struct FSwiglu {
    bf16* H;
    DI void operator()(int row, int col, f32x4 lo, f32x4 hi) const {
        f32x4 r;
#pragma unroll
        for (int e = 0; e < 4; ++e) r[e] = silu_f(lo[e]) * hi[e];
        *(u32x2*)(H + (size_t)row * DFF + ((col >> 5) << 4) + (col & 15)) = pk4(r);
    }
};
struct FResid {
    const float* X; float* Z; long zrow_off; float s; int atomic, add_x;
    DI void operator()(int row, int col, f32x4 lo, f32x4 hi) const {
        const float* xp = X + (size_t)row * DM + col;
        float* zp = Z + ((long)row - zrow_off) * DM + col;
        f32x4 a = lo * s, b = hi * s;
        if (add_x) { a += *(const f32x4*)xp * DN_ALPHA; b += *(const f32x4*)(xp + 16) * DN_ALPHA; }
        if (atomic) {
#pragma unroll
            for (int e = 0; e < 4; ++e) { atomicAdd(zp + e, a[e]); atomicAdd(zp + 16 + e, b[e]); }
        } else { *(f32x4*)zp = a; *(f32x4*)(zp + 16) = b; }
    }
};
struct FBf16 {
    bf16* P; int ld;
    DI void operator()(int row, int col, f32x4 lo, f32x4 hi) const {
        bf16* p = P + (size_t)row * ld + col;
        *(u32x2*)p = pk4(lo); *(u32x2*)(p + 16) = pk4(hi);
    }
};
struct FF32 {
    float* P; int ld, row_off, col_off;
    DI void operator()(int row, int col, f32x4 lo, f32x4 hi) const {
        float* p = P + (size_t)(row - row_off) * ld + (col - col_off);
        *(f32x4*)p = lo; *(f32x4*)(p + 16) = hi;
    }
};
struct FQkv {
    bf16* QKV; float* QKVS; const float* rope; float* out; int j;
    DI void operator()(int row, int col, f32x4 lo, f32x4 hi) const {
        const int s = col / 3072, rem = col - s * 3072, g = rem >> 10, hh = (rem >> 7) & 7, d = rem & 127;
        const bool smp = row >= MP;
        const int pidx = smp ? TP + ((row - MP) & 3) : (row & (TP - 1));
        if (s < 2 && d < 16) {
            const f32x4 c = *(const f32x4*)(rope + (size_t)pidx * 32 + d), sn = *(const f32x4*)(rope + (size_t)pidx * 32 + 16 + d);
            const f32x4 x1 = lo, x2 = hi;
            lo = x1 * c - x2 * sn; hi = x2 * c + x1 * sn;
        }
        const int keep = 128 << (2 * g);
        if (!smp) {
            bf16* p = QKV + (size_t)row * AQKV + col;
            *(u32x2*)p = pk4(lo); *(u32x2*)(p + 16) = pk4(hi);
            if (s >= 1) {
                const int t = row & (TP - 1), b = row >> 12;
                if (t >= TP - keep) {
                    float* dst = out + (g == 0 ? O_A128P : g == 1 ? O_A512P : O_A2048P) + ((((size_t)(j * NBP + b) * keep + (t - (TP - keep))) * 2 + (s - 1)) * 8 + hh) * 128 + d;
                    *(f32x4*)dst = lo; *(f32x4*)(dst + 16) = hi;
                }
            }
        } else {
            const int r = row - MP, b = r >> 2, t = r & 3;
            float* p = QKVS + (size_t)r * AQKV + col;
            *(f32x4*)p = lo; *(f32x4*)(p + 16) = hi;
            if (s >= 1) {
                float* dst = out + (g == 0 ? O_A128S : g == 1 ? O_A512S : O_A2048S) + ((((size_t)(j * 8 + b) * keep + (keep - 4 + t)) * 2 + (s - 1)) * 8 + hh) * 128 + d;
                *(f32x4*)dst = lo; *(f32x4*)(dst + 16) = hi;
            }
        }
    }
};
template <class F> struct EpiWrap {
    static constexpr bool PERM = false, AFTER_DRAIN = false;
    F f;
    DI void operator()(const pg8::f32x4 (&acc)[2][2][4][2], const pg8::Unit& u, int wr, int wc, int fr, int fq) const {
#pragma unroll
        for (int ai = 0; ai < 2; ++ai)
#pragma unroll
            for (int m = 0; m < 4; ++m) {
                const int row = u.pm * 256 + ai * 128 + wr * 64 + m * 16 + fr;
#pragma unroll
                for (int bj = 0; bj < 2; ++bj) f(row, u.pn * 256 + bj * 128 + wc * 32 + 4 * fq, acc[ai][bj][m][0], acc[ai][bj][m][1]);
            }
    }
};

template <int NF, class F>
DI void skinny_unit(const Frame& Fr, const bf16* A, int lda, int row0, const bf16* Wt, int K, int f0, int kbeg, int klen, const F& f) {
    const int lane = Fr.lane, w = Fr.wave, r = lane & 31, h = lane >> 5;
    const int kw = klen >> 3, k0 = kbeg + w * kw;
    f32x16 acc[NF];
#pragma unroll
    for (int nf = 0; nf < NF; ++nf)
#pragma unroll
        for (int i = 0; i < 16; ++i) acc[nf][i] = 0.f;
    const bf16* ap = A + (size_t)(row0 + r) * lda + k0 + 8 * h;
    const bf16* wp = Wt + (size_t)(f0 + r) * K + k0 + 8 * h;
#pragma unroll 4
    for (int k = 0; k < kw; k += 16) {
        const bf16x8 b = *(const bf16x8*)(ap + k);
#pragma unroll
        for (int nf = 0; nf < NF; ++nf) {
            const bf16x8 a = *(const bf16x8*)(wp + (size_t)nf * 32 * K + k);
            acc[nf] = __builtin_amdgcn_mfma_f32_32x32x16_bf16(a, b, acc[nf], 0, 0, 0);
        }
    }
    LAS float* red = (LAS float*)Fr.lds;
#pragma unroll
    for (int nf = 0; nf < NF; ++nf)
#pragma unroll
        for (int i = 0; i < 16; ++i) red[((w * NF + nf) * 16 + i) * 64 + lane] = acc[nf][i];
    __syncthreads();
    if (w < 2 * NF) {
        const int nf = w >> 1, g = w & 1;
        f32x4 lo = {0.f, 0.f, 0.f, 0.f}, hi = {0.f, 0.f, 0.f, 0.f};
#pragma unroll
        for (int ww = 0; ww < 8; ++ww)
#pragma unroll
            for (int e = 0; e < 4; ++e) {
                lo[e] += red[((ww * NF + nf) * 16 + 4 * g + e) * 64 + lane];
                hi[e] += red[((ww * NF + nf) * 16 + 4 * g + 8 + e) * 64 + lane];
            }
        f(row0 + r, f0 + 32 * nf + 8 * g + 4 * h, lo, hi);
    }
    __syncthreads();
}
#define MFMA32(a, b, c) __builtin_amdgcn_mfma_f32_32x32x16_bf16((a), (b), (c), 0, 0, 0)
DI s16x4 lds_tr(LAS const uchar* p) { return __builtin_amdgcn_ds_read_tr16_b64_v4i16((LAS s16x4*)p); }
DI bf16x8 frag_xk(LAS const uchar* base, int ld, int x0, int k0, int lane) {
    return *(LAS const bf16x8*)(base + (x0 + (lane & 31)) * ld + (k0 + 8 * (lane >> 5)) * 2);
}
DI bf16x8 frag_kx(LAS const uchar* base, int ld, int x0, int k0, int lane) {
    const int h = lane >> 5, blk = (lane >> 4) & 1, q = (lane & 15) >> 2, p = lane & 3;
    LAS const uchar* a = base + (k0 + 8 * h + q) * ld + (x0 + 16 * blk + 4 * p) * 2;
    const s16x4 lo = lds_tr(a), hi = lds_tr(a + 4 * ld);
    return __builtin_shufflevector(lo, hi, 0, 1, 2, 3, 4, 5, 6, 7);
}
DI bf16x8 frag_kx_perm(LAS const uchar* base, int ld, int x0, int k0, int lane) {
    const int h = lane >> 5, blk = (lane >> 4) & 1, q = (lane & 15) >> 2, p = lane & 3;
    LAS const uchar* a = base + (k0 + 4 * h + q) * ld + (x0 + 16 * blk + 4 * p) * 2;
    const s16x4 lo = lds_tr(a), hi = lds_tr(a + 8 * ld);
    return __builtin_shufflevector(lo, hi, 0, 1, 2, 3, 4, 5, 6, 7);
}
DI bf16x8 pack_step(const f32x16& x, int s) {
    u32x4 p;
    p.x = pk2(x[8 * s + 0], x[8 * s + 1]); p.y = pk2(x[8 * s + 2], x[8 * s + 3]); p.z = pk2(x[8 * s + 4], x[8 * s + 5]); p.w = pk2(x[8 * s + 6], x[8 * s + 7]);
    return __builtin_bit_cast(bf16x8, p);
}
DI f32x16 zero16() { f32x16 z;
#pragma unroll
    for (int i = 0; i < 16; ++i) z[i] = 0.f; return z; }
template <bool A_KX, bool B_KX>
DI f32x16 mm_tile(f32x16 acc, LAS const uchar* A, int lda, int am0, LAS const uchar* B, int ldb, int bn0, int ksteps, int lane) {
#pragma unroll 1
    for (int s = 0; s < ksteps; ++s) {
        const bf16x8 a = A_KX ? frag_kx(A, lda, am0, 16 * s, lane) : frag_xk(A, lda, am0, 16 * s, lane);
        const bf16x8 b = B_KX ? frag_kx(B, ldb, bn0, 16 * s, lane) : frag_xk(B, ldb, bn0, 16 * s, lane);
        acc = MFMA32(a, b, acc);
    }
    return acc;
}

DI void tr_item(const WDesc& d, int item, LAS float* scr, int lane) {
    const int nnt = d.N >> 6, kt = item / nnt, nt = item - kt * nnt, k0 = kt << 6, n0 = nt << 6;
    const float* src = d.src + (size_t)k0 * d.N + n0 + 4 * (lane & 15);
#pragma unroll 8
    for (int i = 0; i < 16; ++i) {
        const int kk = 4 * i + (lane >> 4);
        const f32x4 v = *(const f32x4*)(src + (size_t)kk * d.N);
        LAS float* s = scr + kk * 65 + 4 * (lane & 15);
        s[0] = v[0]; s[1] = v[1]; s[2] = v[2]; s[3] = v[3];
    }
    asm volatile("s_waitcnt lgkmcnt(0)" ::: "memory");
    const int c = lane & 7;
#pragma unroll
    for (int j = 0; j < 8; ++j) {
        const int n = (lane >> 3) + 8 * j;
        LAS const float* s = scr + (8 * c) * 65 + n;
        u32x4 o; o.x = pk2(s[0], s[65]); o.y = pk2(s[2 * 65], s[3 * 65]); o.z = pk2(s[4 * 65], s[5 * 65]); o.w = pk2(s[6 * 65], s[7 * 65]);
        const int ns = n0 + n;
        int drow = ns;
        if (d.mode == 1) { const int jj = ns < DFF ? ns : ns - DFF; drow = ((jj >> 4) << 5) + (ns < DFF ? 0 : 16) + (jj & 15); }
        *(u32x4*)(d.dst + (size_t)drow * d.K + k0 + 8 * c) = o;
    }
    asm volatile("s_waitcnt lgkmcnt(0)" ::: "memory");
}
DI void prologue(const Frame& F, const Args& a) {
    uchar* ws = a.ws;
    LAS float* scr = (LAS float*)(F.lds + F.wave * 16640);
    for (int it = F.gw; it < a.nitems; it += F.NGW) {
        int m = 0;
#pragma unroll 1
        for (int q = 1; q < NWD; ++q) if (it >= a.wd[q].item0) m = q;
        tr_item(a.wd[m], it - a.wd[m].item0, scr, F.lane);
    }
    const int gt = F.gw * 64 + F.lane, NT = F.NGW * 64;
    {
        float* rope = (float*)(ws + WS_ROPE);
        for (int i = gt; i < 4100 * 16; i += NT) {
            const int pidx = i >> 4, f = i & 15;
            const int pos = pidx < TP ? pidx : PASTLEN + (pidx - TP);
            const float inv = exp2f(-(float)f * (18.931568569324174f / 16.f));
            const float ang = (float)pos * inv;
            const double rev = (double)ang * 0.15915494309189535;
            const float fr = (float)(rev - floor(rev));
            rope[(size_t)pidx * 32 + f] = __builtin_amdgcn_cosf(fr);
            rope[(size_t)pidx * 32 + 16 + f] = __builtin_amdgcn_sinf(fr);
        }
    }
    { f32x4* z = (f32x4*)(ws + WS_ZS); const f32x4 zz = {0.f, 0.f, 0.f, 0.f}; for (int i = gt; i < (int)(12 * ZS_ONE / 16); i += NT) z[i] = zz; }
    {
        float* X = a.out; bf16* XB = (bf16*)(ws + WS_XB);
        for (int i = gt; i < MALL * DM / 4; i += NT) {
            const size_t e = (size_t)i * 4;
            const f32x4 v = e < (size_t)MP * DM ? *(const f32x4*)(a.in[0] + e) : *(const f32x4*)(a.in[1] + (e - (size_t)MP * DM));
            *(f32x4*)(X + e) = v; *(u32x2*)(XB + e) = pk4(v);
        }
    }
    {
        const size_t outs_off[3] = {O_A128S, O_A512S, O_A2048S};
#pragma unroll
        for (int g = 0; g < 3; ++g) {
            const int wb = 128 << (2 * g);
            const int per = (wb - 4) * 2048 / 4, tot = 16 * per;
            const float* src = a.in[2 + g]; float* dst = a.out + outs_off[g];
            for (int i = gt; i < tot; i += NT) {
                const int blk = i / per, o = i - blk * per;
                const size_t base = (size_t)blk * wb * 2048;
                *(f32x4*)(dst + base + (size_t)o * 4) = *(const f32x4*)(src + base + 8192 + (size_t)o * 4);
            }
        }
    }
}

DI void ln_phase(const Frame& F, const float* Zp, const float* Zs, const float* g, const float* b, float* X, bf16* XB) {
    f32x4 gv[8], bv[8];
#pragma unroll
    for (int j = 0; j < 8; ++j) { gv[j] = *(const f32x4*)(g + 4 * F.lane + 256 * j); bv[j] = *(const f32x4*)(b + 4 * F.lane + 256 * j); }
    for (int row = F.gw; row < MALL; row += F.NGW) {
        const float* z = row < MP ? Zp + (size_t)row * DM : Zs + (size_t)(row - MP) * DM;
        f32x4 v[8]; float s = 0.f;
#pragma unroll
        for (int j = 0; j < 8; ++j) { v[j] = *(const f32x4*)(z + 4 * F.lane + 256 * j); s += (v[j][0] + v[j][1]) + (v[j][2] + v[j][3]); }
        const float mean = wave_sum(s) * (1.f / DM); float s2 = 0.f;
#pragma unroll
        for (int j = 0; j < 8; ++j) { v[j] = v[j] - mean; s2 += (v[j][0] * v[j][0] + v[j][1] * v[j][1]) + (v[j][2] * v[j][2] + v[j][3] * v[j][3]); }
        const float rstd = 1.f / sqrtf(wave_sum(s2) * (1.f / DM) + LN_EPS);
        float* xo = X + (size_t)row * DM + 4 * F.lane; bf16* xb = XB + (size_t)row * DM + 4 * F.lane;
#pragma unroll
        for (int j = 0; j < 8; ++j) { const f32x4 y = v[j] * rstd * gv[j] + bv[j]; *(f32x4*)(xo + 256 * j) = y; *(u32x2*)(xb + 256 * j) = pk4(y); }
    }
}
DI void attn_prompt_unit(const Frame& F, int u, const bf16* QKV, bf16* OG, float* LSE, bf16* O) {
    const int b = u >> 6, hd = (u >> 3) & 7, ck = u & 7;
    const int lane = F.lane, w = F.wave, qi = lane & 31, h = lane >> 5;
    constexpr int LDV = 272;
    LAS uchar* Vl = F.lds + w * (32 * LDV);
    const float SC = 0.08838834764831845f * 1.4426950408889634f;
    for (int it = 0; it < 6; ++it) {
        const int tl = w + 8 * it, g = tl >> 4, idx = tl & 15;
        const int dil = 1 << (2 * g);
        int r, Lb;
        if (g == 0) { r = 0; Lb = ck * 512 + 32 * idx; } else if (g == 1) { r = idx & 3; Lb = ck * 128 + 32 * (idx >> 2); } else { r = idx; Lb = ck * 32; }
        const int rowb = b * TP;
        const int colQ = g * 1024 + hd * 128, colK = 3072 + colQ, colV = 6144 + colQ;
        bf16x8 qf[8];
        {
            const unsigned qo = (unsigned)(((rowb + r + dil * (Lb + qi)) * AQKV + colQ + 8 * h) * 2);
#pragma unroll
            for (int s = 0; s < 8; ++s) qf[s] = ldg<bf16x8>(QKV, qo + 32 * s);
        }
        f32x16 st[5];
#pragma unroll
        for (int kb = 0; kb < 5; ++kb) {
            int Lk = Lb - 128 + 32 * kb + qi; if (Lk < 0) Lk = 0;
            const unsigned ko = (unsigned)(((rowb + r + dil * Lk) * AQKV + colK + 8 * h) * 2);
            f32x16 acc = zero16();
#pragma unroll
            for (int s = 0; s < 8; ++s) { const bf16x8 kf = ldg<bf16x8>(QKV, ko + 32 * s); acc = MFMA32(kf, qf[s], acc); }
            st[kb] = acc;
        }
        float m = -INFINITY;
        {
            int lo = qi; if (128 - Lb > lo) lo = 128 - Lb;
            const int a0 = 4 * h - lo, b0 = 128 + qi - 4 * h;
#pragma unroll
            for (int kb = 0; kb < 5; ++kb)
#pragma unroll
                for (int i = 0; i < 16; ++i) {
                    const int cst = 32 * kb + (i & 3) + 8 * (i >> 2);
                    const unsigned msk = (unsigned)(((a0 + cst) | (b0 - cst)) >> 31);
                    const unsigned xb = __float_as_uint(st[kb][i] * SC);
                    const float sv = __uint_as_float((xb & ~msk) | (0xff800000u & msk));
                    st[kb][i] = sv; m = fmaxf(m, sv);
                }
        }
        m = fmaxf(m, __shfl_xor(m, 32));
        float l = 0.f;
#pragma unroll
        for (int kb = 0; kb < 5; ++kb)
#pragma unroll
            for (int i = 0; i < 16; ++i) { const float p = exp2f(st[kb][i] - m); st[kb][i] = p; l += p; }
        l += __shfl_xor(l, 32);
        f32x16 ot[4];
#pragma unroll
        for (int c = 0; c < 4; ++c) ot[c] = zero16();
#pragma unroll
        for (int kb = 0; kb < 5; ++kb) {
#pragma unroll
            for (int i = 0; i < 8; ++i) {
                const int cid = lane + 64 * i, key = cid >> 4, ch = cid & 15;
                int Lk = Lb - 128 + 32 * kb + key; if (Lk < 0) Lk = 0;
                const u32x4 v = ldg<u32x4>(QKV, (unsigned)(((rowb + r + dil * Lk) * AQKV + colV + 8 * ch) * 2));
                *(LAS u32x4*)(Vl + key * LDV + ch * 16) = v;
            }
#pragma unroll
            for (int s = 0; s < 2; ++s) {
                const bf16x8 pb = pack_step(st[kb], s);
#pragma unroll
                for (int c = 0; c < 4; ++c) { const bf16x8 af = frag_kx_perm(Vl, LDV, 32 * c, 16 * s, lane); ot[c] = MFMA32(af, pb, ot[c]); }
            }
        }
        const float rl = 1.f / l;
        const int orow = rowb + r + dil * (Lb + qi);
        const unsigned oo = (unsigned)((((g * MP + orow) * 1024) + hd * 128 + 4 * h) * 2);
#pragma unroll
        for (int c = 0; c < 4; ++c)
#pragma unroll
            for (int gq = 0; gq < 4; ++gq) {
                f32x4 v = {ot[c][4 * gq] * rl, ot[c][4 * gq + 1] * rl, ot[c][4 * gq + 2] * rl, ot[c][4 * gq + 3] * rl};
                stg<u32x2>(OG, oo + (32 * c + 8 * gq) * 2, pk4(v));
            }
        if (h == 0) stg<float>(LSE, (unsigned)(((g * MP + orow) * 8 + hd) * 4), (m + log2f(l)) * 0.6931471805599453f);
    }
    asm volatile("s_waitcnt vmcnt(0)" ::: "memory");
    __syncthreads();
    __builtin_amdgcn_fence(__ATOMIC_ACQUIRE, "agent");
    const int l16 = F.tid & 15;
#pragma unroll 2
    for (int it = 0; it < 16; ++it) {
        const int tok = ck * 512 + (F.tid >> 4) + 32 * it;
        const int row = b * TP + tok;
        const float l0 = ldg<float>(LSE, (unsigned)((row * 8 + hd) * 4)), l1 = ldg<float>(LSE, (unsigned)(((MP + row) * 8 + hd) * 4)), l2 = ldg<float>(LSE, (unsigned)(((2 * MP + row) * 8 + hd) * 4));
        const float mx = fmaxf(l0, fmaxf(l1, l2));
        float w0 = __expf(l0 - mx), w1 = __expf(l1 - mx), w2 = __expf(l2 - mx);
        const float ws = 1.f / (w0 + w1 + w2); w0 *= ws; w1 *= ws; w2 *= ws;
        const unsigned off = (unsigned)((row * 1024 + hd * 128 + 8 * l16) * 2);
        const u32x4 a0 = ldg<u32x4>(OG, off), a1 = ldg<u32x4>(OG, off + MP * 1024 * 2), a2 = ldg<u32x4>(OG, off + 2 * MP * 1024 * 2);
        u32x4 o;
#pragma unroll
        for (int e = 0; e < 4; ++e)
            o[e] = pk2(w0 * bflo(a0[e]) + w1 * bflo(a1[e]) + w2 * bflo(a2[e]), w0 * bfhi(a0[e]) + w1 * bfhi(a1[e]) + w2 * bfhi(a2[e]));
        stg<u32x4>(O, off, o);
    }
    __syncthreads();
}

DI void attn_sample_unit(const Frame& F, int su, const float* QKVS, const float* cache0, const float* cache1, const float* cache2, int j, bf16* O) {
    const int b = su >> 5, hd = (su >> 2) & 7, t = su & 3;
    const int lane = F.lane, w = F.wave, l32 = lane & 31, hw = lane >> 5;
    LAS float* sc = (LAS float*)F.lds;
    LAS float* part = (LAS float*)(F.lds + 4096);
    if (w < 6) {
        const int g = w >> 1, half = w & 1, dil = 1 << (2 * g), wb = 128 << (2 * g);
        const int j0 = half * 65, cnt = half ? 64 : 65;
        const float* cg = (g == 0 ? cache0 : g == 1 ? cache1 : cache2) + ((size_t)(j * 8 + b) * wb) * 2048 + hd * 128 + 4 * l32;
        const float* qn = QKVS + (size_t)(b * 4) * AQKV + g * 1024 + hd * 128 + 4 * l32;
        const f32x4 q4 = *(const f32x4*)(qn + (size_t)t * AQKV);
#pragma unroll 4
        for (int it = 0; it < 33; ++it) {
            const int jl = 2 * it + hw;
            float s = 0.f;
            if (jl < cnt) {
                const int idx = wb + t - dil * (j0 + jl);
                const float* kp = idx >= wb ? qn + (size_t)(idx - wb) * AQKV + 3072 : cg + (size_t)idx * 2048;
                const f32x4 k4 = *(const f32x4*)kp;
                s = q4[0] * k4[0] + q4[1] * k4[1] + q4[2] * k4[2] + q4[3] * k4[3];
            }
#pragma unroll
            for (int o = 1; o < 32; o <<= 1) s += __shfl_xor(s, o);
            if (l32 == 0 && jl < cnt) sc[w * 80 + jl] = s * 0.08838834764831845f;
        }
        asm volatile("s_waitcnt lgkmcnt(0)" ::: "memory");
        float m = lane < cnt ? sc[w * 80 + lane] : -INFINITY;
        if (lane == 0 && cnt == 65) m = fmaxf(m, sc[w * 80 + 64]);
        m = wave_max(m);
        float lsum = 0.f; f32x4 acc = {0.f, 0.f, 0.f, 0.f};
#pragma unroll 4
        for (int it = 0; it < 33; ++it) {
            const int jl = 2 * it + hw;
            if (jl < cnt) {
                const int idx = wb + t - dil * (j0 + jl);
                const float* vp = idx >= wb ? qn + (size_t)(idx - wb) * AQKV + 6144 : cg + (size_t)idx * 2048 + 1024;
                const f32x4 v4 = *(const f32x4*)vp;
                const float p = __expf(sc[w * 80 + jl] - m);
                lsum += p; acc += v4 * p;
            }
        }
        lsum += __shfl_xor(lsum, 32);
#pragma unroll
        for (int e = 0; e < 4; ++e) acc[e] += __shfl_xor(acc[e], 32);
        if (lane == 0) { part[w * 136] = m; part[w * 136 + 1] = lsum; }
        if (lane < 32) *(LAS f32x4*)(part + w * 136 + 8 + 4 * l32) = acc;
    }
    __syncthreads();
    if (w == 0 && lane < 32) {
        float M = -INFINITY;
#pragma unroll
        for (int ww = 0; ww < 6; ++ww) M = fmaxf(M, part[ww * 136]);
        float L = 0.f; f32x4 o = {0.f, 0.f, 0.f, 0.f};
#pragma unroll
        for (int ww = 0; ww < 6; ++ww) { const float e = __expf(part[ww * 136] - M); L += part[ww * 136 + 1] * e; o += *(LAS const f32x4*)(part + ww * 136 + 8 + 4 * l32) * e; }
        o = o * (1.f / L);
        *(u32x2*)(O + (size_t)(MP + b * 4 + t) * 1024 + hd * 128 + 4 * l32) = pk4(o);
    }
    __syncthreads();
}
struct BPtrs {
    const bf16* PB; const float* EB; const float* PBS; bf16 *WG, *UG, *QG, *KG, *QKG; float* GCG; bf16* YB;
    const float *conv_w, *a_log, *dt_bias, *norm_w, *ssm0, *conv0;
    float *ssm_p, *ssm_s, *conv_p, *conv_s;
};
DI void bprep_unit(const Frame& F, int pu, const BPtrs& P) {
    const int b = pu >> 10, n = (pu >> 4) & 63, hq = pu & 15;
    int lane = F.lane, tid = F.tid; asm volatile("" : "+v"(lane), "+v"(tid));
    const int w = F.wave, t0 = n * 64;
    constexpr int LD = 272, LDT = 144;
    LAS uchar* Kl = F.lds; LAS uchar* V0l = F.lds + 17408; LAS uchar* V1l = F.lds + 34816; LAS uchar* Ql = F.lds + 52224;
    LAS float* Gkk = (LAS float*)(F.lds + 69632); LAS float* Gqk = (LAS float*)(F.lds + 86016);
    LAS float* LT = (LAS float*)(F.lds + 102400);
    LAS uchar* Tb = F.lds + 52224;
    LAS float* betaL = (LAS float*)(F.lds + 135168); LAS float* gcL = betaL + 128; LAS float* egL = gcL + 128;
    for (int it = 0; it < 8; ++it) {
        const int task = w + 8 * it, mt = task >> 4, rg = task & 15;
        const int i = 4 * rg + (lane >> 4), ch = lane & 15, t = t0 + i;
        const int cb = mt == 0 ? hq * 128 : mt == 1 ? 2048 + hq * 128 : 4096 + (2 * hq + (mt - 2)) * 128;
        const int col = cb + 8 * ch;
        float y[8];
#pragma unroll
        for (int e = 0; e < 8; ++e) y[e] = 0.f;
#pragma unroll
        for (int jj = 0; jj < 4; ++jj) {
            const int tt = t - 3 + jj;
            u32x4 x = {0u, 0u, 0u, 0u};
            if (tt >= 0) x = ldg<u32x4>(P.PB, (unsigned)(((b * TP + tt) * BINM + col) * 2));
            const f32x4 w0 = ldg<f32x4>(P.conv_w, (unsigned)((jj * 8192 + col) * 4)), w1 = ldg<f32x4>(P.conv_w, (unsigned)((jj * 8192 + col + 4) * 4));
            y[0] += bflo(x[0]) * w0[0]; y[1] += bfhi(x[0]) * w0[1]; y[2] += bflo(x[1]) * w0[2]; y[3] += bfhi(x[1]) * w0[3];
            y[4] += bflo(x[2]) * w1[0]; y[5] += bfhi(x[2]) * w1[1]; y[6] += bflo(x[3]) * w1[2]; y[7] += bfhi(x[3]) * w1[3];
        }
        float ss = 0.f;
#pragma unroll
        for (int e = 0; e < 8; ++e) { y[e] = silu_f(y[e]); ss += y[e] * y[e]; }
        if (mt < 2) {
#pragma unroll
            for (int o = 1; o < 16; o <<= 1) ss += __shfl_xor(ss, o);
            const float rn = rsqrtf(ss + 1e-6f) * (mt == 0 ? 0.08838834764831845f : 1.f);
#pragma unroll
            for (int e = 0; e < 8; ++e) y[e] *= rn;
        }
        u32x4 o; o.x = pk2(y[0], y[1]); o.y = pk2(y[2], y[3]); o.z = pk2(y[4], y[5]); o.w = pk2(y[6], y[7]);
        LAS uchar* dst = mt == 0 ? Ql : mt == 1 ? Kl : mt == 2 ? V0l : V1l;
        *(LAS u32x4*)(dst + i * LD + ch * 16) = o;
        if (mt == 0) stg<u32x4>(P.QG, (unsigned)((((b * 16 + hq) * TP + t) * 128 + 8 * ch) * 2), o);
        if (mt == 1) stg<u32x4>(P.KG, (unsigned)((((b * 16 + hq) * TP + t) * 128 + 8 * ch) * 2), o);
    }
    __syncthreads();
    {
        const int which = w >> 2, ti = (w >> 1) & 1, tj = w & 1;
        f32x16 acc = mm_tile<false, false>(zero16(), which ? Ql : Kl, LD, 32 * ti, Kl, LD, 32 * tj, 8, lane);
        LAS float* G = which ? Gqk : Gkk;
#pragma unroll
        for (int i = 0; i < 16; ++i) G[(32 * ti + crow(i, lane >> 5)) * 64 + 32 * tj + (lane & 31)] = acc[i];
    }
    if (w < 2) {
        const int hv = 2 * hq + w, t = t0 + lane;
        const float braw = ldg<float>(P.EB, (unsigned)(((b * TP + t) * 64 + hv) * 4)), araw = ldg<float>(P.EB, (unsigned)(((b * TP + t) * 64 + 32 + hv) * 4));
        const float beta = sigmoid_f(braw);
        float gc = -__expf(P.a_log[hv]) * softplus_f(araw + P.dt_bias[hv]);
#pragma unroll
        for (int o = 1; o < 64; o <<= 1) { const float v = __shfl_up(gc, o); if (lane >= o) gc += v; }
        betaL[w * 64 + lane] = beta; gcL[w * 64 + lane] = gc; egL[w * 64 + lane] = __expf(gc);
        stg<float>(P.GCG, (unsigned)(((b * 32 + hv) * TP + t) * 4), gc);
    }
    __syncthreads();
#pragma unroll 1
    for (int hvl = 0; hvl < 2; ++hvl) {
        const int hv = 2 * hq + hvl;
        for (int idx = tid; idx < 4096; idx += 512) {
            const int r = idx >> 6, c = idx & 63;
            const float gj = gcL[hvl * 64 + c], gr = gcL[hvl * 64 + r];
            LT[(hvl * 64 + r) * 64 + c] = (c > r) ? betaL[hvl * 64 + c] * Gkk[c * 64 + r] * __expf(gj - gr) : 0.f;
            const float qv = (r >= c) ? Gqk[r * 64 + c] * __expf(gr - gj) : 0.f;
            stg<bf16>(P.QKG, (unsigned)((((((b * 32 + hv) * 64 + n) * 64 + r) * 64) + c) * 2), (bf16)(pk2(qv, 0.f) & 0xffffu));
        }
    }
    __syncthreads();
    asm volatile("" : "+v"(lane), "+v"(tid));
    if (w < 2) {
        float t[64];
#pragma unroll
        for (int c = 0; c < 64; ++c) t[c] = 0.f;
        unsigned lt_a = (unsigned)(size_t)(LT + w * 4096), be_a = (unsigned)(size_t)(betaL + w * 64), eg_a = (unsigned)(size_t)(egL + w * 64);
        asm volatile("" : "+v"(lt_a), "+v"(be_a), "+v"(eg_a));
        LAS const float* lt = (LAS const float*)(size_t)lt_a; LAS const float* bel = (LAS const float*)(size_t)be_a; LAS const float* egl = (LAS const float*)(size_t)eg_a;
#pragma unroll
        for (int c = 63; c >= 0; --c) {
            asm volatile("" ::: "memory");
            float acc = (lane == c) ? 1.f : 0.f;
#pragma unroll
            for (int jb = (c + 1) >> 2; jb < 16; ++jb) {
                const f32x4 l4 = *(LAS const f32x4*)(lt + c * 64 + 4 * jb);
                acc -= t[4 * jb] * l4[0]; acc -= t[4 * jb + 1] * l4[1]; acc -= t[4 * jb + 2] * l4[2]; acc -= t[4 * jb + 3] * l4[3];
            }
            asm volatile("" : "+v"(acc) :: "memory");
            t[c] = acc;
        }
        LAS uchar* tb0 = Tb + (w * 2 + 0) * (64 * LDT) + lane * LDT; LAS uchar* tb1 = Tb + (w * 2 + 1) * (64 * LDT) + lane * LDT;
#pragma unroll
        for (int q = 0; q < 8; ++q) {
            float a[8], c2[8];
            const f32x4 b0 = *(LAS const f32x4*)(bel + 8 * q), b1 = *(LAS const f32x4*)(bel + 8 * q + 4), e0 = *(LAS const f32x4*)(egl + 8 * q), e1 = *(LAS const f32x4*)(egl + 8 * q + 4);
#pragma unroll
            for (int e = 0; e < 4; ++e) { a[e] = t[8 * q + e] * b0[e]; c2[e] = a[e] * e0[e]; a[4 + e] = t[8 * q + 4 + e] * b1[e]; c2[4 + e] = a[4 + e] * e1[e]; }
            u32x4 o0, o1; o0.x = pk2(a[0], a[1]); o0.y = pk2(a[2], a[3]); o0.z = pk2(a[4], a[5]); o0.w = pk2(a[6], a[7]);
            o1.x = pk2(c2[0], c2[1]); o1.y = pk2(c2[2], c2[3]); o1.z = pk2(c2[4], c2[5]); o1.w = pk2(c2[6], c2[7]);
            *(LAS u32x4*)(tb0 + 16 * q) = o0; *(LAS u32x4*)(tb1 + 16 * q) = o1;
        }
    }
    __syncthreads();
    asm volatile("" : "+v"(lane), "+v"(tid));
    {
        const int hvl = w >> 2, hv = 2 * hq + hvl;
#pragma unroll 1
        for (int tt = 0; tt < 4; ++tt) {
            const int id = (w & 3) * 4 + tt, which = id >> 3, ti = (id >> 2) & 1, c = id & 3;
            f32x16 acc = mm_tile<false, true>(zero16(), Tb + (hvl * 2 + which) * (64 * LDT), LDT, 32 * ti, which ? Kl : (hvl ? V1l : V0l), LD, 32 * c, 4, lane);
            bf16* dstb = which ? P.WG : P.UG;
            const unsigned dof = (unsigned)(((((b * 32 + hv) * TP + t0 + 32 * ti + 4 * (lane >> 5)) * 128) + 32 * c + (lane & 31)) * 2);
#pragma unroll
            for (int i = 0; i < 16; ++i) stg<bf16>(dstb, dof + ((i & 3) + 8 * (i >> 2)) * 256, (bf16)(pk2(acc[i], 0.f) & 0xffffu));
        }
    }
    __syncthreads();
}
DI void bchain_unit(const Frame& F, int cu, const BPtrs& P) {
    const int b = cu >> 5, hv = cu & 31, hq = hv >> 1;
    const int lane = F.lane, w = F.wave, tid = F.tid, h = lane >> 5, l32 = lane & 31;
    constexpr int LD = 272, LDQ = 144, LDO = 528;
    LAS uchar* Wl = F.lds; LAS uchar* Ql = F.lds + 17408; LAS uchar* Kl = F.lds + 34816; LAS uchar* QKl = F.lds + 52224;
    LAS uchar* Sb = F.lds + 61440; LAS uchar* VNl = F.lds + 96256; LAS uchar* VNd = F.lds + 113664;
    LAS float* gcL = (LAS float*)(F.lds + 131072); LAS float* egL = gcL + 64;
    LAS uchar* Ol = F.lds;
    const bf16* wg = P.WG + ((size_t)b * 32 + hv) * TP * 128; const bf16* ug = P.UG + ((size_t)b * 32 + hv) * TP * 128;
    const bf16* qg = P.QG + ((size_t)b * 16 + hq) * TP * 128; const bf16* kg = P.KG + ((size_t)b * 16 + hq) * TP * 128;
    const bf16* qkg = P.QKG + ((size_t)b * 32 + hv) * 64 * 4096; const float* gcg = P.GCG + ((size_t)b * 32 + hv) * TP;
    const int kb = w & 3, c0 = 2 * (w >> 2);
    f32x16 S0 = zero16(), S1 = zero16();
    for (int i = tid; i < 128 * LD / 4; i += 512) ((LAS unsigned*)Sb)[i] = 0u;
    const int ti = w >> 2, tc = w & 3;
#pragma unroll 1
    for (int n = 0; n < 64; ++n) {
        const int t0 = n * 64;
        {
            const char* wgn = (const char*)(wg + (size_t)t0 * 128); const char* qgn = (const char*)(qg + (size_t)t0 * 128); const char* kgn = (const char*)(kg + (size_t)t0 * 128);
#pragma unroll
            for (int k = 0; k < 2; ++k) {
                const int cid = tid + 512 * k, r = cid >> 4, ch = cid & 15; const unsigned go = (unsigned)(cid * 16);
                *(LAS u32x4*)(Wl + r * LD + ch * 16) = *(const u32x4*)(wgn + go);
                *(LAS u32x4*)(Ql + r * LD + ch * 16) = *(const u32x4*)(qgn + go);
                *(LAS u32x4*)(Kl + r * LD + ch * 16) = *(const u32x4*)(kgn + go);
            }
            { const int r = tid >> 3, ch = tid & 7; *(LAS u32x4*)(QKl + r * LDQ + ch * 16) = *(const u32x4*)((const char*)(qkg + (size_t)n * 4096) + (unsigned)(tid * 16)); }
        }
        if (tid < 64) { const float g = gcg[t0 + tid]; gcL[tid] = g; egL[tid] = __expf(g); }
        __syncthreads();
        const float glast = gcL[63];
        f32x16 vn = mm_tile<false, true>(zero16(), Wl, LD, 32 * ti, Sb, LD, 32 * tc, 8, lane);
        {
            const char* upb = (const char*)(ug + (size_t)(t0 + 32 * ti) * 128 + 32 * tc);
            const unsigned uo = (unsigned)((4 * h * 128 + l32) * 2);
#pragma unroll
            for (int i = 0; i < 16; ++i) {
                const int r = crow(i, h);
                const float v = bf2f(*(const bf16*)(upb + uo + (unsigned)(((i & 3) + 8 * (i >> 2)) * 256))) - vn[i];
                const float vd = v * __expf(glast - gcL[32 * ti + r]);
                *(LAS bf16*)(VNl + (32 * ti + r) * LD + (32 * tc + l32) * 2) = (bf16)(pk2(v, 0.f) & 0xffffu);
                *(LAS bf16*)(VNd + (32 * ti + r) * LD + (32 * tc + l32) * 2) = (bf16)(pk2(vd, 0.f) & 0xffffu);
            }
        }
        __syncthreads();
        f32x16 o = mm_tile<false, true>(zero16(), Ql, LD, 32 * ti, Sb, LD, 32 * tc, 8, lane);
#pragma unroll
        for (int i = 0; i < 16; ++i) o[i] *= egL[32 * ti + crow(i, h)];
        o = mm_tile<false, true>(o, QKl, LDQ, 32 * ti, VNl, LD, 32 * tc, 4, lane);
        {
            const float el = __expf(glast);
#pragma unroll
            for (int i = 0; i < 16; ++i) { S0[i] *= el; S1[i] *= el; }
            S0 = mm_tile<true, true>(S0, Kl, LD, 32 * kb, VNd, LD, 32 * c0, 4, lane);
            S1 = mm_tile<true, true>(S1, Kl, LD, 32 * kb, VNd, LD, 32 * (c0 + 1), 4, lane);
        }
        __syncthreads();
#pragma unroll
        for (int i = 0; i < 16; ++i) {
            const int r = 32 * kb + crow(i, h);
            *(LAS bf16*)(Sb + r * LD + (32 * c0 + l32) * 2) = (bf16)(pk2(S0[i], 0.f) & 0xffffu);
            *(LAS bf16*)(Sb + r * LD + (32 * (c0 + 1) + l32) * 2) = (bf16)(pk2(S1[i], 0.f) & 0xffffu);
            *(LAS float*)(Ol + (32 * ti + crow(i, h)) * LDO + (32 * tc + l32) * 4) = o[i];
        }
        __syncthreads();
        {
            const int r = tid >> 3, part = tid & 7;
            float ov[16]; float ss = 0.f;
#pragma unroll
            for (int q = 0; q < 4; ++q) { const f32x4 v = *(LAS const f32x4*)(Ol + r * LDO + (16 * part + 4 * q) * 4); ov[4 * q] = v[0]; ov[4 * q + 1] = v[1]; ov[4 * q + 2] = v[2]; ov[4 * q + 3] = v[3]; }
#pragma unroll
            for (int e = 0; e < 16; ++e) ss += ov[e] * ov[e];
            ss += __shfl_xor(ss, 1); ss += __shfl_xor(ss, 2); ss += __shfl_xor(ss, 4);
            const float rstd = rsqrtf(ss * (1.f / 128.f) + RMS_EPS);
            const char* zp = (const char*)(P.PB + ((size_t)b * TP + t0) * BINM + 8192 + hv * 128) + (unsigned)((r * BINM + 16 * part) * 2);
            const u32x4 z0 = *(const u32x4*)zp, z1 = *(const u32x4*)(zp + 16);
            const float* nw = P.norm_w + 16 * part;
            u32x4 y0, y1;
#pragma unroll
            for (int e = 0; e < 4; ++e) {
                y0[e] = pk2(ov[2 * e] * rstd * nw[2 * e] * silu_f(bflo(z0[e])), ov[2 * e + 1] * rstd * nw[2 * e + 1] * silu_f(bfhi(z0[e])));
                y1[e] = pk2(ov[8 + 2 * e] * rstd * nw[8 + 2 * e] * silu_f(bflo(z1[e])), ov[8 + 2 * e + 1] * rstd * nw[8 + 2 * e + 1] * silu_f(bfhi(z1[e])));
            }
            char* yp = (char*)(P.YB + ((size_t)b * TP + t0) * 4096 + hv * 128) + (unsigned)((r * 4096 + 16 * part) * 2);
            *(u32x4*)yp = y0; *(u32x4*)(yp + 16) = y1;
        }
        __syncthreads();
    }
    {
        float* sp = P.ssm_p + ((size_t)b * 32 + hv) * 16384;
#pragma unroll
        for (int i = 0; i < 16; ++i) {
            const int r = 32 * kb + crow(i, h);
            sp[r * 128 + 32 * c0 + l32] = S0[i]; sp[r * 128 + 32 * (c0 + 1) + l32] = S1[i];
        }
    }
    __syncthreads();
}

DI void bsample_unit(const Frame& F, int su, const BPtrs& P) {
    const int b = su >> 5, hv = su & 31, hq = hv >> 1;
    const int tid = F.tid, lane = F.lane, w = F.wave, dv = tid & 127, qd = tid >> 7;
    LAS float* raw = (LAS float*)F.lds;
    LAS float* qv = raw + 1536; LAS float* kv = qv + 512; LAS float* vv = kv + 512;
    LAS float* part = vv + 512;
    LAS float* ov = part + 512;
    LAS float* scal = ov + 512;
    float s[32];
    {
        const float* s0 = P.ssm0 + ((size_t)b * 32 + hv) * 16384 + (32 * qd) * 128 + dv;
#pragma unroll
        for (int i = 0; i < 32; ++i) s[i] = s0[i * 128];
    }
    if (tid < 384) {
        const int which = tid >> 7, d = tid & 127;
        const int col = which == 0 ? hq * 128 + d : which == 1 ? 2048 + hq * 128 + d : 4096 + hv * 128 + d;
        float full[7];
#pragma unroll
        for (int r = 0; r < 3; ++r) full[r] = P.conv0[((size_t)b * 3 + r) * 8192 + col];
#pragma unroll
        for (int t = 0; t < 4; ++t) full[3 + t] = P.PBS[(size_t)(b * 4 + t) * BIN + col];
        const float w0 = P.conv_w[col], w1 = P.conv_w[8192 + col], w2 = P.conv_w[2 * 8192 + col], w3 = P.conv_w[3 * 8192 + col];
#pragma unroll
        for (int t = 0; t < 4; ++t) raw[(which * 4 + t) * 128 + d] = silu_f(full[t] * w0 + full[t + 1] * w1 + full[t + 2] * w2 + full[t + 3] * w3);
#pragma unroll
        for (int r = 0; r < 3; ++r) P.conv_s[((size_t)b * 3 + r) * 8192 + col] = full[4 + r];
    }
    if (tid < 4) {
        const float braw = P.PBS[(size_t)(b * 4 + tid) * BIN + 12288 + hv], araw = P.PBS[(size_t)(b * 4 + tid) * BIN + 12320 + hv];
        scal[tid] = sigmoid_f(braw); scal[4 + tid] = __expf(-__expf(P.a_log[hv]) * softplus_f(araw + P.dt_bias[hv]));
    }
    __syncthreads();
    {
        const int which = w >> 2, t = w & 3;
        const float a0 = raw[(which * 4 + t) * 128 + lane], a1 = raw[(which * 4 + t) * 128 + 64 + lane];
        const float rn = rsqrtf(wave_sum(a0 * a0 + a1 * a1) + 1e-6f) * (which == 0 ? 0.08838834764831845f : 1.f);
        LAS float* dst = which == 0 ? qv : kv;
        dst[t * 128 + lane] = a0 * rn; dst[t * 128 + 64 + lane] = a1 * rn;
        vv[tid] = raw[1024 + tid];
    }
    __syncthreads();
    for (int t = 0; t < 4; ++t) {
        const float beta = scal[t], eg = scal[4 + t];
        float p = 0.f;
#pragma unroll
        for (int i = 0; i < 32; ++i) p += kv[t * 128 + 32 * qd + i] * s[i];
        part[qd * 128 + dv] = p;
        __syncthreads();
        const float kS = (part[dv] + part[128 + dv]) + (part[256 + dv] + part[384 + dv]);
        const float vt = vv[t * 128 + dv];
        float po = 0.f;
#pragma unroll
        for (int i = 0; i < 32; ++i) {
            const float kk = kv[t * 128 + 32 * qd + i];
            s[i] = eg * (s[i] - beta * kk * kS) + beta * kk * vt;
            po += s[i] * qv[t * 128 + 32 * qd + i];
        }
        __syncthreads();
        part[qd * 128 + dv] = po;
        __syncthreads();
        if (qd == 0) ov[t * 128 + dv] = (part[dv] + part[128 + dv]) + (part[256 + dv] + part[384 + dv]);
        __syncthreads();
    }
    if (w < 4) {
        const int t = w;
        const float o0 = ov[t * 128 + lane], o1 = ov[t * 128 + 64 + lane];
        const float rstd = rsqrtf(wave_sum(o0 * o0 + o1 * o1) * (1.f / 128.f) + RMS_EPS);
        const float* zp = P.PBS + (size_t)(b * 4 + t) * BIN + 8192 + hv * 128;
        bf16* yp = P.YB + (size_t)(MP + b * 4 + t) * 4096 + hv * 128;
        yp[lane] = (bf16)(pk2(o0 * rstd * P.norm_w[lane] * silu_f(zp[lane]), 0.f) & 0xffffu);
        yp[64 + lane] = (bf16)(pk2(o1 * rstd * P.norm_w[64 + lane] * silu_f(zp[64 + lane]), 0.f) & 0xffffu);
    }
    {
        float* so = P.ssm_s + ((size_t)b * 32 + hv) * 16384 + (32 * qd) * 128 + dv;
#pragma unroll
        for (int i = 0; i < 32; ++i) so[i * 128] = s[i];
    }
    __syncthreads();
}
struct CPtrs {
    const bf16* PC; const float* EC; const float* PCS; float* SS; bf16* YC;
    const float *conv_w, *conv_b, *dt_bias, *a_log, *dskip, *norm_w, *ssm0, *conv0;
    float *ssm_p, *ssm_s, *conv_p, *conv_s;
};
DI void c_scalars(const CPtrs& P, int b, int hd, int n, LAS float* dtL, LAS float* acsL, int lane) {
    const float dtr = P.EC[((size_t)b * TP + n * 64 + lane) * 64 + hd];
    const float dt = softplus_f(dtr + P.dt_bias[hd]);
    float a = -__expf(P.a_log[hd]) * dt;
#pragma unroll
    for (int o = 1; o < 64; o <<= 1) { const float v = __shfl_up(a, o); if (lane >= o) a += v; }
    dtL[lane] = dt; acsL[lane] = a;
}
DI void cchain_unit(const Frame& F, int cu, const CPtrs& P) {
    const int b = cu >> 6, hd = cu & 63, g = hd >> 3;
    const int lane = F.lane, w = F.wave, tid = F.tid, h = lane >> 5, l32 = lane & 31;
    constexpr int LDX = 144, LDB = 272, LDY = 272;
    LAS uchar* Xl = F.lds; LAS uchar* XDl = F.lds + 9216; LAS uchar* XWl = F.lds + 18432;
    LAS uchar* Bl = F.lds + 27648; LAS uchar* Cl = F.lds + 45056;
    LAS uchar* Gl = F.lds + 62464;
    LAS uchar* Hl = F.lds + 71680;
    LAS uchar* Yl = F.lds + 89088;
    LAS float* dtL = (LAS float*)(F.lds + 106496);
    LAS float* acsL = dtL + 128;
    const int nb = w & 3, pb = w >> 2;
    f32x16 hst = zero16();
    for (int i = tid; i < 64 * LDB / 4; i += 512) ((LAS unsigned*)Hl)[i] = 0u;
    if (w == 7) c_scalars(P, b, hd, 0, dtL, acsL, lane);
    const float dsk = P.dskip[hd];
    __syncthreads();
    for (int n = 0; n < 64; ++n) {
        const int t0 = n * 64, cur = n & 1;
        LAS const float* dtc = dtL + cur * 64; LAS const float* acs = acsL + cur * 64;
        const float alast = acs[63];
        for (int it = 0; it < 5; ++it) {
            const int id = tid + 512 * it, i = id / 40, ch = id - i * 40, t = t0 + i;
            const int col = ch < 8 ? 4096 + hd * 64 + 8 * ch : ch < 24 ? 8192 + g * 128 + 8 * (ch - 8) : 9216 + g * 128 + 8 * (ch - 24);
            const int cc = col - 4096;
            float y[8];
            { const f32x4 b0 = *(const f32x4*)(P.conv_b + cc), b1 = *(const f32x4*)(P.conv_b + cc + 4); y[0] = b0[0]; y[1] = b0[1]; y[2] = b0[2]; y[3] = b0[3]; y[4] = b1[0]; y[5] = b1[1]; y[6] = b1[2]; y[7] = b1[3]; }
#pragma unroll
            for (int jj = 0; jj < 4; ++jj) {
                const int tt = t - 3 + jj;
                u32x4 x = {0u, 0u, 0u, 0u};
                if (tt >= 0) x = *(const u32x4*)(P.PC + ((size_t)b * TP + tt) * CINM + col);
                const f32x4 w0 = *(const f32x4*)(P.conv_w + jj * 6144 + cc), w1 = *(const f32x4*)(P.conv_w + jj * 6144 + cc + 4);
                y[0] += bflo(x[0]) * w0[0]; y[1] += bfhi(x[0]) * w0[1]; y[2] += bflo(x[1]) * w0[2]; y[3] += bfhi(x[1]) * w0[3];
                y[4] += bflo(x[2]) * w1[0]; y[5] += bfhi(x[2]) * w1[1]; y[6] += bflo(x[3]) * w1[2]; y[7] += bfhi(x[3]) * w1[3];
            }
#pragma unroll
            for (int e = 0; e < 8; ++e) y[e] = silu_f(y[e]);
            u32x4 o; o.x = pk2(y[0], y[1]); o.y = pk2(y[2], y[3]); o.z = pk2(y[4], y[5]); o.w = pk2(y[6], y[7]);
            if (ch < 8) {
                const float d1 = dtc[i], d2 = d1 * __expf(alast - acs[i]);
                u32x4 o1, o2;
                o1.x = pk2(y[0] * d1, y[1] * d1); o1.y = pk2(y[2] * d1, y[3] * d1); o1.z = pk2(y[4] * d1, y[5] * d1); o1.w = pk2(y[6] * d1, y[7] * d1);
                o2.x = pk2(y[0] * d2, y[1] * d2); o2.y = pk2(y[2] * d2, y[3] * d2); o2.z = pk2(y[4] * d2, y[5] * d2); o2.w = pk2(y[6] * d2, y[7] * d2);
                *(LAS u32x4*)(Xl + i * LDX + ch * 16) = o; *(LAS u32x4*)(XDl + i * LDX + ch * 16) = o1; *(LAS u32x4*)(XWl + i * LDX + ch * 16) = o2;
            } else if (ch < 24) *(LAS u32x4*)(Bl + i * LDB + (ch - 8) * 16) = o;
            else *(LAS u32x4*)(Cl + i * LDB + (ch - 24) * 16) = o;
        }
        __syncthreads();
        f32x16 yacc = zero16();
        const int ti = (w >> 1) & 1, tq = w & 1;
        if (w >= 4) {
            if (!(ti == 0 && tq == 1)) {
                f32x16 cbt = mm_tile<false, false>(zero16(), Cl, LDB, 32 * ti, Bl, LDB, 32 * tq, 8, lane);
                const int j = 32 * tq + l32; const float aj = acs[j];
#pragma unroll
                for (int r = 0; r < 16; ++r) {
                    const int i = 32 * ti + crow(r, h);
                    const float v = (i >= j) ? cbt[r] * __expf(acs[i] - aj) : 0.f;
                    *(LAS bf16*)(Gl + i * LDX + j * 2) = (bf16)(pk2(v, 0.f) & 0xffffu);
                }
            } else {
#pragma unroll
                for (int r = 0; r < 16; ++r) *(LAS bf16*)(Gl + crow(r, h) * LDX + (32 + l32) * 2) = (bf16)0;
            }
        } else {
            yacc = mm_tile<false, false>(yacc, Cl, LDB, 32 * ti, Hl, LDB, 32 * tq, 8, lane);
#pragma unroll
            for (int r = 0; r < 16; ++r) yacc[r] *= __expf(acs[32 * ti + crow(r, h)]);
        }
        __syncthreads();
        if (w < 4) {
            yacc = mm_tile<false, true>(yacc, Gl, LDX, 32 * ti, XDl, LDX, 32 * tq, 4, lane);
#pragma unroll
            for (int r = 0; r < 16; ++r) *(LAS float*)(Yl + (32 * ti + crow(r, h)) * LDY + (32 * tq + l32) * 4) = yacc[r];
        }
        {
            const float el = __expf(alast);
#pragma unroll
            for (int r = 0; r < 16; ++r) hst[r] *= el;
            hst = mm_tile<true, true>(hst, Bl, LDB, 32 * nb, XWl, LDX, 32 * pb, 4, lane);
        }
        __syncthreads();
#pragma unroll
        for (int q = 0; q < 4; ++q) {
            f32x4 v = {hst[4 * q], hst[4 * q + 1], hst[4 * q + 2], hst[4 * q + 3]};
            *(LAS u32x2*)(Hl + (32 * pb + l32) * LDB + (32 * nb + 8 * q + 4 * h) * 2) = pk4(v);
        }
        if (w == 7 && n < 63) c_scalars(P, b, hd, n + 1, dtL + (cur ^ 1) * 64, acsL + (cur ^ 1) * 64, lane);
        {
            const int i = tid >> 3, part = tid & 7, t = t0 + i;
            const f32x4 ya = *(LAS const f32x4*)(Yl + i * LDY + (8 * part) * 4), yb = *(LAS const f32x4*)(Yl + i * LDY + (8 * part + 4) * 4);
            const u32x4 xv = *(LAS const u32x4*)(Xl + i * LDX + part * 16);
            const u32x4 zv = *(const u32x4*)(P.PC + ((size_t)b * TP + t) * CINM + hd * 64 + 8 * part);
            float y[8] = {ya[0], ya[1], ya[2], ya[3], yb[0], yb[1], yb[2], yb[3]};
            float ss = 0.f;
#pragma unroll
            for (int e = 0; e < 4; ++e) {
                y[2 * e] = (y[2 * e] + dsk * bflo(xv[e])) * silu_f(bflo(zv[e]));
                y[2 * e + 1] = (y[2 * e + 1] + dsk * bfhi(xv[e])) * silu_f(bfhi(zv[e]));
                ss += y[2 * e] * y[2 * e] + y[2 * e + 1] * y[2 * e + 1];
            }
            ss += __shfl_xor(ss, 1); ss += __shfl_xor(ss, 2); ss += __shfl_xor(ss, 4);
            if (part == 0) P.SS[((size_t)b * TP + t) * 64 + hd] = ss;
            u32x4 o; o.x = pk2(y[0], y[1]); o.y = pk2(y[2], y[3]); o.z = pk2(y[4], y[5]); o.w = pk2(y[6], y[7]);
            *(u32x4*)(P.YC + ((size_t)b * TP + t) * 4096 + hd * 64 + 8 * part) = o;
        }
        __syncthreads();
    }
    {
        float* sp = P.ssm_p + (((size_t)b * 64 + hd) * 64 + 32 * pb + l32) * 128 + 32 * nb + 4 * h;
#pragma unroll
        for (int q = 0; q < 4; ++q) { f32x4 v = {hst[4 * q], hst[4 * q + 1], hst[4 * q + 2], hst[4 * q + 3]}; *(f32x4*)(sp + 8 * q) = v; }
    }
    __syncthreads();
}

DI void csample_unit(const Frame& F, int su, const CPtrs& P) {
    const int b = su >> 3, g = su & 7;
    const int tid = F.tid, lane = F.lane, w = F.wave, hd = g * 8 + w;
    LAS float* xs = (LAS float*)F.lds;
    LAS float* Bs = xs + 2048; LAS float* Cs = Bs + 512;
    LAS float* ys = Cs + 512;
    for (int c = tid; c < 768; c += 512) {
        const int cc = c < 512 ? g * 512 + c : c < 640 ? 4096 + g * 128 + (c - 512) : 5120 + g * 128 + (c - 640);
        float full[7];
#pragma unroll
        for (int r = 0; r < 3; ++r) full[r] = P.conv0[((size_t)b * 3 + r) * 6144 + cc];
#pragma unroll
        for (int t = 0; t < 4; ++t) full[3 + t] = P.PCS[(size_t)(b * 4 + t) * CIN + 4096 + cc];
        const float w0 = P.conv_w[cc], w1 = P.conv_w[6144 + cc], w2 = P.conv_w[2 * 6144 + cc], w3 = P.conv_w[3 * 6144 + cc], cb = P.conv_b[cc];
#pragma unroll
        for (int t = 0; t < 4; ++t) {
            const float v = silu_f(full[t] * w0 + full[t + 1] * w1 + full[t + 2] * w2 + full[t + 3] * w3 + cb);
            if (c < 512) xs[t * 512 + c]= v; else if (c < 640) Bs[t * 128 + (c - 512)] = v; else Cs[t * 128 + (c - 640)] = v;
        }
#pragma unroll
        for (int r = 0; r < 3; ++r) P.conv_s[((size_t)b * 3 + r) * 6144 + cc] = full[4 + r];
    }
    __syncthreads();
    float dt[4], dA[4];
    {
        const float a = -__expf(P.a_log[hd]), db = P.dt_bias[hd];
#pragma unroll
        for (int t = 0; t < 4; ++t) { dt[t] = softplus_f(P.PCS[(size_t)(b * 4 + t) * CIN + 10240 + hd] + db); dA[t] = __expf(dt[t] * a); }
    }
    const float dsk = P.dskip[hd];
#pragma unroll 1
    for (int ph = 0; ph < 2; ++ph) {
        float hs[32][2];
        const float* h0 = P.ssm0 + (((size_t)b * 64 + hd) * 64 + 32 * ph) * 128 + lane;
#pragma unroll
        for (int pi = 0; pi < 32; ++pi) { hs[pi][0] = h0[pi * 128]; hs[pi][1] = h0[pi * 128 + 64]; }
#pragma unroll 1
        for (int t = 0; t < 4; ++t) {
            const float b0 = Bs[t * 128 + lane], b1 = Bs[t * 128 + 64 + lane], c0 = Cs[t * 128 + lane], c1 = Cs[t * 128 + 64 + lane];
#pragma unroll
            for (int pi = 0; pi < 32; ++pi) {
                const float x = xs[t * 512 + w * 64 + 32 * ph + pi], dx = dt[t] * x;
                hs[pi][0] = hs[pi][0] * dA[t] + dx * b0; hs[pi][1] = hs[pi][1] * dA[t] + dx * b1;
                const float yv = wave_sum(hs[pi][0] * c0 + hs[pi][1] * c1);
                if (lane == 0) ys[t * 512 + w * 64 + 32 * ph + pi] = yv + dsk * x;
            }
        }
        float* ho = P.ssm_s + (((size_t)b * 64 + hd) * 64 + 32 * ph) * 128 + lane;
#pragma unroll
        for (int pi = 0; pi < 32; ++pi) { ho[pi * 128] = hs[pi][0]; ho[pi * 128 + 64] = hs[pi][1]; }
    }
    __syncthreads();
    if (w < 4) {
        const int t = w;
        const float* zp = P.PCS + (size_t)(b * 4 + t) * CIN + g * 512 + 8 * lane;
        float y[8]; float ss = 0.f;
#pragma unroll
        for (int e = 0; e < 8; ++e) { y[e] = ys[t * 512 + 8 * lane + e] * silu_f(zp[e]); ss += y[e] * y[e]; }
        const float rstd = rsqrtf(wave_sum(ss) * (1.f / 512.f) + RMS_EPS);
        const float* nw = P.norm_w + g * 512 + 8 * lane;
        u32x4 o; o.x = pk2(y[0] * rstd * nw[0], y[1] * rstd * nw[1]); o.y = pk2(y[2] * rstd * nw[2], y[3] * rstd * nw[3]);
        o.z = pk2(y[4] * rstd * nw[4], y[5] * rstd * nw[5]); o.w = pk2(y[6] * rstd * nw[6], y[7] * rstd * nw[7]);
        *(u32x4*)(P.YC + (size_t)(MP + b * 4 + t) * 4096 + g * 512 + 8 * lane) = o;
    }
    __syncthreads();
}
DI void cnorm_phase(const Frame& F, const CPtrs& P) {
    for (int row = F.gw; row < MP; row += F.NGW) {
        const float* ss = P.SS + (size_t)row * 64;
#pragma unroll
        for (int k = 0; k < 8; ++k) {
            const f32x4 s0 = *(const f32x4*)(ss + 8 * k), s1 = *(const f32x4*)(ss + 8 * k + 4);
            const float rstd = rsqrtf(((s0[0] + s0[1]) + (s0[2] + s0[3]) + (s1[0] + s1[1]) + (s1[2] + s1[3])) * (1.f / 512.f) + RMS_EPS);
            bf16* yp = P.YC + (size_t)row * 4096 + 8 * (F.lane + 64 * k);
            const float* nw = P.norm_w + 8 * (F.lane + 64 * k);
            const u32x4 v = *(const u32x4*)yp; const f32x4 n0 = *(const f32x4*)nw, n1 = *(const f32x4*)(nw + 4);
            u32x4 o; o.x = pk2(bflo(v[0]) * rstd * n0[0], bfhi(v[0]) * rstd * n0[1]); o.y = pk2(bflo(v[1]) * rstd * n0[2], bfhi(v[1]) * rstd * n0[3]);
            o.z = pk2(bflo(v[2]) * rstd * n1[0], bfhi(v[2]) * rstd * n1[1]); o.w = pk2(bflo(v[3]) * rstd * n1[2], bfhi(v[3]) * rstd * n1[3]);
            *(u32x4*)yp = o;
        }
    }
}
template <class Fn>
DI void run_gemm(const Frame& F, const bf16* A, const bf16* Bt, int N, int K, const Fn& f) {
    pg8::Gemm g{A, Bt, MP, N, K}; pg8::StaticOrder S; S.init(MP, N, F.G, F.bid);
    EpiWrap<Fn> E{f};
    pg8::gemm_phase<EpiWrap<Fn>, pg8::StaticOrder, true, true>(F.lds, g, S, E, F.tid);
}
#define SKINNY_LOOP(u, count) for (int u = (F.G - 1 - F.bid); u < (count); u += F.G)
#define SIDE_LOOP(u, count, nres) for (int _ns = (F.G > (nres) ? F.G - (nres) : F.G), u = ((F.G - 1 - F.bid) < _ns ? (F.G - 1 - F.bid) : (count)); u < (count); u += _ns)

enum { PH_PRO = 0, PH_GU, PH_DN, PH_LN, PH_AQKV, PH_ATT, PH_AO, PH_BIN, PH_BPREP, PH_BCHAIN, PH_BOUT, PH_CIN, PH_CCHAIN, PH_CNORM, PH_COUT, PH_N };

DI void fill_b(BPtrs& P, const Args& args) {
    uchar* ws = args.ws;
    P.PB = (const bf16*)(ws + MB_PB); P.EB = (const float*)(ws + MB_EB); P.PBS = (const float*)(ws + MB_PBS);
    P.WG = (bf16*)(ws + MB_WG); P.UG = (bf16*)(ws + MB_UG); P.QG = (bf16*)(ws + MB_QG); P.KG = (bf16*)(ws + MB_KG); P.QKG = (bf16*)(ws + MB_QKG);
    P.GCG = (float*)(ws + MB_GCG); P.YB = (bf16*)(ws + MB_YB);
    P.conv_w = args.in[18]; P.a_log = args.in[19]; P.dt_bias = args.in[20]; P.norm_w = args.in[21]; P.ssm0 = args.in[5]; P.conv0 = args.in[6];
    P.ssm_p = args.out + O_BSSMP; P.ssm_s = args.out + O_BSSMS; P.conv_p = args.out + O_BCONVP; P.conv_s = args.out + O_BCONVS;
}
DI void fill_c(CPtrs& P, const Args& args) {
    uchar* ws = args.ws;
    P.PC = (const bf16*)(ws + MC_PC); P.EC = (const float*)(ws + MC_EC); P.PCS = (const float*)(ws + MC_PCS); P.SS = (float*)(ws + MC_SS); P.YC = (bf16*)(ws + MC_YC);
    P.conv_w = args.in[24]; P.conv_b = args.in[25]; P.dt_bias = args.in[26]; P.a_log = args.in[27]; P.dskip = args.in[28]; P.norm_w = args.in[29];
    P.ssm0 = args.in[7]; P.conv0 = args.in[8];
    P.ssm_p = args.out + O_CSSMP; P.ssm_s = args.out + O_CSSMS; P.conv_p = args.out + O_CCONVP; P.conv_s = args.out + O_CCONVS;
}
template <int PH>
DI void phase_body(const Frame& F, const Args& args, int hl, int zsi, int j) {
    uchar* ws = args.ws;
    float* X = args.out; bf16* XB = (bf16*)(ws + WS_XB); float* ZP = (float*)(ws + WS_ZP); bf16* HB = (bf16*)(ws + WS_H);
    float* ZS = (float*)(ws + WS_ZS + (size_t)zsi * ZS_ONE);
    if constexpr (PH == PH_PRO) prologue(F, args);
    if constexpr (PH == PH_GU) {
        const bf16* Wgu = (const bf16*)(ws + WS_W + (size_t)hl * FFN_BYTES);
        FSwiglu f{HB}; run_gemm(F, XB, Wgu, NGU, DM, f);
        SKINNY_LOOP(u, NGU / 64) skinny_unit<2>(F, XB, DM, MP, Wgu, DM, 64 * u, 0, DM, f);
    }
    if constexpr (PH == PH_DN) {
        const bf16* Wdn = (const bf16*)(ws + WS_W + (size_t)hl * FFN_BYTES + GU_BYTES);
        FResid f{X, ZP, 0, 0.5f, 0, 1}; run_gemm(F, HB, Wdn, DM, DFF, f);
        SKINNY_LOOP(u, 256) { const int ft = u >> 2, ks = u & 3; FResid fs{X, ZS, MP, 0.5f, 1, ks == 0}; skinny_unit<1>(F, HB, DFF, MP, Wdn, DFF, 32 * ft, ks * (DFF / 4), DFF / 4, fs); }
    }
    if constexpr (PH == PH_LN) ln_phase(F, ZP, ZS, args.in[9] + (size_t)zsi * DM, args.in[10] + (size_t)zsi * DM, X, XB);
    if constexpr (PH == PH_AQKV || PH == PH_ATT || PH == PH_AO) {
        const bf16* Wq = (const bf16*)(ws + WS_WA + (size_t)j * A_BYTES); const bf16* Wo = (const bf16*)(ws + WS_WA + (size_t)j * A_BYTES + AQ_BYTES);
        bf16* QKV = (bf16*)(ws + MA_QKV); float* QKVS = (float*)(ws + MA_QKVS); bf16* OG = (bf16*)(ws + MA_OG); float* LSE = (float*)(ws + MA_LSE); bf16* OA = (bf16*)(ws + MA_O);
        if constexpr (PH == PH_AQKV) {
            FQkv f; f.QKV = QKV; f.QKVS = QKVS; f.rope = (const float*)(ws + WS_ROPE); f.j = j;
            f.out = args.out;
            run_gemm(F, XB, Wq, AQKV, DM, f);
            SKINNY_LOOP(u, AQKV / 64) skinny_unit<2>(F, XB, DM, MP, Wq, DM, 64 * u, 0, DM, f);
        }
        if constexpr (PH == PH_ATT) {
            for (int u = F.bid; u < 128; u += F.G) attn_prompt_unit(F, u, QKV, OG, LSE, OA);
            SIDE_LOOP(u, 256, 128) attn_sample_unit(F, u, QKVS, args.in[2], args.in[3], args.in[4], j, OA);
        }
        if constexpr (PH == PH_AO) {
            FResid f{X, ZP, 0, 1.f, 0, 1}; run_gemm(F, OA, Wo, DM, 1024, f);
            SKINNY_LOOP(u, 256) { const int ft = u >> 2, ks = u & 3; FResid fs{X, ZS, MP, 1.f, 1, ks == 0}; skinny_unit<1>(F, OA, 1024, MP, Wo, 1024, 32 * ft, ks * 256, 256, fs); }
        }
    }
    if constexpr (PH == PH_BIN || PH == PH_BPREP || PH == PH_BCHAIN || PH == PH_BOUT) {
        const bf16* Wi = (const bf16*)(ws + WS_WB); const bf16* Wo = (const bf16*)(ws + WS_WB + BI_BYTES);
        BPtrs P; fill_b(P, args);
        if constexpr (PH == PH_BIN) {
            FBf16 f{(bf16*)(ws + MB_PB), BINM}; run_gemm(F, XB, Wi, BINM, DM, f);
            FF32 fe{(float*)(ws + MB_EB), 64, 0, BINM};
            SKINNY_LOOP(u, 256) skinny_unit<2>(F, XB, DM, 32 * u, Wi, DM, BINM, 0, DM, fe);
            FF32 fs{(float*)(ws + MB_PBS), BIN, MP, 0};
            SKINNY_LOOP(u, BIN / 64) skinny_unit<2>(F, XB, DM, MP, Wi, DM, 64 * u, 0, DM, fs);
        }
        if constexpr (PH == PH_BPREP) {
            for (int u = F.bid; u < 2048; u += F.G) bprep_unit(F, u, P);
            for (int i = F.gw * 64 + F.lane; i < 2 * 3 * 8192; i += F.NGW * 64) { const int b = i / 24576, r = (i / 8192) % 3, c = i & 8191; P.conv_p[i] = bf2f(P.PB[((size_t)b * TP + TP - 3 + r) * BINM + c]); }
        }
        if constexpr (PH == PH_BCHAIN) {
            for (int u = F.bid; u < 64; u += F.G) bchain_unit(F, u, P);
            SIDE_LOOP(u, 256, 64) bsample_unit(F, u, P);
        }
        if constexpr (PH == PH_BOUT) {
            FResid f{X, ZP, 0, 1.f, 0, 1}; run_gemm(F, P.YB, Wo, DM, 4096, f);
            SKINNY_LOOP(u, 256) { const int ft = u >> 2, ks = u & 3; FResid fs{X, ZS, MP, 1.f, 1, ks == 0}; skinny_unit<1>(F, P.YB, 4096, MP, Wo, 4096, 32 * ft, ks * 1024, 1024, fs); }
        }
    }
    if constexpr (PH == PH_CIN || PH == PH_CCHAIN || PH == PH_CNORM || PH == PH_COUT) {
        const bf16* Wi = (const bf16*)(ws + WS_WC); const bf16* Wo = (const bf16*)(ws + WS_WC + CI_BYTES);
        CPtrs P; fill_c(P, args);
        if constexpr (PH == PH_CIN) {
            FBf16 f{(bf16*)(ws + MC_PC), CINM}; run_gemm(F, XB, Wi, CINM, DM, f);
            FF32 fe{(float*)(ws + MC_EC), 64, 0, CINM};
            SKINNY_LOOP(u, 256) skinny_unit<2>(F, XB, DM, 32 * u, Wi, DM, CINM, 0, DM, fe);
            FF32 fs{(float*)(ws + MC_PCS), CIN, MP, 0};
            SKINNY_LOOP(u, CIN / 64) skinny_unit<2>(F, XB, DM, MP, Wi, DM, 64 * u, 0, DM, fs);
        }
        if constexpr (PH == PH_CCHAIN) {
            for (int u = F.bid; u < 128; u += F.G) cchain_unit(F, u, P);
            SIDE_LOOP(u, 64, 128) csample_unit(F, u, P);
            for (int i = F.gw * 64 + F.lane; i < 2 * 3 * 6144; i += F.NGW * 64) { const int b = i / 18432, r = (i / 6144) % 3, c = i % 6144; P.conv_p[i] = bf2f(P.PC[((size_t)b * TP + TP - 3 + r) * CINM + 4096 + c]); }
        }
        if constexpr (PH == PH_CNORM) cnorm_phase(F, P);
        if constexpr (PH == PH_COUT) {
            FResid f{X, ZP, 0, 1.f, 0, 1}; run_gemm(F, P.YC, Wo, DM, 4096, f);
            SKINNY_LOOP(u, 256) { const int ft = u >> 2, ks = u & 3; FResid fs{X, ZS, MP, 1.f, 1, ks == 0}; skinny_unit<1>(F, P.YC, 4096, MP, Wo, 4096, 32 * ft, ks * 1024, 1024, fs); }
        }
    }
}
DI void make_frame(Frame& F, unsigned char* lds_raw) {
    F.lds = (LAS uchar*)lds_raw;
    F.tid = threadIdx.x; F.lane = F.tid & 63; F.wave = __builtin_amdgcn_readfirstlane(F.tid >> 6);
    F.G = gridDim.x; F.bid = blockIdx.x; F.gw = F.bid * NWAVES + F.wave; F.NGW = F.G * NWAVES;
}
#if MK_MULTI
template <int PH>
__global__ void __launch_bounds__(NWAVES * 64, 2) mk_phase(Args args, int hl, int zsi, int j) {
    extern __shared__ __attribute__((aligned(16))) unsigned char lds_raw[];
    Frame F; make_frame(F, lds_raw);
    phase_body<PH>(F, args, hl, zsi, j);
}
#endif

static void fill_args(Args& a, void* const* d_in, void* d_out, void* d_ws) {
    for (int i = 0; i < 31; ++i) a.in[i] = (const float*)d_in[i];
    a.out = (float*)d_out; a.ws = (unsigned char*)d_ws;
    unsigned char* ws = (unsigned char*)d_ws;
    int nd = 0, items = 0;
    auto add = [&](const float* src, size_t dst_off, int K, int N, int mode) { a.wd[nd].src = src; a.wd[nd].dst = (bf16*)(ws + dst_off); a.wd[nd].K = K; a.wd[nd].N = N; a.wd[nd].mode = mode; a.wd[nd].item0 = items; items += (K / 64) * (N / 64); ++nd; };
    for (int L = 0; L < 4; ++L)
        for (int wh = 0; wh < 2; ++wh) {
            const int hl = 2 * L + wh;
            add(a.in[wh ? 13 : 11] + (size_t)L * DM * NGU, WS_W + (size_t)hl * FFN_BYTES, DM, NGU, 1);
            add(a.in[wh ? 14 : 12] + (size_t)L * DFF * DM, WS_W + (size_t)hl * FFN_BYTES + GU_BYTES, DFF, DM, 0);
        }
    for (int j = 0; j < 2; ++j) { add(a.in[15] + (size_t)j * DM * AQKV, WS_WA + (size_t)j * A_BYTES, DM, AQKV, 0); add(a.in[16] + (size_t)j * 1024 * DM, WS_WA + (size_t)j * A_BYTES + AQ_BYTES, 1024, DM, 0); }
    add(a.in[17], WS_WB, DM, BIN, 0); add(a.in[22], WS_WB + BI_BYTES, 4096, DM, 0);
    add(a.in[23], WS_WC, DM, CIN, 0); add(a.in[30], WS_WC + CI_BYTES, 4096, DM, 0);
    a.nitems = items; a.pad = 0;
}
#if MK_MULTI
template <int PH> static void launch_phase(const Args& a, int grid, hipStream_t stream, int hl, int zsi, int j) {
    static bool attr = false;
    if (!attr) { (void)hipFuncSetAttribute((const void*)mk_phase<PH>, hipFuncAttributeMaxDynamicSharedMemorySize, LDS_BYTES); attr = true; }
    hipLaunchKernelGGL(mk_phase<PH>, dim3(grid), dim3(NWAVES * 64), LDS_BYTES, stream, a, hl, zsi, j);
}
extern "C" void kernel_launch(void* const* d_in, const int* in_sizes, int n_in, void* d_out, int out_size, void* d_ws, size_t ws_size, hipStream_t stream) {
    static int grid = 0;
    if (grid == 0) {
        if (n_in != 31 || (size_t)out_size != O_END || ws_size < WS_END) {
            fprintf(stderr, "kernel_launch: expected 31 inputs, out %zu floats, ws >= %zu bytes; got n_in %d out %d ws %zu; nothing launched\n", (size_t)O_END, (size_t)WS_END, n_in, out_size, ws_size);
            grid = -1; return;
        }
        int dev = 0, cus = 0;
        if (hipGetDevice(&dev) != hipSuccess || hipDeviceGetAttribute(&cus, hipDeviceAttributeMultiprocessorCount, dev) != hipSuccess) { grid = -1; return; }
        grid = cus;
    }
    if (grid < 0) return;
    Args a{}; fill_args(a, d_in, d_out, d_ws);
    launch_phase<PH_PRO>(a, grid, stream, 0, 0, 0);
    for (int hl = 0; hl < 8; ++hl) {
        const int layer = hl >> 1, which = hl & 1, zf = 3 * layer + 2 * which, zm = 3 * layer + 1;
        launch_phase<PH_GU>(a, grid, stream, hl, zf, 0);
        launch_phase<PH_DN>(a, grid, stream, hl, zf, 0);
        launch_phase<PH_LN>(a, grid, stream, hl, zf, 0);
        if (which == 1) continue;
        if (layer == 0 || layer == 3) {
            const int j = layer == 0 ? 0 : 1;
            launch_phase<PH_AQKV>(a, grid, stream, hl, zm, j); launch_phase<PH_ATT>(a, grid, stream, hl, zm, j); launch_phase<PH_AO>(a, grid, stream, hl, zm, j);
        } else if (layer == 1) {
            launch_phase<PH_BIN>(a, grid, stream, hl, zm, 0); launch_phase<PH_BPREP>(a, grid, stream, hl, zm, 0); launch_phase<PH_BCHAIN>(a, grid, stream, hl, zm, 0); launch_phase<PH_BOUT>(a, grid, stream, hl, zm, 0);
        } else {
            launch_phase<PH_CIN>(a, grid, stream, hl, zm, 0); launch_phase<PH_CCHAIN>(a, grid, stream, hl, zm, 0); launch_phase<PH_CNORM>(a, grid, stream, hl, zm, 0); launch_phase<PH_COUT>(a, grid, stream, hl, zm, 0);
        }
        launch_phase<PH_LN>(a, grid, stream, hl, zm, 0);
    }
    const hipError_t le = hipPeekAtLastError();
    if (le != hipSuccess) fprintf(stderr, "kernel_launch: launch failed: %s\n", hipGetErrorName(le));
}
#endif
#if !MK_MULTI
DI void launder_frame(Frame& F) {
    int t_ = F.tid, l_ = F.lane, w_ = F.wave, g_ = F.G, b_ = F.bid; unsigned la_ = (unsigned)(size_t)F.lds;
    asm volatile("" : "+v"(t_), "+v"(l_)); asm volatile("" : "+s"(w_), "+s"(g_), "+s"(b_), "+s"(la_));
    F.tid = t_; F.lane = l_; F.wave = w_; F.G = g_; F.bid = b_; F.gw = b_ * NWAVES + w_; F.NGW = g_ * NWAVES; F.lds = (LAS uchar*)(size_t)la_;
}
__global__ void __launch_bounds__(NWAVES * 64, 2) mk_fwd(Args args) {
    extern __shared__ __attribute__((aligned(16))) unsigned char lds_raw[];
    Frame F; make_frame(F, lds_raw);
    volatile LAS unsigned* MISC = (volatile LAS unsigned*)(F.lds + MISC_OFF);
    for (int u = F.tid; u < (LDS_BYTES - MISC_OFF) / 4; u += NWAVES * 64) ((LAS unsigned*)(F.lds + MISC_OFF))[u] = 0u;
    __syncthreads();
    XcdBarrier bar = xcd_barrier_post((unsigned*)(args.ws + WS_CTL) + CW_BAR, MISC + 8);
#define RUN(PH, hl, zsi, j) do { asm volatile("; MARK_PHASE %0 %1" :: "i"(PH), "i"(zsi)); launder_frame(F); phase_body<PH>(F, args, hl, zsi, j); xcd_barrier(bar); } while (0)
#define FFN(hl, zsi) RUN(PH_GU, hl, zsi, 0); RUN(PH_DN, hl, zsi, 0); RUN(PH_LN, hl, zsi, 0)
#define MIXA(zsi, j) RUN(PH_AQKV, 0, zsi, j); RUN(PH_ATT, 0, zsi, j); RUN(PH_AO, 0, zsi, j); RUN(PH_LN, 0, zsi, 0)
#define MIXB(zsi) RUN(PH_BIN, 0, zsi, 0); RUN(PH_BPREP, 0, zsi, 0); RUN(PH_BCHAIN, 0, zsi, 0); RUN(PH_BOUT, 0, zsi, 0); RUN(PH_LN, 0, zsi, 0)
#define MIXC(zsi) RUN(PH_CIN, 0, zsi, 0); RUN(PH_CCHAIN, 0, zsi, 0); RUN(PH_CNORM, 0, zsi, 0); RUN(PH_COUT, 0, zsi, 0); RUN(PH_LN, 0, zsi, 0)
    RUN(PH_PRO, 0, 0, 0);
    FFN(0, 0); MIXA(1, 0); FFN(1, 2);
    FFN(2, 3); MIXB(4);    FFN(3, 5);
    FFN(4, 6); MIXC(7);    FFN(5, 8);
    FFN(6, 9); MIXA(10, 1); FFN(7, 11);
}
extern "C" void kernel_launch(void* const* d_in, const int* in_sizes, int n_in, void* d_out, int out_size, void* d_ws, size_t ws_size, hipStream_t stream) {
    static int grid = 0;
    if (grid == 0) {
        if (n_in != 31 || (size_t)out_size != O_END || ws_size < WS_END) {
            fprintf(stderr, "kernel_launch: expected 31 inputs, out %zu floats, ws >= %zu bytes; got n_in %d out %d ws %zu; nothing launched\n", (size_t)O_END, (size_t)WS_END, n_in, out_size, ws_size);
            grid = -1; return;
        }
        int dev = 0, cus = 0, per_cu = 0;
        if (hipGetDevice(&dev) != hipSuccess || hipDeviceGetAttribute(&cus, hipDeviceAttributeMultiprocessorCount, dev) != hipSuccess) { grid = -1; return; }
        if (hipFuncSetAttribute((const void*)mk_fwd, hipFuncAttributeMaxDynamicSharedMemorySize, LDS_BYTES) != hipSuccess) { fprintf(stderr, "kernel_launch: hipFuncSetAttribute failed\n"); grid = -1; return; }
        if (hipOccupancyMaxActiveBlocksPerMultiprocessor(&per_cu, (const void*)mk_fwd, NWAVES * 64, LDS_BYTES) != hipSuccess || per_cu < 1)
            fprintf(stderr, "kernel_launch: note: occupancy query reports %d workgroups per CU\n", per_cu);
        (void)hipGetLastError();
        grid = cus;
    }
    if (grid < 0) return;
    if (hipMemsetAsync((char*)d_ws + WS_CTL, 0, CTL_ZERO_BYTES, stream) != hipSuccess) { fprintf(stderr, "kernel_launch: memset failed\n"); return; }
    Args a{}; fill_args(a, d_in, d_out, d_ws);
    hipLaunchKernelGGL(mk_fwd, dim3(grid), dim3(NWAVES * 64), LDS_BYTES, stream, a);
    const hipError_t le = hipPeekAtLastError();
    if (le != hipSuccess) fprintf(stderr, "kernel_launch: launch failed: %s\n", hipGetErrorName(le));
}
#endif
```

```cpp
#include <hip/hip_runtime.h>
#include <cstdio>
#include <cstdint>
#ifndef MK_MULTI
#define MK_MULTI 0
#endif
#define DUP_PH -1
namespace pg8 {
#define PG8_LAS __attribute__((address_space(3)))
typedef unsigned short bf16_t;
typedef short bf16x8 __attribute__((ext_vector_type(8)));
typedef float f32x4 __attribute__((ext_vector_type(4)));
typedef unsigned u32x4 __attribute__((ext_vector_type(4)));
constexpr int BM = 256, BK = 64, HALF = 128, HTB = HALF * BK * 2  , STAGE_BYTES = 8 * HTB, NXCD = 8, WGM = 8;

__host__ __device__ __forceinline__ int lds_byte(int r, int c) { const int st = (r >> 4) * 2 + (c >> 5), rr = r & 15, cc = c & 31, ob = rr * 64 + cc * 2; return st * 1024 + (ob ^ (((ob >> 9) & 1) << 5)); }
__host__ __device__ __forceinline__ void stage_rc(int b, int& R, int& C) { const int st = b / 1024, sb = b % 1024, swz = sb ^ (((sb >> 9) & 1) << 5); R = (st >> 1) * 16 + swz / 64; C = (st & 1) * 32 + (swz % 64) / 2; }
__host__ __device__ __forceinline__ int perm32(int rho) { const int n = rho >> 4, i = rho & 15; return 8 * (i >> 2) + 4 * n + (i & 3); }

struct Unit { int pm, pn; };
struct Gemm { const bf16_t* A; const bf16_t* Bt; int M, N, K; };

struct StaticOrder {
    int nM, nN, nwg, G, c;
    __host__ __device__ void init(int M, int N, int G_, int c_) { nM = M / BM; nN = N / BM; nwg = nM * nN; G = G_; c = c_; }
    __host__ __device__ bool next(int i, Unit& u) const {
        const long L = (long)i * G + c; if (L >= nwg) return false;
        int wgid = (int)L; { const int q = nwg / NXCD, r = nwg % NXCD, xcd = wgid % NXCD, off = wgid / NXCD; wgid = (xcd < r ? xcd * (q + 1) : r * (q + 1) + (xcd - r) * q) + off; }
        const int nig = WGM * nN, gid = wgid / nig, fm = gid * WGM, gsz = (nM - fm) < WGM ? (nM - fm) : WGM;
        u.pm = fm + ((wgid % nig) % gsz); u.pn = (wgid % nig) / gsz; return true;
    }
    __device__ __forceinline__ void a_ready(const Unit&) const {}
    __device__ __forceinline__ void done(const Unit&) const {}
};


template <class Epi, class Sched, bool ALIGN_EPI = false, bool SP2 = false>
__device__ __forceinline__ void gemm_phase(PG8_LAS unsigned char* lds, const Gemm g, const Sched& S, const Epi& E, const int tid) {
    const int wid = __builtin_amdgcn_readfirstlane(tid >> 6), lane = tid & 63, wr = wid >> 2, wc = wid & 3, fr = lane & 15, fq = lane >> 4;
    const int K = g.K, nt = K / BK;
    unsigned voffA[2], voffB[2];
#pragma unroll
    for (int i = 0; i < 2; ++i) { int R, C; stage_rc(tid * 16 + i * 8192, R, C); const int Rb = Epi::PERM ? ((R & ~31) + perm32(R & 31)) : R;
        voffA[i] = (unsigned)(R * K + C) * 2u; voffB[i] = (unsigned)(Rb * K + C) * 2u; }
    const size_t kstep = (size_t)(BK * 2);
    const size_t hstep = (size_t)HALF * K * 2;
    const size_t tstep = 2 * hstep;
    const unsigned ldsw = (unsigned)wid * 1024u;
    const int aoff = lds_byte(wr * 64 + fr, fq * 8), boff = lds_byte(wc * 32 + fr, fq * 8);
#define PG8_SA(b, h) (((b) * 2 + (h)) * HTB)
#define PG8_SB(b, h) ((4 + (b) * 2 + (h)) * HTB)
#define PG8_STAGE(bufoff, gbase, voff) do { _Pragma("unroll") for (int _i = 0; _i < 2; ++_i) \
        __builtin_amdgcn_global_load_lds((const unsigned*)((const char*)(gbase) + (voff)[_i]), (PG8_LAS unsigned*)(lds + (bufoff) + ldsw + _i * 8192), 16, 0, 0); } while (0)
#define PG8_LDA(dst, b, h) do { _Pragma("unroll") for (int m = 0; m < 4; ++m) _Pragma("unroll") for (int k = 0; k < 2; ++k) dst[m][k] = *(const PG8_LAS bf16x8*)(lds + PG8_SA(b, h) + aoff + m * 2048 + k * 1024); } while (0)
#define PG8_LDB(dst, b, h) do { _Pragma("unroll") for (int n = 0; n < 2; ++n) _Pragma("unroll") for (int k = 0; k < 2; ++k) dst[n][k] = *(const PG8_LAS bf16x8*)(lds + PG8_SB(b, h) + boff + n * 2048 + k * 1024); } while (0)
#define PG8_MMA(ai, bj, At, Bt) do { __builtin_amdgcn_s_setprio(1); _Pragma("unroll") for (int m = 0; m < 4; ++m) _Pragma("unroll") for (int n = 0; n < 2; ++n) _Pragma("unroll") for (int k = 0; k < 2; ++k) \
        acc[ai][bj][m][n] = __builtin_amdgcn_mfma_f32_16x16x32_bf16(Bt[n][k], At[m][k], acc[ai][bj][m][n], 0, 0, 0); __builtin_amdgcn_s_setprio(0); } while (0)
#define PG8_WAIT_V(n) asm volatile("s_waitcnt vmcnt(" #n ")" ::: "memory")
#define PG8_WAIT_L(n) asm volatile("s_waitcnt lgkmcnt(" #n ")" ::: "memory")
#define PG8_BAR __builtin_amdgcn_s_barrier()
#define PG8_SCHED __builtin_amdgcn_sched_barrier(0)
    Unit cur, nxt; int ui = 0;
    if (!S.next(0, cur)) return;
    f32x4 acc[2][2][4][2];
#pragma unroll
    for (int a = 0; a < 2; ++a)
#pragma unroll
        for (int b = 0; b < 2; ++b)
#pragma unroll
            for (int m = 0; m < 4; ++m)
#pragma unroll
                for (int n = 0; n < 2; ++n) acc[a][b][m][n] = (f32x4){0.f, 0.f, 0.f, 0.f};
    bf16x8 At[4][2], B0[2][2], B1[2][2];
    const char* cA = (const char*)g.A + (size_t)cur.pm * tstep; const char* cB = (const char*)g.Bt + (size_t)cur.pn * tstep;
    S.a_ready(cur);
    if constexpr (SP2) {
        PG8_STAGE(PG8_SB(0, 0), cB, voffB); PG8_STAGE(PG8_SB(0, 1), cB + hstep, voffB); PG8_STAGE(PG8_SA(0, 0), cA, voffA); PG8_STAGE(PG8_SA(0, 1), cA + hstep, voffA);
        if (wr == 1) PG8_BAR;
        PG8_WAIT_V(2); PG8_BAR;
        PG8_STAGE(PG8_SB(1, 0), cB + kstep, voffB); PG8_STAGE(PG8_SA(1, 0), cA + kstep, voffA); PG8_STAGE(PG8_SB(1, 1), cB + hstep + kstep, voffB);
        PG8_WAIT_V(6); PG8_BAR;
    } else {
        PG8_STAGE(PG8_SB(0, 0), cB, voffB); PG8_STAGE(PG8_SA(0, 0), cA, voffA); PG8_STAGE(PG8_SB(0, 1), cB + hstep, voffB); PG8_STAGE(PG8_SA(0, 1), cA + hstep, voffA);
        if (wr == 1) PG8_BAR;
        PG8_WAIT_V(4); PG8_BAR;
        PG8_STAGE(PG8_SB(1, 0), cB + kstep, voffB); PG8_STAGE(PG8_SA(1, 0), cA + kstep, voffA); PG8_STAGE(PG8_SB(1, 1), cB + hstep + kstep, voffB);
        PG8_WAIT_V(6); PG8_BAR;
    }
    for (;;) {
        const bool has_next = S.next(ui + 1, nxt);
        const char* nA = has_next ? (const char*)g.A + (size_t)nxt.pm * tstep : cA; const char* nB = has_next ? (const char*)g.Bt + (size_t)nxt.pn * tstep : cB;
        for (int t = 0; t < nt; t += 2) {
            const bool last = (t == nt - 2);
            const char* a1 = cA + (size_t)(t + 1) * kstep;
            const char* a2 = last ? nA : cA + (size_t)(t + 2) * kstep; const char* b2 = last ? nB : cB + (size_t)(t + 2) * kstep;
            const char* a3 = a2 + kstep; const char* b3 = b2 + kstep;
            if (last && has_next) S.a_ready(nxt);
            if constexpr (SP2) {
            PG8_LDB(B0, 0, 0); PG8_LDB(B1, 0, 1); PG8_SCHED; PG8_LDA(At, 0, 0); PG8_STAGE(PG8_SA(1, 1), a1 + hstep, voffA);
            PG8_WAIT_V(8); PG8_WAIT_L(0); PG8_BAR; PG8_MMA(0, 0, At, B0); PG8_MMA(0, 1, At, B1); PG8_BAR; PG8_SCHED;
            PG8_LDA(At, 0, 1); PG8_STAGE(PG8_SB(0, 0), b2, voffB); PG8_STAGE(PG8_SB(0, 1), b2 + hstep, voffB); PG8_STAGE(PG8_SA(0, 0), a2, voffA);
            PG8_WAIT_V(8); PG8_WAIT_L(0); PG8_BAR; PG8_MMA(1, 0, At, B0); PG8_MMA(1, 1, At, B1); PG8_BAR; PG8_SCHED;
            PG8_LDB(B0, 1, 0); PG8_LDB(B1, 1, 1); PG8_SCHED; PG8_LDA(At, 1, 0); PG8_STAGE(PG8_SA(0, 1), a2 + hstep, voffA);
            PG8_WAIT_V(8); PG8_WAIT_L(0); PG8_BAR; PG8_MMA(0, 0, At, B0); PG8_MMA(0, 1, At, B1); PG8_BAR; PG8_SCHED;
            PG8_LDA(At, 1, 1); PG8_STAGE(PG8_SB(1, 0), b3, voffB); PG8_STAGE(PG8_SB(1, 1), b3 + hstep, voffB); PG8_STAGE(PG8_SA(1, 0), a3, voffA);
            PG8_WAIT_V(8); PG8_WAIT_L(0); PG8_BAR; PG8_MMA(1, 0, At, B0); PG8_MMA(1, 1, At, B1); PG8_BAR; PG8_SCHED;
            } else {
            PG8_LDB(B0, 0, 0); PG8_SCHED; PG8_LDA(At, 0, 0); PG8_STAGE(PG8_SA(1, 1), a1 + hstep, voffA);
            PG8_WAIT_L(8); PG8_BAR; PG8_WAIT_L(0); PG8_MMA(0, 0, At, B0); PG8_BAR; PG8_SCHED;
            PG8_LDB(B1, 0, 1); PG8_STAGE(PG8_SB(0, 0), b2, voffB);
            PG8_BAR; PG8_WAIT_L(0); PG8_MMA(0, 1, At, B1); PG8_BAR;
            PG8_LDA(At, 0, 1); PG8_STAGE(PG8_SA(0, 0), a2, voffA);
            PG8_BAR; PG8_WAIT_L(0); PG8_MMA(1, 0, At, B0); PG8_BAR; PG8_SCHED;
            PG8_STAGE(PG8_SB(0, 1), b2 + hstep, voffB);
            PG8_WAIT_V(6); PG8_BAR; PG8_MMA(1, 1, At, B1); PG8_BAR;
            PG8_LDB(B0, 1, 0); PG8_SCHED; PG8_LDA(At, 1, 0); PG8_STAGE(PG8_SA(0, 1), a2 + hstep, voffA);
            PG8_WAIT_L(8); PG8_BAR; PG8_WAIT_L(0); PG8_MMA(0, 0, At, B0); PG8_BAR; PG8_SCHED;
            PG8_LDB(B1, 1, 1); PG8_STAGE(PG8_SB(1, 0), b3, voffB);
            PG8_BAR; PG8_WAIT_L(0); PG8_MMA(0, 1, At, B1); PG8_BAR;
            PG8_LDA(At, 1, 1); PG8_STAGE(PG8_SA(1, 0), a3, voffA);
            PG8_BAR; PG8_WAIT_L(0); PG8_MMA(1, 0, At, B0); PG8_BAR; PG8_SCHED;
            PG8_STAGE(PG8_SB(1, 1), b3 + hstep, voffB);
            PG8_WAIT_V(6); PG8_BAR; PG8_MMA(1, 1, At, B1); PG8_BAR;
            }
        }
        if constexpr (ALIGN_EPI) { if (wr == 0) PG8_BAR; }
        if constexpr (!Epi::AFTER_DRAIN) { E(acc, cur, wr, wc, fr, fq); S.done(cur); }
        if (!has_next) break;
#pragma unroll
        for (int a = 0; a < 2; ++a)
#pragma unroll
            for (int b = 0; b < 2; ++b)
#pragma unroll
                for (int m = 0; m < 4; ++m)
#pragma unroll
                    for (int n = 0; n < 2; ++n) acc[a][b][m][n] = (f32x4){0.f, 0.f, 0.f, 0.f};
        cur = nxt; cA = nA; cB = nB; ++ui;
        if constexpr (ALIGN_EPI) { if (wr == 1) PG8_BAR; }
    }
    PG8_WAIT_V(0);
    if constexpr (!ALIGN_EPI) { if (wr == 0) PG8_BAR; }
    PG8_BAR;
    if constexpr (Epi::AFTER_DRAIN) { E.fused(acc, cur, wr, wc, fr, fq, lds, wid, lane); S.done(cur); }
#undef PG8_SA
#undef PG8_SB
#undef PG8_STAGE
#undef PG8_LDA
#undef PG8_LDB
#undef PG8_MMA
#undef PG8_WAIT_V
#undef PG8_WAIT_L
#undef PG8_BAR
#undef PG8_SCHED
}
}
#define GAS __attribute__((address_space(1)))
#define LAS __attribute__((address_space(3)))
typedef unsigned short bf16;
typedef unsigned char uchar;
typedef float f32x4 __attribute__((ext_vector_type(4)));
typedef float f32x2 __attribute__((ext_vector_type(2)));
typedef float f32x16 __attribute__((ext_vector_type(16)));
typedef short bf16x8 __attribute__((ext_vector_type(8)));
typedef short s16x4 __attribute__((ext_vector_type(4)));
typedef unsigned u32x4 __attribute__((ext_vector_type(4)));
typedef unsigned u32x2 __attribute__((ext_vector_type(2)));
typedef __bf16 hbf16x2 __attribute__((ext_vector_type(2)));
#define DI __device__ __forceinline__

DI unsigned pk2(float a, float b) { f32x2 v = {a, b}; hbf16x2 r = __builtin_convertvector(v, hbf16x2); return __builtin_bit_cast(unsigned, r); }
DI float bf2f(unsigned short b) { return __uint_as_float(((unsigned)b) << 16); }
DI float bflo(unsigned u) { return __uint_as_float(u << 16); }
DI float bfhi(unsigned u) { return __uint_as_float(u & 0xffff0000u); }
DI u32x2 pk4(f32x4 v) { u32x2 r; r.x = pk2(v[0], v[1]); r.y = pk2(v[2], v[3]); return r; }
DI float wave_sum(float v) {
#pragma unroll
    for (int o = 1; o < 64; o <<= 1) v += __shfl_xor(v, o);
    return v;
}
DI float wave_max(float v) {
#pragma unroll
    for (int o = 1; o < 64; o <<= 1) v = fmaxf(v, __shfl_xor(v, o));
    return v;
}
DI float silu_f(float x) { return x / (1.f + __expf(-x)); }
DI float sigmoid_f(float x) { return 1.f / (1.f + __expf(-x)); }
DI float softplus_f(float x) { return x > 20.f ? x : log1pf(__expf(x)); }
DI int crow(int r, int h) { return (r & 3) + 8 * (r >> 2) + 4 * h; }
template <class T> DI T ldg(const void* base, unsigned off) { return *(const T*)((const char*)base + off); }
template <class T> DI void stg(void* base, unsigned off, T v) { *(T*)((char*)base + off) = v; }

constexpr int DM = 2048, TP = 4096, NBP = 2, MP = NBP * TP, MS = 32, MALL = MP + MS, DFF = 5632, NGU = 2 * DFF;
constexpr int AQKV = 9216, BIN = 12352, BINM = 12288, CIN = 10304, CINM = 10240;
constexpr float DN_ALPHA = 1.6817928305074290f;
constexpr float LN_EPS = 1e-5f, RMS_EPS = 1e-6f;
constexpr int PASTLEN = 16384;

constexpr size_t O_YP = 0, O_YS = O_YP + (size_t)MP * DM, O_A128P = O_YS + (size_t)MS * DM,
    O_A128S = O_A128P + 1048576, O_A512P = O_A128S + 4194304, O_A512S = O_A512P + 4194304, O_A2048P = O_A512S + 16777216,
    O_A2048S = O_A2048P + 16777216, O_BSSMP = O_A2048S + 67108864, O_BSSMS = O_BSSMP + 1048576, O_BCONVP = O_BSSMS + 4194304,
    O_BCONVS = O_BCONVP + 49152, O_CSSMP = O_BCONVS + 196608, O_CSSMS = O_CSSMP + 1048576, O_CCONVP = O_CSSMS + 4194304,
    O_CCONVS = O_CCONVP + 36864, O_END = O_CCONVS + 147456;

constexpr size_t MiB = 1u << 20;
constexpr size_t WS_CTL = 0, CTL_ZERO_BYTES = 1 * MiB;
constexpr size_t WS_ROPE = 1 * MiB;
constexpr size_t WS_ZS = 2 * MiB, ZS_ONE = (size_t)MS * DM * 4;
constexpr size_t WS_W = 8 * MiB;
constexpr size_t GU_BYTES = (size_t)NGU * DM * 2, DN_BYTES = (size_t)DM * DFF * 2, FFN_BYTES = GU_BYTES + DN_BYTES;
constexpr size_t WS_WA = WS_W + 8 * FFN_BYTES, AQ_BYTES = (size_t)AQKV * DM * 2, AO_BYTES = (size_t)DM * 1024 * 2, A_BYTES = AQ_BYTES + AO_BYTES;
constexpr size_t WS_WB = WS_WA + 2 * A_BYTES, BI_BYTES = (size_t)BIN * DM * 2, BO_BYTES = (size_t)DM * 4096 * 2;
constexpr size_t WS_WC = WS_WB + BI_BYTES + BO_BYTES, CI_BYTES = (size_t)CIN * DM * 2, CO_BYTES = BO_BYTES;
constexpr size_t WS_XB = WS_WC + CI_BYTES + CO_BYTES;
constexpr size_t WS_ZP = WS_XB + (size_t)MALL * DM * 2;
constexpr size_t WS_H = WS_ZP + (size_t)MP * DM * 4;
constexpr size_t WS_MIX = WS_H + (size_t)MALL * DFF * 2;
constexpr size_t MA_QKV = WS_MIX, MA_QKVS = MA_QKV + (size_t)MP * AQKV * 2, MA_OG = MA_QKVS + (size_t)MS * AQKV * 4,
    MA_LSE = MA_OG + (size_t)3 * MP * 1024 * 2, MA_O = MA_LSE + (size_t)3 * MP * 8 * 4, MA_END = MA_O + (size_t)MALL * 1024 * 2;
constexpr size_t MB_PB = WS_MIX, MB_EB = MB_PB + (size_t)MP * BINM * 2, MB_PBS = MB_EB + (size_t)MP * 64 * 4, MB_WG = MB_PBS + (size_t)MS * BIN * 4,
    MB_UG = MB_WG + (size_t)MP * 32 * 128 * 2, MB_QG = MB_UG + (size_t)MP * 32 * 128 * 2, MB_KG = MB_QG + (size_t)MP * 16 * 128 * 2,
    MB_QKG = MB_KG + (size_t)MP * 16 * 128 * 2, MB_GCG = MB_QKG + (size_t)2 * 32 * 64 * 64 * 64 * 2, MB_YB = MB_GCG + (size_t)MP * 32 * 4,
    MB_END = MB_YB + (size_t)MALL * 4096 * 2;
constexpr size_t MC_PC = WS_MIX, MC_EC = MC_PC + (size_t)MP * CINM * 2, MC_PCS = MC_EC + (size_t)MP * 64 * 4, MC_SS = MC_PCS + (size_t)MS * CIN * 4,
    MC_YC = MC_SS + (size_t)MP * 64 * 4, MC_ACS = MC_YC + (size_t)MALL * 4096 * 2, MC_XBC = MC_ACS + (size_t)MP * 64 * 4, MC_END = MC_XBC + (size_t)MP * 6144 * 2;
constexpr size_t WS_END = (MB_END > MA_END ? (MB_END > MC_END ? MB_END : MC_END) : (MA_END > MC_END ? MA_END : MC_END));
static_assert(MA_QKVS % 256 == 0 && MA_OG % 256 == 0 && MA_O % 256 == 0 && MB_EB % 256 == 0 && MB_WG % 256 == 0 && MB_YB % 256 == 0 && MC_YC % 256 == 0 && WS_MIX % 256 == 0, "alignment");

constexpr int CW_BAR = 4096;
constexpr int SCR_BYTES = 143360, MISC_OFF = SCR_BYTES, LDS_BYTES = 147456;
constexpr int NWAVES = 8;

struct WDesc { const float* src; bf16* dst; int K, N, mode, item0; };
constexpr int NWD = 24;
struct Args { const float* in[31]; float* out; unsigned char* ws; WDesc wd[NWD]; int slot[6][2]; int nitems; int pad; };

struct Frame {
    LAS uchar* lds;
    int tid, lane, wave, G, gw, NGW, bid;
};
#define XB_TMO      128
#define XB_XCNT(j)  (256  + 64 * (j))
#define XB_XSUB(j)  (1280 + 64 * (j))
#define XB_XGEN(j)  (2304 + 64 * (j))
#define XB_TOP      3328
#define XB_TOPGEN   3392
#define XCD_BAR_WORDS 3456
#define XB_SPIN_CAP (1u << 18)

__device__ __forceinline__ unsigned xb_ld(unsigned* p)              { return __hip_atomic_load(p, __ATOMIC_RELAXED, __HIP_MEMORY_SCOPE_AGENT); }
__device__ __forceinline__ unsigned xb_add(unsigned* p, unsigned v) { return __hip_atomic_fetch_add(p, v, __ATOMIC_RELAXED, __HIP_MEMORY_SCOPE_AGENT); }
__device__ __forceinline__ unsigned xb_xcc_id() { return (unsigned)__builtin_amdgcn_s_getreg((3 << 11) | 20) & 0xFu; }
#define XB_SPIN(cond, bar) do { unsigned _sp = 0; while (cond) { __builtin_amdgcn_s_sleep(1); \
    if ((++_sp & 255u) == 0u) { if (xb_ld(&(bar)[XB_TMO])) break; if (_sp > XB_SPIN_CAP) { atomicAdd(&(bar)[XB_TMO], 1u); break; } } } } while (0)

struct XcdBarrier {
    unsigned* bar; unsigned x;
    volatile LAS unsigned* st;
};

__device__ __forceinline__ XcdBarrier xcd_barrier_post(unsigned* bar, volatile LAS unsigned* st) {
    XcdBarrier b; b.bar = bar; b.x = xb_xcc_id(); b.st = st;
    if (threadIdx.x == 0) (void)xb_add(&bar[XB_XCNT(b.x)], 1u);
    return b;
}
__device__ __forceinline__ void xcd_barrier_complete(unsigned* bar, unsigned x, unsigned& nloc, unsigned& nx) {
    const unsigned G = gridDim.x * gridDim.y * gridDim.z;
    unsigned sum, cnt, mine, sp = 0u;
    for (;;) {
        sum = 0u; cnt = 0u; mine = 0u;
#pragma unroll
        for (unsigned j = 0; j < 16; ++j) { const unsigned c = xb_ld(&bar[XB_XCNT(j)]); sum += c; cnt += (c > 0u) ? 1u : 0u; mine = (j == x) ? c : mine; }
        if (sum == G) break;
        __builtin_amdgcn_s_sleep(1);
        if ((++sp & 255u) == 0u) { if (xb_ld(&bar[XB_TMO])) break; if (sp > XB_SPIN_CAP) { atomicAdd(&bar[XB_TMO], 1u); break; } }
    }
    nloc = mine > 0u ? mine : 1u; nx = cnt > 0u ? cnt : 1u;
}

__device__ __forceinline__ void xcd_barrier(const XcdBarrier& b) {
    asm volatile("s_waitcnt vmcnt(0)" ::: "memory");
    __syncthreads();
    if (threadIdx.x == 0) {
        unsigned* bar = b.bar;
        __builtin_amdgcn_s_waitcnt(0);
        unsigned nloc = b.st[0], nx = b.st[1];
        if (nloc == 0u) { xcd_barrier_complete(bar, b.x, nloc, nx); b.st[0] = nloc; b.st[1] = nx; }
        const unsigned old = xb_add(&bar[XB_XSUB(b.x)], 1u);
        const unsigned gen = old / nloc;
        if (old + 1u == (gen + 1u) * nloc) {
            __builtin_amdgcn_fence(__ATOMIC_RELEASE, "agent");
            asm volatile("s_waitcnt vmcnt(0)" ::: "memory");
            const unsigned og = xb_add(&bar[XB_TOP], 1u);
            const unsigned tg = og / nx;
            if (og + 1u == (tg + 1u) * nx) xb_add(&bar[XB_TOPGEN], 1u);
            else XB_SPIN(xb_ld(&bar[XB_TOPGEN]) == tg, bar);
            __builtin_amdgcn_fence(__ATOMIC_ACQUIRE, "agent");
            xb_add(&bar[XB_XGEN(b.x)], 1u);
            asm volatile("s_waitcnt vmcnt(0)" ::: "memory");
        } else {
            XB_SPIN(xb_ld(&bar[XB_XGEN(b.x)]) == gen, bar);
            __builtin_amdgcn_fence(__ATOMIC_ACQUIRE, "agent");
            asm volatile("s_waitcnt vmcnt(0)" ::: "memory");
        }
    }
    __syncthreads();
}
struct FSwiglu {
    bf16* H;
    DI void operator()(int row, int col, f32x4 lo, f32x4 hi) const {
        f32x4 r;
#pragma unroll
        for (int e = 0; e < 4; ++e) r[e] = silu_f(lo[e]) * hi[e];
        *(u32x2*)(H + (size_t)row * DFF + ((col >> 5) << 4) + (col & 15)) = pk4(r);
    }
};
struct FResid {
    const float* X; float* Z; long zrow_off; float s; int atomic, add_x;
    DI void operator()(int row, int col, f32x4 lo, f32x4 hi) const {
        const float* xp = X + (size_t)row * DM + col;
        float* zp = Z + ((long)row - zrow_off) * DM + col;
        f32x4 a = lo * s, b = hi * s;
        if (add_x) { a += *(const f32x4*)xp * DN_ALPHA; b += *(const f32x4*)(xp + 16) * DN_ALPHA; }
        if (atomic) {
#pragma unroll
            for (int e = 0; e < 4; ++e) { atomicAdd(zp + e, a[e]); atomicAdd(zp + 16 + e, b[e]); }
        } else { *(f32x4*)zp = a; *(f32x4*)(zp + 16) = b; }
    }
};
struct FBf16 {
    bf16* P; int ld;
    DI void operator()(int row, int col, f32x4 lo, f32x4 hi) const {
        bf16* p = P + (size_t)row * ld + col;
        *(u32x2*)p = pk4(lo); *(u32x2*)(p + 16) = pk4(hi);
    }
};
struct FF32 {
    float* P; int ld, row_off, col_off;
    DI void operator()(int row, int col, f32x4 lo, f32x4 hi) const {
        float* p = P + (size_t)(row - row_off) * ld + (col - col_off);
        *(f32x4*)p = lo; *(f32x4*)(p + 16) = hi;
    }
};
struct FQkv {
    bf16* QKV; float* QKVS; const float* rope; float* out; int j;
    DI void operator()(int row, int col, f32x4 lo, f32x4 hi) const {
        const int s = col / 3072, rem = col - s * 3072, g = rem >> 10, hh = (rem >> 7) & 7, d = rem & 127;
        const bool smp = row >= MP;
        const int pidx = smp ? TP + ((row - MP) & 3) : (row & (TP - 1));
        if (s < 2 && d < 16) {
            const f32x4 c = *(const f32x4*)(rope + (size_t)pidx * 32 + d), sn = *(const f32x4*)(rope + (size_t)pidx * 32 + 16 + d);
            const f32x4 x1 = lo, x2 = hi;
            lo = x1 * c - x2 * sn; hi = x2 * c + x1 * sn;
        }
        const int keep = 128 << (2 * g);
        if (!smp) {
            bf16* p = QKV + (size_t)row * AQKV + col;
            *(u32x2*)p = pk4(lo); *(u32x2*)(p + 16) = pk4(hi);
            if (s >= 1) {
                const int t = row & (TP - 1), b = row >> 12;
                if (t >= TP - keep) {
                    float* dst = out + (g == 0 ? O_A128P : g == 1 ? O_A512P : O_A2048P) + ((((size_t)(j * NBP + b) * keep + (t - (TP - keep))) * 2 + (s - 1)) * 8 + hh) * 128 + d;
                    *(f32x4*)dst = lo; *(f32x4*)(dst + 16) = hi;
                }
            }
        } else {
            const int r = row - MP, b = r >> 2, t = r & 3;
            float* p = QKVS + (size_t)r * AQKV + col;
            *(f32x4*)p = lo; *(f32x4*)(p + 16) = hi;
            if (s >= 1) {
                float* dst = out + (g == 0 ? O_A128S : g == 1 ? O_A512S : O_A2048S) + ((((size_t)(j * 8 + b) * keep + (keep - 4 + t)) * 2 + (s - 1)) * 8 + hh) * 128 + d;
                *(f32x4*)dst = lo; *(f32x4*)(dst + 16) = hi;
            }
        }
    }
};
template <class F> struct EpiWrap {
    static constexpr bool PERM = false, AFTER_DRAIN = false;
    F f;
    DI void operator()(const pg8::f32x4 (&acc)[2][2][4][2], const pg8::Unit& u, int wr, int wc, int fr, int fq) const {
#pragma unroll
        for (int ai = 0; ai < 2; ++ai)
#pragma unroll
            for (int m = 0; m < 4; ++m) {
                const int row = u.pm * 256 + ai * 128 + wr * 64 + m * 16 + fr;
#pragma unroll
                for (int bj = 0; bj < 2; ++bj) f(row, u.pn * 256 + bj * 128 + wc * 32 + 4 * fq, acc[ai][bj][m][0], acc[ai][bj][m][1]);
            }
    }
};

template <int NF, class F>
DI void skinny_unit(const Frame& Fr, const bf16* A, int lda, int row0, const bf16* Wt, int K, int f0, int kbeg, int klen, const F& f) {
    const int lane = Fr.lane, w = Fr.wave, r = lane & 31, h = lane >> 5;
    const int kw = klen >> 3, k0 = kbeg + w * kw;
    f32x16 acc[NF];
#pragma unroll
    for (int nf = 0; nf < NF; ++nf)
#pragma unroll
        for (int i = 0; i < 16; ++i) acc[nf][i] = 0.f;
    const bf16* ap = A + (size_t)(row0 + r) * lda + k0 + 8 * h;
    const bf16* wp = Wt + (size_t)(f0 + r) * K + k0 + 8 * h;
#pragma unroll 4
    for (int k = 0; k < kw; k += 16) {
        const bf16x8 b = *(const bf16x8*)(ap + k);
#pragma unroll
        for (int nf = 0; nf < NF; ++nf) {
            const bf16x8 a = *(const bf16x8*)(wp + (size_t)nf * 32 * K + k);
            acc[nf] = __builtin_amdgcn_mfma_f32_32x32x16_bf16(a, b, acc[nf], 0, 0, 0);
        }
    }
    LAS float* red = (LAS float*)Fr.lds;
#pragma unroll
    for (int nf = 0; nf < NF; ++nf)
#pragma unroll
        for (int i = 0; i < 16; ++i) red[((w * NF + nf) * 16 + i) * 64 + lane] = acc[nf][i];
    __syncthreads();
    if (w < 2 * NF) {
        const int nf = w >> 1, g = w & 1;
        f32x4 lo = {0.f, 0.f, 0.f, 0.f}, hi = {0.f, 0.f, 0.f, 0.f};
#pragma unroll
        for (int ww = 0; ww < 8; ++ww)
#pragma unroll
            for (int e = 0; e < 4; ++e) {
                lo[e] += red[((ww * NF + nf) * 16 + 4 * g + e) * 64 + lane];
                hi[e] += red[((ww * NF + nf) * 16 + 4 * g + 8 + e) * 64 + lane];
            }
        f(row0 + r, f0 + 32 * nf + 8 * g + 4 * h, lo, hi);
    }
    __syncthreads();
}
#define MFMA32(a, b, c) __builtin_amdgcn_mfma_f32_32x32x16_bf16((a), (b), (c), 0, 0, 0)
DI s16x4 lds_tr(LAS const uchar* p) { return __builtin_amdgcn_ds_read_tr16_b64_v4i16((LAS s16x4*)p); }
DI bf16x8 frag_xk(LAS const uchar* base, int ld, int x0, int k0, int lane) {
    return *(LAS const bf16x8*)(base + (x0 + (lane & 31)) * ld + (k0 + 8 * (lane >> 5)) * 2);
}
DI bf16x8 frag_kx(LAS const uchar* base, int ld, int x0, int k0, int lane) {
    const int h = lane >> 5, blk = (lane >> 4) & 1, q = (lane & 15) >> 2, p = lane & 3;
    LAS const uchar* a = base + (k0 + 8 * h + q) * ld + (x0 + 16 * blk + 4 * p) * 2;
    const s16x4 lo = lds_tr(a), hi = lds_tr(a + 4 * ld);
    return __builtin_shufflevector(lo, hi, 0, 1, 2, 3, 4, 5, 6, 7);
}
DI bf16x8 frag_kx_perm(LAS const uchar* base, int ld, int x0, int k0, int lane) {
    const int h = lane >> 5, blk = (lane >> 4) & 1, q = (lane & 15) >> 2, p = lane & 3;
    LAS const uchar* a = base + (k0 + 4 * h + q) * ld + (x0 + 16 * blk + 4 * p) * 2;
    const s16x4 lo = lds_tr(a), hi = lds_tr(a + 8 * ld);
    return __builtin_shufflevector(lo, hi, 0, 1, 2, 3, 4, 5, 6, 7);
}
DI bf16x8 pack_step(const f32x16& x, int s) {
    u32x4 p;
    p.x = pk2(x[8 * s + 0], x[8 * s + 1]); p.y = pk2(x[8 * s + 2], x[8 * s + 3]); p.z = pk2(x[8 * s + 4], x[8 * s + 5]); p.w = pk2(x[8 * s + 6], x[8 * s + 7]);
    return __builtin_bit_cast(bf16x8, p);
}
DI f32x16 zero16() { f32x16 z;
#pragma unroll
    for (int i = 0; i < 16; ++i) z[i] = 0.f; return z; }
template <bool A_KX, bool B_KX>
DI f32x16 mm_tile(f32x16 acc, LAS const uchar* A, int lda, int am0, LAS const uchar* B, int ldb, int bn0, int ksteps, int lane) {
#pragma unroll 4
    for (int s = 0; s < ksteps; ++s) {
        const bf16x8 a = A_KX ? frag_kx(A, lda, am0, 16 * s, lane) : frag_xk(A, lda, am0, 16 * s, lane);
        const bf16x8 b = B_KX ? frag_kx(B, ldb, bn0, 16 * s, lane) : frag_xk(B, ldb, bn0, 16 * s, lane);
        acc = MFMA32(a, b, acc);
    }
    return acc;
}

DI void tr_item(const WDesc& d, int item, LAS float* scr, int lane) {
    const int nnt = d.N >> 6, kt = item / nnt, nt = item - kt * nnt, k0 = kt << 6, n0 = nt << 6;
    const float* src = d.src + (size_t)k0 * d.N + n0 + 4 * (lane & 15);
#pragma unroll 8
    for (int i = 0; i < 16; ++i) {
        const int kk = 4 * i + (lane >> 4);
        const f32x4 v = *(const f32x4*)(src + (size_t)kk * d.N);
        LAS float* s = scr + kk * 65 + 4 * (lane & 15);
        s[0] = v[0]; s[1] = v[1]; s[2] = v[2]; s[3] = v[3];
    }
    asm volatile("s_waitcnt lgkmcnt(0)" ::: "memory");
    const int c = lane & 7;
#pragma unroll
    for (int j = 0; j < 8; ++j) {
        const int n = (lane >> 3) + 8 * j;
        LAS const float* s = scr + (8 * c) * 65 + n;
        u32x4 o; o.x = pk2(s[0], s[65]); o.y = pk2(s[2 * 65], s[3 * 65]); o.z = pk2(s[4 * 65], s[5 * 65]); o.w = pk2(s[6 * 65], s[7 * 65]);
        const int ns = n0 + n;
        int drow = ns;
        if (d.mode == 1) { const int jj = ns < DFF ? ns : ns - DFF; drow = ((jj >> 4) << 5) + (ns < DFF ? 0 : 16) + (jj & 15); }
        *(u32x4*)(d.dst + (size_t)drow * d.K + k0 + 8 * c) = o;
    }
    asm volatile("s_waitcnt lgkmcnt(0)" ::: "memory");
}
DI void convert_items(const Frame& F, const Args& a, int i0, int i1, int gw, int ngw) {
    LAS float* scr = (LAS float*)(F.lds + F.wave * 16640);
    for (int it = i0 + gw; it < i1; it += ngw) {
        int m = 0;
#pragma unroll 1
        for (int q = 1; q < NWD; ++q) if (it >= a.wd[q].item0) m = q;
        tr_item(a.wd[m], it - a.wd[m].item0, scr, F.lane);
    }
}
constexpr int CC_PER0 = 124 * 512, CC_PER1 = 508 * 512, CC_PER2 = 2044 * 512, CC_T0 = 16 * CC_PER0, CC_T1 = CC_T0 + 16 * CC_PER1, CC_TOT = CC_T1 + 16 * CC_PER2;
DI void cache_copy(const Args& a, int f0, int f1, int gt, int nt) {
    for (int i = f0 + gt; i < f1; i += nt) {
        const int g = i < CC_T0 ? 0 : i < CC_T1 ? 1 : 2;
        const int li = i - (g == 0 ? 0 : g == 1 ? CC_T0 : CC_T1), per = g == 0 ? CC_PER0 : g == 1 ? CC_PER1 : CC_PER2, wb = 128 << (2 * g);
        const int blk = li / per, o = li - blk * per;
        const float* src = g == 0 ? a.in[2] : g == 1 ? a.in[3] : a.in[4];
        float* dst = a.out + (g == 0 ? O_A128S : g == 1 ? O_A512S : O_A2048S);
        const size_t base = (size_t)blk * wb * 2048;
        *(f32x4*)(dst + base + (size_t)o * 4) = *(const f32x4*)(src + base + 8192 + (size_t)o * 4);
    }
}
DI void bg_slot(const Frame& F, const Args& a, int k, int first) {
    if (F.bid < first || F.G <= first) return;
    convert_items(F, a, a.slot[k][0], a.slot[k][1], (F.bid - first) * NWAVES + F.wave, (F.G - first) * NWAVES);
}
DI void prologue(const Frame& F, const Args& a) {
    uchar* ws = a.ws;
    convert_items(F, a, a.slot[0][0], a.slot[0][1], F.gw, F.NGW);
    const int gt = F.gw * 64 + F.lane, NT = F.NGW * 64;
    {
        float* rope = (float*)(ws + WS_ROPE);
        for (int i = gt; i < 4100 * 16; i += NT) {
            const int pidx = i >> 4, f = i & 15;
            const int pos = pidx < TP ? pidx : PASTLEN + (pidx - TP);
            const float inv = (float)exp2(-(double)f * (18.931568569324174 / 16.0));
            const float ang = (float)pos * inv;
            const double rev = (double)ang * 0.15915494309189535;
            const float fr = (float)(rev - floor(rev));
            rope[(size_t)pidx * 32 + f] = __builtin_amdgcn_cosf(fr);
            rope[(size_t)pidx * 32 + 16 + f] = __builtin_amdgcn_sinf(fr);
        }
    }
    { f32x4* z = (f32x4*)(ws + WS_ZS); const f32x4 zz = {0.f, 0.f, 0.f, 0.f}; for (int i = gt; i < (int)(12 * ZS_ONE / 16); i += NT) z[i] = zz; }
    {
        float* X = a.out; bf16* XB = (bf16*)(ws + WS_XB);
        for (int i = gt; i < MALL * DM / 4; i += NT) {
            const size_t e = (size_t)i * 4;
            const f32x4 v = e < (size_t)MP * DM ? *(const f32x4*)(a.in[0] + e) : *(const f32x4*)(a.in[1] + (e - (size_t)MP * DM));
            *(f32x4*)(X + e) = v; *(u32x2*)(XB + e) = pk4(v);
        }
    }
}

DI void ln_phase(const Frame& F, const float* Zp, const float* Zs, const float* g, const float* b, float* X, bf16* XB) {
    f32x4 gv[8], bv[8];
#pragma unroll
    for (int j = 0; j < 8; ++j) { gv[j] = *(const f32x4*)(g + 4 * F.lane + 256 * j); bv[j] = *(const f32x4*)(b + 4 * F.lane + 256 * j); }
    for (int row = F.gw; row < MALL; row += F.NGW) {
        const float* z = row < MP ? Zp + (size_t)row * DM : Zs + (size_t)(row - MP) * DM;
        f32x4 v[8]; float s = 0.f;
#pragma unroll
        for (int j = 0; j < 8; ++j) { v[j] = *(const f32x4*)(z + 4 * F.lane + 256 * j); s += (v[j][0] + v[j][1]) + (v[j][2] + v[j][3]); }
        const float mean = wave_sum(s) * (1.f / DM); float s2 = 0.f;
#pragma unroll
        for (int j = 0; j < 8; ++j) { v[j] = v[j] - mean; s2 += (v[j][0] * v[j][0] + v[j][1] * v[j][1]) + (v[j][2] * v[j][2] + v[j][3] * v[j][3]); }
        const float rstd = 1.f / sqrtf(wave_sum(s2) * (1.f / DM) + LN_EPS);
        float* xo = X + (size_t)row * DM + 4 * F.lane; bf16* xb = XB + (size_t)row * DM + 4 * F.lane;
#pragma unroll
        for (int j = 0; j < 8; ++j) { const f32x4 y = v[j] * rstd * gv[j] + bv[j]; *(f32x4*)(xo + 256 * j) = y; *(u32x2*)(xb + 256 * j) = pk4(y); }
    }
}
DI void attn_prompt_unit(const Frame& F, int u, const bf16* QKV, bf16* OG, float* LSE, bf16* O) {
    const int b = u >> 6, hd = (u >> 3) & 7, ck = u & 7;
    const int lane = F.lane, w = F.wave, qi = lane & 31, h = lane >> 5;
    constexpr int LDV = 272;
    LAS uchar* Vl = F.lds + w * (32 * LDV);
    const float SC = 0.08838834764831845f * 1.4426950408889634f;
    for (int it = 0; it < 6; ++it) {
        const int tl = w + 8 * it, g = tl >> 4, idx = tl & 15;
        const int dil = 1 << (2 * g);
        int r, Lb;
        if (g == 0) { r = 0; Lb = ck * 512 + 32 * idx; } else if (g == 1) { r = idx & 3; Lb = ck * 128 + 32 * (idx >> 2); } else { r = idx; Lb = ck * 32; }
        const int rowb = b * TP;
        const int colQ = g * 1024 + hd * 128, colK = 3072 + colQ, colV = 6144 + colQ;
        bf16x8 qf[8];
        {
            const unsigned qo = (unsigned)(((rowb + r + dil * (Lb + qi)) * AQKV + colQ + 8 * h) * 2);
#pragma unroll
            for (int s = 0; s < 8; ++s) qf[s] = ldg<bf16x8>(QKV, qo + 32 * s);
        }
        f32x16 st[5];
#pragma unroll
        for (int kb = 0; kb < 5; ++kb) {
            int Lk = Lb - 128 + 32 * kb + qi; if (Lk < 0) Lk = 0;
            const unsigned ko = (unsigned)(((rowb + r + dil * Lk) * AQKV + colK + 8 * h) * 2);
            f32x16 acc = zero16();
#pragma unroll
            for (int s = 0; s < 8; ++s) { const bf16x8 kf = ldg<bf16x8>(QKV, ko + 32 * s); acc = MFMA32(kf, qf[s], acc); }
            st[kb] = acc;
        }
        float m = -INFINITY;
        {
            int lo = qi; if (128 - Lb > lo) lo = 128 - Lb;
            const int a0 = 4 * h - lo, b0 = 128 + qi - 4 * h;
#pragma unroll
            for (int kb = 0; kb < 5; ++kb)
#pragma unroll
                for (int i = 0; i < 16; ++i) {
                    const int cst = 32 * kb + (i & 3) + 8 * (i >> 2);
                    const unsigned msk = (unsigned)(((a0 + cst) | (b0 - cst)) >> 31);
                    const unsigned xb = __float_as_uint(st[kb][i] * SC);
                    const float sv = __uint_as_float((xb & ~msk) | (0xff800000u & msk));
                    st[kb][i] = sv; m = fmaxf(m, sv);
                }
        }
        m = fmaxf(m, __shfl_xor(m, 32));
        float l = 0.f;
#pragma unroll
        for (int kb = 0; kb < 5; ++kb)
#pragma unroll
            for (int i = 0; i < 16; ++i) { const float p = exp2f(st[kb][i] - m); st[kb][i] = p; l += p; }
        l += __shfl_xor(l, 32);
        f32x16 ot[4];
#pragma unroll
        for (int c = 0; c < 4; ++c) ot[c] = zero16();
#pragma unroll
        for (int kb = 0; kb < 5; ++kb) {
#pragma unroll
            for (int i = 0; i < 8; ++i) {
                const int cid = lane + 64 * i, key = cid >> 4, ch = cid & 15;
                int Lk = Lb - 128 + 32 * kb + key; if (Lk < 0) Lk = 0;
                const u32x4 v = ldg<u32x4>(QKV, (unsigned)(((rowb + r + dil * Lk) * AQKV + colV + 8 * ch) * 2));
                *(LAS u32x4*)(Vl + key * LDV + ch * 16) = v;
            }
#pragma unroll
            for (int s = 0; s < 2; ++s) {
                const bf16x8 pb = pack_step(st[kb], s);
#pragma unroll
                for (int c = 0; c < 4; ++c) { const bf16x8 af = frag_kx_perm(Vl, LDV, 32 * c, 16 * s, lane); ot[c] = MFMA32(af, pb, ot[c]); }
            }
        }
        const float rl = 1.f / l;
        const int orow = rowb + r + dil * (Lb + qi);
        const unsigned oo = (unsigned)((((g * MP + orow) * 1024) + hd * 128 + 4 * h) * 2);
#pragma unroll
        for (int c = 0; c < 4; ++c)
#pragma unroll
            for (int gq = 0; gq < 4; ++gq) {
                f32x4 v = {ot[c][4 * gq] * rl, ot[c][4 * gq + 1] * rl, ot[c][4 * gq + 2] * rl, ot[c][4 * gq + 3] * rl};
                stg<u32x2>(OG, oo + (32 * c + 8 * gq) * 2, pk4(v));
            }
        if (h == 0) stg<float>(LSE, (unsigned)(((g * MP + orow) * 8 + hd) * 4), (m + log2f(l)) * 0.6931471805599453f);
    }
    asm volatile("s_waitcnt vmcnt(0)" ::: "memory");
    __syncthreads();
    __builtin_amdgcn_fence(__ATOMIC_ACQUIRE, "agent");
    const int l16 = F.tid & 15;
#pragma unroll 2
    for (int it = 0; it < 16; ++it) {
        const int tok = ck * 512 + (F.tid >> 4) + 32 * it;
        const int row = b * TP + tok;
        const float l0 = ldg<float>(LSE, (unsigned)((row * 8 + hd) * 4)), l1 = ldg<float>(LSE, (unsigned)(((MP + row) * 8 + hd) * 4)), l2 = ldg<float>(LSE, (unsigned)(((2 * MP + row) * 8 + hd) * 4));
        const float mx = fmaxf(l0, fmaxf(l1, l2));
        float w0 = __expf(l0 - mx), w1 = __expf(l1 - mx), w2 = __expf(l2 - mx);
        const float ws = 1.f / (w0 + w1 + w2); w0 *= ws; w1 *= ws; w2 *= ws;
        const unsigned off = (unsigned)((row * 1024 + hd * 128 + 8 * l16) * 2);
        const u32x4 a0 = ldg<u32x4>(OG, off), a1 = ldg<u32x4>(OG, off + MP * 1024 * 2), a2 = ldg<u32x4>(OG, off + 2 * MP * 1024 * 2);
        u32x4 o;
#pragma unroll
        for (int e = 0; e < 4; ++e)
            o[e] = pk2(w0 * bflo(a0[e]) + w1 * bflo(a1[e]) + w2 * bflo(a2[e]), w0 * bfhi(a0[e]) + w1 * bfhi(a1[e]) + w2 * bfhi(a2[e]));
        stg<u32x4>(O, off, o);
    }
    __syncthreads();
}

DI void attn_sample_unit(const Frame& F, int su, const float* QKVS, const float* cache0, const float* cache1, const float* cache2, int j, bf16* O) {
    const int b = su >> 5, hd = (su >> 2) & 7, t = su & 3;
    const int lane = F.lane, w = F.wave, l32 = lane & 31, hw = lane >> 5;
    LAS float* sc = (LAS float*)F.lds;
    LAS float* part = (LAS float*)(F.lds + 4096);
    if (w < 6) {
        const int g = w >> 1, half = w & 1, dil = 1 << (2 * g), wb = 128 << (2 * g);
        const int j0 = half * 65, cnt = half ? 64 : 65;
        const float* cg = (g == 0 ? cache0 : g == 1 ? cache1 : cache2) + ((size_t)(j * 8 + b) * wb) * 2048 + hd * 128 + 4 * l32;
        const float* qn = QKVS + (size_t)(b * 4) * AQKV + g * 1024 + hd * 128 + 4 * l32;
        const f32x4 q4 = *(const f32x4*)(qn + (size_t)t * AQKV);
#pragma unroll 4
        for (int it = 0; it < 33; ++it) {
            const int jl = 2 * it + hw;
            float s = 0.f;
            if (jl < cnt) {
                const int idx = wb + t - dil * (j0 + jl);
                const float* kp = idx >= wb ? qn + (size_t)(idx - wb) * AQKV + 3072 : cg + (size_t)idx * 2048;
                const f32x4 k4 = *(const f32x4*)kp;
                s = q4[0] * k4[0] + q4[1] * k4[1] + q4[2] * k4[2] + q4[3] * k4[3];
            }
#pragma unroll
            for (int o = 1; o < 32; o <<= 1) s += __shfl_xor(s, o);
            if (l32 == 0 && jl < cnt) sc[w * 80 + jl] = s * 0.08838834764831845f;
        }
        asm volatile("s_waitcnt lgkmcnt(0)" ::: "memory");
        float m = lane < cnt ? sc[w * 80 + lane] : -INFINITY;
        if (lane == 0 && cnt == 65) m = fmaxf(m, sc[w * 80 + 64]);
        m = wave_max(m);
        float lsum = 0.f; f32x4 acc = {0.f, 0.f, 0.f, 0.f};
#pragma unroll 4
        for (int it = 0; it < 33; ++it) {
            const int jl = 2 * it + hw;
            if (jl < cnt) {
                const int idx = wb + t - dil * (j0 + jl);
                const float* vp = idx >= wb ? qn + (size_t)(idx - wb) * AQKV + 6144 : cg + (size_t)idx * 2048 + 1024;
                const f32x4 v4 = *(const f32x4*)vp;
                const float p = __expf(sc[w * 80 + jl] - m);
                lsum += p; acc += v4 * p;
            }
        }
        lsum += __shfl_xor(lsum, 32);
#pragma unroll
        for (int e = 0; e < 4; ++e) acc[e] += __shfl_xor(acc[e], 32);
        if (lane == 0) { part[w * 136] = m; part[w * 136 + 1] = lsum; }
        if (lane < 32) *(LAS f32x4*)(part + w * 136 + 8 + 4 * l32) = acc;
    }
    __syncthreads();
    if (w == 0 && lane < 32) {
        float M = -INFINITY;
#pragma unroll
        for (int ww = 0; ww < 6; ++ww) M = fmaxf(M, part[ww * 136]);
        float L = 0.f; f32x4 o = {0.f, 0.f, 0.f, 0.f};
#pragma unroll
        for (int ww = 0; ww < 6; ++ww) { const float e = __expf(part[ww * 136] - M); L += part[ww * 136 + 1] * e; o += *(LAS const f32x4*)(part + ww * 136 + 8 + 4 * l32) * e; }
        o = o * (1.f / L);
        *(u32x2*)(O + (size_t)(MP + b * 4 + t) * 1024 + hd * 128 + 4 * l32) = pk4(o);
    }
    __syncthreads();
}
struct BPtrs {
    const bf16* PB; const float* EB; const float* PBS; bf16 *WG, *UG, *QG, *KG, *QKG; float* GCG; bf16* YB;
    const float *conv_w, *a_log, *dt_bias, *norm_w, *ssm0, *conv0;
    float *ssm_p, *ssm_s, *conv_p, *conv_s;
};
DI void bprep_unit(const Frame& F, int pu, const BPtrs& P) {
    const int b = pu >> 10, n = (pu >> 4) & 63, hq = pu & 15;
    int lane = F.lane, tid = F.tid; asm volatile("" : "+v"(lane), "+v"(tid));
    const int w = F.wave, t0 = n * 64;
    constexpr int LD = 272, LDT = 144;
    LAS uchar* Kl = F.lds; LAS uchar* V0l = F.lds + 17408; LAS uchar* V1l = F.lds + 34816; LAS uchar* Ql = F.lds + 52224;
    LAS float* Gkk = (LAS float*)(F.lds + 69632); LAS float* Gqk = (LAS float*)(F.lds + 86016);
    LAS float* LT = (LAS float*)(F.lds + 102400);
    LAS uchar* Tb = F.lds + 52224;
    LAS float* betaL = (LAS float*)(F.lds + 135168); LAS float* gcL = betaL + 128; LAS float* egL = gcL + 128;
    for (int it = 0; it < 8; ++it) {
        const int task = w + 8 * it, mt = task >> 4, rg = task & 15;
        const int i = 4 * rg + (lane >> 4), ch = lane & 15, t = t0 + i;
        const int cb = mt == 0 ? hq * 128 : mt == 1 ? 2048 + hq * 128 : 4096 + (2 * hq + (mt - 2)) * 128;
        const int col = cb + 8 * ch;
        float y[8];
#pragma unroll
        for (int e = 0; e < 8; ++e) y[e] = 0.f;
#pragma unroll
        for (int jj = 0; jj < 4; ++jj) {
            const int tt = t - 3 + jj;
            u32x4 x = {0u, 0u, 0u, 0u};
            if (tt >= 0) x = ldg<u32x4>(P.PB, (unsigned)(((b * TP + tt) * BINM + col) * 2));
            const f32x4 w0 = ldg<f32x4>(P.conv_w, (unsigned)((jj * 8192 + col) * 4)), w1 = ldg<f32x4>(P.conv_w, (unsigned)((jj * 8192 + col + 4) * 4));
            y[0] += bflo(x[0]) * w0[0]; y[1] += bfhi(x[0]) * w0[1]; y[2] += bflo(x[1]) * w0[2]; y[3] += bfhi(x[1]) * w0[3];
            y[4] += bflo(x[2]) * w1[0]; y[5] += bfhi(x[2]) * w1[1]; y[6] += bflo(x[3]) * w1[2]; y[7] += bfhi(x[3]) * w1[3];
        }
        float ss = 0.f;
#pragma unroll
        for (int e = 0; e < 8; ++e) { y[e] = silu_f(y[e]); ss += y[e] * y[e]; }
        if (mt < 2) {
#pragma unroll
            for (int o = 1; o < 16; o <<= 1) ss += __shfl_xor(ss, o);
            const float rn = rsqrtf(ss + 1e-6f) * (mt == 0 ? 0.08838834764831845f : 1.f);
#pragma unroll
            for (int e = 0; e < 8; ++e) y[e] *= rn;
        }
        u32x4 o; o.x = pk2(y[0], y[1]); o.y = pk2(y[2], y[3]); o.z = pk2(y[4], y[5]); o.w = pk2(y[6], y[7]);
        LAS uchar* dst = mt == 0 ? Ql : mt == 1 ? Kl : mt == 2 ? V0l : V1l;
        *(LAS u32x4*)(dst + i * LD + ch * 16) = o;
        if (mt == 0) stg<u32x4>(P.QG, (unsigned)((((b * 16 + hq) * TP + t) * 128 + 8 * ch) * 2), o);
        if (mt == 1) stg<u32x4>(P.KG, (unsigned)((((b * 16 + hq) * TP + t) * 128 + 8 * ch) * 2), o);
    }
    __syncthreads();
    {
        const int which = w >> 2, ti = (w >> 1) & 1, tj = w & 1;
        f32x16 acc = mm_tile<false, false>(zero16(), which ? Ql : Kl, LD, 32 * ti, Kl, LD, 32 * tj, 8, lane);
        LAS float* G = which ? Gqk : Gkk;
#pragma unroll
        for (int i = 0; i < 16; ++i) G[(32 * ti + crow(i, lane >> 5)) * 64 + 32 * tj + (lane & 31)] = acc[i];
    }
    if (w < 2) {
        const int hv = 2 * hq + w, t = t0 + lane;
        const float braw = ldg<float>(P.EB, (unsigned)(((b * TP + t) * 64 + hv) * 4)), araw = ldg<float>(P.EB, (unsigned)(((b * TP + t) * 64 + 32 + hv) * 4));
        const float beta = sigmoid_f(braw);
        float gc = -__expf(P.a_log[hv]) * softplus_f(araw + P.dt_bias[hv]);
#pragma unroll
        for (int o = 1; o < 64; o <<= 1) { const float v = __shfl_up(gc, o); if (lane >= o) gc += v; }
        betaL[w * 64 + lane] = beta; gcL[w * 64 + lane] = gc; egL[w * 64 + lane] = __expf(gc);
        stg<float>(P.GCG, (unsigned)(((b * 32 + hv) * TP + t) * 4), gc);
    }
    __syncthreads();
#pragma unroll 1
    for (int hvl = 0; hvl < 2; ++hvl) {
        const int hv = 2 * hq + hvl;
        for (int idx = tid; idx < 4096; idx += 512) {
            const int r = idx >> 6, c = idx & 63;
            const float gj = gcL[hvl * 64 + c], gr = gcL[hvl * 64 + r];
            LT[(hvl * 64 + r) * 64 + c] = (c > r) ? betaL[hvl * 64 + c] * Gkk[c * 64 + r] * __expf(gj - gr) : 0.f;
            const float qv = (r >= c) ? Gqk[r * 64 + c] * __expf(gr - gj) : 0.f;
            stg<bf16>(P.QKG, (unsigned)((((((b * 32 + hv) * 64 + n) * 64 + r) * 64) + c) * 2), (bf16)(pk2(qv, 0.f) & 0xffffu));
        }
    }
    __syncthreads();
    asm volatile("" : "+v"(lane), "+v"(tid));
    if (w < 2) {
        float t[64];
#pragma unroll
        for (int c = 0; c < 64; ++c) t[c] = 0.f;
        unsigned lt_a = (unsigned)(size_t)(LT + w * 4096), be_a = (unsigned)(size_t)(betaL + w * 64), eg_a = (unsigned)(size_t)(egL + w * 64);
        asm volatile("" : "+v"(lt_a), "+v"(be_a), "+v"(eg_a));
        LAS const float* lt = (LAS const float*)(size_t)lt_a; LAS const float* bel = (LAS const float*)(size_t)be_a; LAS const float* egl = (LAS const float*)(size_t)eg_a;
#pragma unroll
        for (int c = 63; c >= 0; --c) {
            asm volatile("" ::: "memory");
            float acc = (lane == c) ? 1.f : 0.f;
#pragma unroll
            for (int jb = (c + 1) >> 2; jb < 16; ++jb) {
                const f32x4 l4 = *(LAS const f32x4*)(lt + c * 64 + 4 * jb);
                acc -= t[4 * jb] * l4[0]; acc -= t[4 * jb + 1] * l4[1]; acc -= t[4 * jb + 2] * l4[2]; acc -= t[4 * jb + 3] * l4[3];
            }
            asm volatile("" : "+v"(acc) :: "memory");
            t[c] = acc;
        }
        LAS uchar* tb0 = Tb + (w * 2 + 0) * (64 * LDT) + lane * LDT; LAS uchar* tb1 = Tb + (w * 2 + 1) * (64 * LDT) + lane * LDT;
#pragma unroll
        for (int q = 0; q < 8; ++q) {
            float a[8], c2[8];
            const f32x4 b0 = *(LAS const f32x4*)(bel + 8 * q), b1 = *(LAS const f32x4*)(bel + 8 * q + 4), e0 = *(LAS const f32x4*)(egl + 8 * q), e1 = *(LAS const f32x4*)(egl + 8 * q + 4);
#pragma unroll
            for (int e = 0; e < 4; ++e) { a[e] = t[8 * q + e] * b0[e]; c2[e] = a[e] * e0[e]; a[4 + e] = t[8 * q + 4 + e] * b1[e]; c2[4 + e] = a[4 + e] * e1[e]; }
            u32x4 o0, o1; o0.x = pk2(a[0], a[1]); o0.y = pk2(a[2], a[3]); o0.z = pk2(a[4], a[5]); o0.w = pk2(a[6], a[7]);
            o1.x = pk2(c2[0], c2[1]); o1.y = pk2(c2[2], c2[3]); o1.z = pk2(c2[4], c2[5]); o1.w = pk2(c2[6], c2[7]);
            *(LAS u32x4*)(tb0 + 16 * q) = o0; *(LAS u32x4*)(tb1 + 16 * q) = o1;
        }
    }
    __syncthreads();
    asm volatile("" : "+v"(lane), "+v"(tid));
    {
        const int hvl = w >> 2, hv = 2 * hq + hvl;
#pragma unroll 1
        for (int tt = 0; tt < 4; ++tt) {
            const int id = (w & 3) * 4 + tt, which = id >> 3, ti = (id >> 2) & 1, c = id & 3;
            f32x16 acc = mm_tile<false, true>(zero16(), Tb + (hvl * 2 + which) * (64 * LDT), LDT, 32 * ti, which ? Kl : (hvl ? V1l : V0l), LD, 32 * c, 4, lane);
            bf16* dstb = which ? P.WG : P.UG;
            const unsigned dof = (unsigned)(((((b * 32 + hv) * TP + t0 + 32 * ti + 4 * (lane >> 5)) * 128) + 32 * c + (lane & 31)) * 2);
#pragma unroll
            for (int i = 0; i < 16; ++i) stg<bf16>(dstb, dof + ((i & 3) + 8 * (i >> 2)) * 256, (bf16)(pk2(acc[i], 0.f) & 0xffffu));
        }
    }
    __syncthreads();
}
DI void bchain_unit(const Frame& F, int cu, const BPtrs& P) {
    const int b = cu >> 5, hv = cu & 31, hq = hv >> 1;
    const int lane = F.lane, w = F.wave, tid_ = F.tid, tid = tid_, h = lane >> 5, l32 = lane & 31;
    constexpr int LD = 272, LDQ = 144, LDO = 528;
    LAS uchar* Wl = F.lds; LAS uchar* Ql = F.lds + 17408; LAS uchar* Kl = F.lds + 34816; LAS uchar* QKl = F.lds + 52224;
    LAS uchar* Sb = F.lds + 61440; LAS uchar* VNl = F.lds + 96256; LAS uchar* VNd = F.lds + 113664;
    LAS float* gcL = (LAS float*)(F.lds + 131072); LAS float* egL = gcL + 64;
    LAS uchar* Ol = F.lds;
    const bf16* wg = P.WG + ((size_t)b * 32 + hv) * TP * 128; const bf16* ug = P.UG + ((size_t)b * 32 + hv) * TP * 128;
    const bf16* qg = P.QG + ((size_t)b * 16 + hq) * TP * 128; const bf16* kg = P.KG + ((size_t)b * 16 + hq) * TP * 128;
    const bf16* qkg = P.QKG + ((size_t)b * 32 + hv) * 64 * 4096; const float* gcg = P.GCG + ((size_t)b * 32 + hv) * TP;
    const int kb = w & 3, c0 = 2 * (w >> 2);
    f32x16 S0 = zero16(), S1 = zero16();
    for (int i = tid; i < 128 * LD / 4; i += 512) ((LAS unsigned*)Sb)[i] = 0u;
    const int ti = w >> 2, tc = w & 3;
    u32x4 pw[2], pq[2], pk[2], pqk; float pg = 0.f;
    {
#pragma unroll
        for (int k = 0; k < 2; ++k) { const unsigned go = (unsigned)((tid + 512 * k) * 16); pw[k] = ldg<u32x4>(wg, go); pq[k] = ldg<u32x4>(qg, go); pk[k] = ldg<u32x4>(kg, go); }
        pqk = ldg<u32x4>(qkg, (unsigned)(tid * 16));
        if (tid < 64) pg = ldg<float>(gcg, (unsigned)(tid * 4));
    }
#pragma unroll 1
    for (int n = 0; n < 64; ++n) {
        const int t0 = n * 64;
        int tid = tid_; asm volatile("" : "+v"(tid));
        const int lane = tid & 63, h = lane >> 5, l32 = lane & 31;
#pragma unroll
        for (int k = 0; k < 2; ++k) {
            const int cid = tid + 512 * k, r = cid >> 4, ch = cid & 15;
            *(LAS u32x4*)(Wl + r * LD + ch * 16) = pw[k]; *(LAS u32x4*)(Ql + r * LD + ch * 16) = pq[k]; *(LAS u32x4*)(Kl + r * LD + ch * 16) = pk[k];
        }
        { const int r = tid >> 3, ch = tid & 7; *(LAS u32x4*)(QKl + r * LDQ + ch * 16) = pqk; }
        if (tid < 64) { gcL[tid] = pg; egL[tid] = __expf(pg); }
        __syncthreads();
        if (n < 63) {
            const unsigned nx = (unsigned)((t0 + 64) * 256);
#pragma unroll
            for (int k = 0; k < 2; ++k) { const unsigned go = nx + (unsigned)((tid + 512 * k) * 16); pw[k] = ldg<u32x4>(wg, go); pq[k] = ldg<u32x4>(qg, go); pk[k] = ldg<u32x4>(kg, go); }
            pqk = ldg<u32x4>(qkg, (unsigned)((n + 1) * 8192 + tid * 16));
            if (tid < 64) pg = ldg<float>(gcg, (unsigned)((t0 + 64 + tid) * 4));
        }
        const float glast = gcL[63];
        float uu[16];
        {
            const char* upb = (const char*)(ug + (size_t)(t0 + 32 * ti) * 128 + 32 * tc);
            const unsigned uo = (unsigned)((4 * h * 128 + l32) * 2);
#pragma unroll
            for (int i = 0; i < 16; ++i) uu[i] = bf2f(*(const bf16*)(upb + uo + (unsigned)(((i & 3) + 8 * (i >> 2)) * 256)));
        }
        f32x16 vn = mm_tile<false, true>(zero16(), Wl, LD, 32 * ti, Sb, LD, 32 * tc, 8, lane);
        {
#pragma unroll
            for (int i = 0; i < 16; ++i) {
                const int r = crow(i, h);
                const float v = uu[i] - vn[i];
                const float vd = v * __expf(glast - gcL[32 * ti + r]);
                *(LAS bf16*)(VNl + (32 * ti + r) * LD + (32 * tc + l32) * 2) = (bf16)(pk2(v, 0.f) & 0xffffu);
                *(LAS bf16*)(VNd + (32 * ti + r) * LD + (32 * tc + l32) * 2) = (bf16)(pk2(vd, 0.f) & 0xffffu);
            }
        }
        __syncthreads();
        f32x16 o = mm_tile<false, true>(zero16(), Ql, LD, 32 * ti, Sb, LD, 32 * tc, 8, lane);
#pragma unroll
        for (int i = 0; i < 16; ++i) o[i] *= egL[32 * ti + crow(i, h)];
        o = mm_tile<false, true>(o, QKl, LDQ, 32 * ti, VNl, LD, 32 * tc, 4, lane);
        {
            const float el = __expf(glast);
#pragma unroll
            for (int i = 0; i < 16; ++i) { S0[i] *= el; S1[i] *= el; }
            S0 = mm_tile<true, true>(S0, Kl, LD, 32 * kb, VNd, LD, 32 * c0, 4, lane);
            S1 = mm_tile<true, true>(S1, Kl, LD, 32 * kb, VNd, LD, 32 * (c0 + 1), 4, lane);
        }
        u32x4 z0, z1;
        {
            const int r = tid >> 3, part = tid & 7;
            const char* zp = (const char*)(P.PB + ((size_t)b * TP + t0) * BINM + 8192 + hv * 128) + (unsigned)((r * BINM + 16 * part) * 2);
            z0 = *(const u32x4*)zp; z1 = *(const u32x4*)(zp + 16);
        }
        __syncthreads();
#pragma unroll
        for (int i = 0; i < 16; ++i) {
            const int r = 32 * kb + crow(i, h);
            *(LAS bf16*)(Sb + r * LD + (32 * c0 + l32) * 2) = (bf16)(pk2(S0[i], 0.f) & 0xffffu);
            *(LAS bf16*)(Sb + r * LD + (32 * (c0 + 1) + l32) * 2) = (bf16)(pk2(S1[i], 0.f) & 0xffffu);
            *(LAS float*)(Ol + (32 * ti + crow(i, h)) * LDO + (32 * tc + l32) * 4) = o[i];
        }
        __syncthreads();
        {
            const int r = tid >> 3, part = tid & 7;
            float ov[16]; float ss = 0.f;
#pragma unroll
            for (int q = 0; q < 4; ++q) { const f32x4 v = *(LAS const f32x4*)(Ol + r * LDO + (16 * part + 4 * q) * 4); ov[4 * q] = v[0]; ov[4 * q + 1] = v[1]; ov[4 * q + 2] = v[2]; ov[4 * q + 3] = v[3]; }
#pragma unroll
            for (int e = 0; e < 16; ++e) ss += ov[e] * ov[e];
            ss += __shfl_xor(ss, 1); ss += __shfl_xor(ss, 2); ss += __shfl_xor(ss, 4);
            const float rstd = rsqrtf(ss * (1.f / 128.f) + RMS_EPS);
            float nw[16];
#pragma unroll
            for (int q = 0; q < 4; ++q) { const f32x4 nv = ldg<f32x4>(P.norm_w, (unsigned)((16 * part + 4 * q) * 4)); nw[4 * q] = nv[0]; nw[4 * q + 1] = nv[1]; nw[4 * q + 2] = nv[2]; nw[4 * q + 3] = nv[3]; }
            u32x4 y0, y1;
#pragma unroll
            for (int e = 0; e < 4; ++e) {
                y0[e] = pk2(ov[2 * e] * rstd * nw[2 * e] * silu_f(bflo(z0[e])), ov[2 * e + 1] * rstd * nw[2 * e + 1] * silu_f(bfhi(z0[e])));
                y1[e] = pk2(ov[8 + 2 * e] * rstd * nw[8 + 2 * e] * silu_f(bflo(z1[e])), ov[8 + 2 * e + 1] * rstd * nw[8 + 2 * e + 1] * silu_f(bfhi(z1[e])));
            }
            char* yp = (char*)(P.YB + ((size_t)b * TP + t0) * 4096 + hv * 128) + (unsigned)((r * 4096 + 16 * part) * 2);
            *(u32x4*)yp = y0; *(u32x4*)(yp + 16) = y1;
        }
        __syncthreads();
    }
    {
        float* sp = P.ssm_p + ((size_t)b * 32 + hv) * 16384;
#pragma unroll
        for (int i = 0; i < 16; ++i) {
            const int r = 32 * kb + crow(i, h);
            sp[r * 128 + 32 * c0 + l32] = S0[i]; sp[r * 128 + 32 * (c0 + 1) + l32] = S1[i];
        }
    }
    __syncthreads();
}

DI void bsample_unit(const Frame& F, int su, const BPtrs& P) {
    const int b = su >> 5, hv = su & 31, hq = hv >> 1;
    const int tid = F.tid, lane = F.lane, w = F.wave, dv = tid & 127, qd = tid >> 7;
    LAS float* raw = (LAS float*)F.lds;
    LAS float* qv = raw + 1536; LAS float* kv = qv + 512; LAS float* vv = kv + 512;
    LAS float* part = vv + 512;
    LAS float* ov = part + 512;
    LAS float* scal = ov + 512;
    float s[32];
    {
        const float* s0 = P.ssm0 + ((size_t)b * 32 + hv) * 16384 + (32 * qd) * 128 + dv;
#pragma unroll
        for (int i = 0; i < 32; ++i) s[i] = s0[i * 128];
    }
    if (tid < 384) {
        const int which = tid >> 7, d = tid & 127;
        const int col = which == 0 ? hq * 128 + d : which == 1 ? 2048 + hq * 128 + d : 4096 + hv * 128 + d;
        float full[7];
#pragma unroll
        for (int r = 0; r < 3; ++r) full[r] = P.conv0[((size_t)b * 3 + r) * 8192 + col];
#pragma unroll
        for (int t = 0; t < 4; ++t) full[3 + t] = P.PBS[(size_t)(b * 4 + t) * BIN + col];
        const float w0 = P.conv_w[col], w1 = P.conv_w[8192 + col], w2 = P.conv_w[2 * 8192 + col], w3 = P.conv_w[3 * 8192 + col];
#pragma unroll
        for (int t = 0; t < 4; ++t) raw[(which * 4 + t) * 128 + d] = silu_f(full[t] * w0 + full[t + 1] * w1 + full[t + 2] * w2 + full[t + 3] * w3);
#pragma unroll
        for (int r = 0; r < 3; ++r) P.conv_s[((size_t)b * 3 + r) * 8192 + col] = full[4 + r];
    }
    if (tid < 4) {
        const float braw = P.PBS[(size_t)(b * 4 + tid) * BIN + 12288 + hv], araw = P.PBS[(size_t)(b * 4 + tid) * BIN + 12320 + hv];
        scal[tid] = sigmoid_f(braw); scal[4 + tid] = __expf(-__expf(P.a_log[hv]) * softplus_f(araw + P.dt_bias[hv]));
    }
    __syncthreads();
    {
        const int which = w >> 2, t = w & 3;
        const float a0 = raw[(which * 4 + t) * 128 + lane], a1 = raw[(which * 4 + t) * 128 + 64 + lane];
        const float rn = rsqrtf(wave_sum(a0 * a0 + a1 * a1) + 1e-6f) * (which == 0 ? 0.08838834764831845f : 1.f);
        LAS float* dst = which == 0 ? qv : kv;
        dst[t * 128 + lane] = a0 * rn; dst[t * 128 + 64 + lane] = a1 * rn;
        vv[tid] = raw[1024 + tid];
    }
    __syncthreads();
    for (int t = 0; t < 4; ++t) {
        const float beta = scal[t], eg = scal[4 + t];
        float p = 0.f;
#pragma unroll
        for (int i = 0; i < 32; ++i) p += kv[t * 128 + 32 * qd + i] * s[i];
        part[qd * 128 + dv] = p;
        __syncthreads();
        const float kS = (part[dv] + part[128 + dv]) + (part[256 + dv] + part[384 + dv]);
        const float vt = vv[t * 128 + dv];
        float po = 0.f;
#pragma unroll
        for (int i = 0; i < 32; ++i) {
            const float kk = kv[t * 128 + 32 * qd + i];
            s[i] = eg * (s[i] - beta * kk * kS) + beta * kk * vt;
            po += s[i] * qv[t * 128 + 32 * qd + i];
        }
        __syncthreads();
        part[qd * 128 + dv] = po;
        __syncthreads();
        if (qd == 0) ov[t * 128 + dv] = (part[dv] + part[128 + dv]) + (part[256 + dv] + part[384 + dv]);
        __syncthreads();
    }
    if (w < 4) {
        const int t = w;
        const float o0 = ov[t * 128 + lane], o1 = ov[t * 128 + 64 + lane];
        const float rstd = rsqrtf(wave_sum(o0 * o0 + o1 * o1) * (1.f / 128.f) + RMS_EPS);
        const float* zp = P.PBS + (size_t)(b * 4 + t) * BIN + 8192 + hv * 128;
        bf16* yp = P.YB + (size_t)(MP + b * 4 + t) * 4096 + hv * 128;
        yp[lane] = (bf16)(pk2(o0 * rstd * P.norm_w[lane] * silu_f(zp[lane]), 0.f) & 0xffffu);
        yp[64 + lane] = (bf16)(pk2(o1 * rstd * P.norm_w[64 + lane] * silu_f(zp[64 + lane]), 0.f) & 0xffffu);
    }
    {
        float* so = P.ssm_s + ((size_t)b * 32 + hv) * 16384 + (32 * qd) * 128 + dv;
#pragma unroll
        for (int i = 0; i < 32; ++i) so[i * 128] = s[i];
    }
    __syncthreads();
}
struct CPtrs {
    const bf16* PC; const float* EC; const float* PCS; float* DT; float* ACS; bf16* XBC; bf16* YC;
    const float *conv_w, *conv_b, *dt_bias, *a_log, *dskip, *norm_w, *ssm0, *conv0;
    float *ssm_p, *ssm_s, *conv_p, *conv_s;
};
DI void cpre_phase(const Frame& F, const CPtrs& P) {
    const int lane = F.lane;
    for (int it = F.gw; it < 1536 + 128; it += F.NGW) {
        if (it < 1536) {
            const int b = it / 768, cg = (it / 64) % 12, rb = it & 63, cc = cg * 512 + 8 * lane, t0 = rb * 64;
            float wt[4][8], bs[8];
#pragma unroll
            for (int jj = 0; jj < 4; ++jj) { const f32x4 w0 = ldg<f32x4>(P.conv_w, (unsigned)((jj * 6144 + cc) * 4)), w1 = ldg<f32x4>(P.conv_w, (unsigned)((jj * 6144 + cc + 4) * 4));
                wt[jj][0] = w0[0]; wt[jj][1] = w0[1]; wt[jj][2] = w0[2]; wt[jj][3] = w0[3]; wt[jj][4] = w1[0]; wt[jj][5] = w1[1]; wt[jj][6] = w1[2]; wt[jj][7] = w1[3]; }
            { const f32x4 b0 = ldg<f32x4>(P.conv_b, (unsigned)(cc * 4)), b1 = ldg<f32x4>(P.conv_b, (unsigned)((cc + 4) * 4)); bs[0] = b0[0]; bs[1] = b0[1]; bs[2] = b0[2]; bs[3] = b0[3]; bs[4] = b1[0]; bs[5] = b1[1]; bs[6] = b1[2]; bs[7] = b1[3]; }
            const unsigned src0 = (unsigned)(((b * TP + t0) * CINM + 4096 + cc) * 2), dst0 = (unsigned)(((b * TP + t0) * 6144 + cc) * 2);
            u32x4 r[11];
#pragma unroll
            for (int q = 0; q < 3; ++q) { r[q] = (u32x4){0u, 0u, 0u, 0u}; if (t0 > 0) r[q] = ldg<u32x4>(P.PC, src0 - (unsigned)((3 - q) * CINM * 2)); }
#pragma unroll 1
            for (int blk = 0; blk < 8; ++blk) {
#pragma unroll
                for (int q = 0; q < 8; ++q) r[3 + q] = ldg<u32x4>(P.PC, src0 + (unsigned)((blk * 8 + q) * CINM * 2));
#pragma unroll
                for (int q = 0; q < 8; ++q) {
                    float y[8];
#pragma unroll
                    for (int e = 0; e < 8; ++e) y[e] = bs[e];
#pragma unroll
                    for (int jj = 0; jj < 4; ++jj) {
                        const u32x4 x = r[q + jj];
                        y[0] += bflo(x[0]) * wt[jj][0]; y[1] += bfhi(x[0]) * wt[jj][1]; y[2] += bflo(x[1]) * wt[jj][2]; y[3] += bfhi(x[1]) * wt[jj][3];
                        y[4] += bflo(x[2]) * wt[jj][4]; y[5] += bfhi(x[2]) * wt[jj][5]; y[6] += bflo(x[3]) * wt[jj][6]; y[7] += bfhi(x[3]) * wt[jj][7];
                    }
#pragma unroll
                    for (int e = 0; e < 8; ++e) y[e] = silu_f(y[e]);
                    u32x4 o; o.x = pk2(y[0], y[1]); o.y = pk2(y[2], y[3]); o.z = pk2(y[4], y[5]); o.w = pk2(y[6], y[7]);
                    stg<u32x4>(P.XBC, dst0 + (unsigned)((blk * 8 + q) * 6144 * 2), o);
                }
                r[0] = r[8]; r[1] = r[9]; r[2] = r[10];
            }
        } else {
            const int id = it - 1536, b = id >> 6, n = id & 63;
            const float a = -__expf(P.a_log[lane]), db = P.dt_bias[lane];
            float acc = 0.f;
            const unsigned o0 = (unsigned)(((b * TP + n * 64) * 64 + lane) * 4);
#pragma unroll 8
            for (int t = 0; t < 64; ++t) {
                const float dt = softplus_f(ldg<float>(P.EC, o0 + t * 256) + db);
                acc += dt * a;
                stg<float>(P.DT, o0 + t * 256, dt); stg<float>(P.ACS, o0 + t * 256, acc);
            }
        }
    }
}
DI void cchain_unit(const Frame& F, int cu, const CPtrs& P) {
    const int b = cu >> 6, hd = cu & 63, g = hd >> 3;
    const int lane = F.lane, w = F.wave, tid = F.tid, h = lane >> 5, l32 = lane & 31;
    constexpr int LDX = 144, LDB = 272, LDY = 272;
    LAS uchar* Xl = F.lds; LAS uchar* XDl = F.lds + 9216; LAS uchar* XWl = F.lds + 18432;
    LAS uchar* Bl = F.lds + 27648; LAS uchar* Cl = F.lds + 45056;
    LAS uchar* Gl = F.lds + 62464;
    LAS uchar* Hl = F.lds + 71680;
    LAS uchar* Yl = F.lds + 89088;
    LAS float* dtL = (LAS float*)(F.lds + 106496);
    LAS float* acsL = dtL + 128;
    const int nb = w & 3, pb = w >> 2;
    f32x16 hst = zero16();
    for (int i = tid; i < 64 * LDB / 4; i += 512) ((LAS unsigned*)Hl)[i] = 0u;
    unsigned soff[5]; int srow[5], sch[5];
#pragma unroll
    for (int it = 0; it < 5; ++it) {
        const int id = tid + 512 * it, i = id / 40, ch = id - i * 40;
        const int c8 = ch < 8 ? hd * 64 + 8 * ch : ch < 24 ? 4096 + g * 128 + 8 * (ch - 8) : 5120 + g * 128 + 8 * (ch - 24);
        srow[it] = i; sch[it] = ch; soff[it] = (unsigned)(((b * TP + i) * 6144 + c8) * 2);
    }
    u32x4 pre[5];
#pragma unroll
    for (int it = 0; it < 5; ++it) pre[it] = ldg<u32x4>(P.XBC, soff[it]);
    const unsigned sc0 = (unsigned)(((b * TP) * 64 + hd) * 4);
    if (w == 7) { dtL[lane] = ldg<float>(P.DT, sc0 + lane * 256); acsL[lane] = ldg<float>(P.ACS, sc0 + lane * 256); }
    const float dsk = P.dskip[hd];
    __syncthreads();
#pragma unroll 1
    for (int n = 0; n < 64; ++n) {
        const int t0 = n * 64, cur = n & 1;
        LAS const float* dtc = dtL + cur * 64; LAS const float* acs = acsL + cur * 64;
        const float alast = acs[63];
#pragma unroll
        for (int it = 0; it < 5; ++it) {
            const int i = srow[it], ch = sch[it]; const u32x4 o = pre[it];
            if (ch < 8) {
                const float d1 = dtc[i], d2 = d1 * __expf(alast - acs[i]);
                u32x4 o1, o2;
#pragma unroll
                for (int e = 0; e < 4; ++e) { const float lo = bflo(o[e]), hi = bfhi(o[e]); o1[e] = pk2(lo * d1, hi * d1); o2[e] = pk2(lo * d2, hi * d2); }
                *(LAS u32x4*)(Xl + i * LDX + ch * 16) = o; *(LAS u32x4*)(XDl + i * LDX + ch * 16) = o1; *(LAS u32x4*)(XWl + i * LDX + ch * 16) = o2;
            } else if (ch < 24) *(LAS u32x4*)(Bl + i * LDB + (ch - 8) * 16) = o;
            else *(LAS u32x4*)(Cl + i * LDB + (ch - 24) * 16) = o;
        }
        __syncthreads();
        if (n < 63) {
#pragma unroll
            for (int it = 0; it < 5; ++it) pre[it] = ldg<u32x4>(P.XBC, soff[it] + (unsigned)((t0 + 64) * 6144 * 2));
        }
        f32x16 yacc = zero16();
        const int ti = (w >> 1) & 1, tq = w & 1;
        if (w >= 4) {
            if (!(ti == 0 && tq == 1)) {
                f32x16 cbt = mm_tile<false, false>(zero16(), Cl, LDB, 32 * ti, Bl, LDB, 32 * tq, 8, lane);
                const int j = 32 * tq + l32; const float aj = acs[j];
#pragma unroll
                for (int r = 0; r < 16; ++r) {
                    const int i = 32 * ti + crow(r, h);
                    const float v = (i >= j) ? cbt[r] * __expf(acs[i] - aj) : 0.f;
                    *(LAS bf16*)(Gl + i * LDX + j * 2) = (bf16)(pk2(v, 0.f) & 0xffffu);
                }
            } else {
#pragma unroll
                for (int r = 0; r < 16; ++r) *(LAS bf16*)(Gl + crow(r, h) * LDX + (32 + l32) * 2) = (bf16)0;
            }
        } else {
            yacc = mm_tile<false, false>(yacc, Cl, LDB, 32 * ti, Hl, LDB, 32 * tq, 8, lane);
#pragma unroll
            for (int r = 0; r < 16; ++r) yacc[r] *= __expf(acs[32 * ti + crow(r, h)]);
        }
        __syncthreads();
        if (w < 4) {
            yacc = mm_tile<false, true>(yacc, Gl, LDX, 32 * ti, XDl, LDX, 32 * tq, 4, lane);
#pragma unroll
            for (int r = 0; r < 16; ++r) *(LAS float*)(Yl + (32 * ti + crow(r, h)) * LDY + (32 * tq + l32) * 4) = yacc[r];
        }
        {
            const float el = __expf(alast);
#pragma unroll
            for (int r = 0; r < 16; ++r) hst[r] *= el;
            hst = mm_tile<true, true>(hst, Bl, LDB, 32 * nb, XWl, LDX, 32 * pb, 4, lane);
        }
        __syncthreads();
#pragma unroll
        for (int q = 0; q < 4; ++q) {
            f32x4 v = {hst[4 * q], hst[4 * q + 1], hst[4 * q + 2], hst[4 * q + 3]};
            *(LAS u32x2*)(Hl + (32 * pb + l32) * LDB + (32 * nb + 8 * q + 4 * h) * 2) = pk4(v);
        }
        if (w == 7 && n < 63) { dtL[(cur ^ 1) * 64 + lane] = ldg<float>(P.DT, sc0 + (unsigned)((t0 + 64 + lane) * 256)); acsL[(cur ^ 1) * 64 + lane] = ldg<float>(P.ACS, sc0 + (unsigned)((t0 + 64 + lane) * 256)); }
        {
            const int i = tid >> 3, part = tid & 7;
            const f32x4 ya = *(LAS const f32x4*)(Yl + i * LDY + (8 * part) * 4), yb = *(LAS const f32x4*)(Yl + i * LDY + (8 * part + 4) * 4);
            const u32x4 xv = *(LAS const u32x4*)(Xl + i * LDX + part * 16);
            u32x4 o;
            o.x = pk2(ya[0] + dsk * bflo(xv[0]), ya[1] + dsk * bfhi(xv[0])); o.y = pk2(ya[2] + dsk * bflo(xv[1]), ya[3] + dsk * bfhi(xv[1]));
            o.z = pk2(yb[0] + dsk * bflo(xv[2]), yb[1] + dsk * bfhi(xv[2])); o.w = pk2(yb[2] + dsk * bflo(xv[3]), yb[3] + dsk * bfhi(xv[3]));
            stg<u32x4>(P.YC, (unsigned)((((b * TP + t0 + i) * 4096) + hd * 64 + 8 * part) * 2), o);
        }
        __syncthreads();
    }
    {
        float* sp = P.ssm_p + (((size_t)b * 64 + hd) * 64 + 32 * pb + l32) * 128 + 32 * nb + 4 * h;
#pragma unroll
        for (int q = 0; q < 4; ++q) { f32x4 v = {hst[4 * q], hst[4 * q + 1], hst[4 * q + 2], hst[4 * q + 3]}; *(f32x4*)(sp + 8 * q) = v; }
    }
    __syncthreads();
}

DI void csample_unit(const Frame& F, int su, const CPtrs& P) {
    const int b = su >> 3, g = su & 7;
    const int tid = F.tid, lane = F.lane, w = F.wave, hd = g * 8 + w;
    LAS float* xs = (LAS float*)F.lds;
    LAS float* Bs = xs + 2048; LAS float* Cs = Bs + 512;
    LAS float* ys = Cs + 512;
    for (int c = tid; c < 768; c += 512) {
        const int cc = c < 512 ? g * 512 + c : c < 640 ? 4096 + g * 128 + (c - 512) : 5120 + g * 128 + (c - 640);
        float full[7];
#pragma unroll
        for (int r = 0; r < 3; ++r) full[r] = P.conv0[((size_t)b * 3 + r) * 6144 + cc];
#pragma unroll
        for (int t = 0; t < 4; ++t) full[3 + t] = P.PCS[(size_t)(b * 4 + t) * CIN + 4096 + cc];
        const float w0 = P.conv_w[cc], w1 = P.conv_w[6144 + cc], w2 = P.conv_w[2 * 6144 + cc], w3 = P.conv_w[3 * 6144 + cc], cb = P.conv_b[cc];
#pragma unroll
        for (int t = 0; t < 4; ++t) {
            const float v = silu_f(full[t] * w0 + full[t + 1] * w1 + full[t + 2] * w2 + full[t + 3] * w3 + cb);
            if (c < 512) xs[t * 512 + c]= v; else if (c < 640) Bs[t * 128 + (c - 512)] = v; else Cs[t * 128 + (c - 640)] = v;
        }
#pragma unroll
        for (int r = 0; r < 3; ++r) P.conv_s[((size_t)b * 3 + r) * 6144 + cc] = full[4 + r];
    }
    __syncthreads();
    float dt[4], dA[4];
    {
        const float a = -__expf(P.a_log[hd]), db = P.dt_bias[hd];
#pragma unroll
        for (int t = 0; t < 4; ++t) { dt[t] = softplus_f(P.PCS[(size_t)(b * 4 + t) * CIN + 10240 + hd] + db); dA[t] = __expf(dt[t] * a); }
    }
    const float dsk = P.dskip[hd];
#pragma unroll 1
    for (int ph = 0; ph < 2; ++ph) {
        float hs[32][2];
        const float* h0 = P.ssm0 + (((size_t)b * 64 + hd) * 64 + 32 * ph) * 128 + lane;
#pragma unroll
        for (int pi = 0; pi < 32; ++pi) { hs[pi][0] = h0[pi * 128]; hs[pi][1] = h0[pi * 128 + 64]; }
#pragma unroll 1
        for (int t = 0; t < 4; ++t) {
            const float b0 = Bs[t * 128 + lane], b1 = Bs[t * 128 + 64 + lane], c0 = Cs[t * 128 + lane], c1 = Cs[t * 128 + 64 + lane];
#pragma unroll
            for (int pi = 0; pi < 32; ++pi) {
                const float x = xs[t * 512 + w * 64 + 32 * ph + pi], dx = dt[t] * x;
                hs[pi][0] = hs[pi][0] * dA[t] + dx * b0; hs[pi][1] = hs[pi][1] * dA[t] + dx * b1;
                const float yv = wave_sum(hs[pi][0] * c0 + hs[pi][1] * c1);
                if (lane == 0) ys[t * 512 + w * 64 + 32 * ph + pi] = yv + dsk * x;
            }
        }
        float* ho = P.ssm_s + (((size_t)b * 64 + hd) * 64 + 32 * ph) * 128 + lane;
#pragma unroll
        for (int pi = 0; pi < 32; ++pi) { ho[pi * 128] = hs[pi][0]; ho[pi * 128 + 64] = hs[pi][1]; }
    }
    __syncthreads();
    if (w < 4) {
        const int t = w;
        const float* zp = P.PCS + (size_t)(b * 4 + t) * CIN + g * 512 + 8 * lane;
        float y[8]; float ss = 0.f;
#pragma unroll
        for (int e = 0; e < 8; ++e) { y[e] = ys[t * 512 + 8 * lane + e] * silu_f(zp[e]); ss += y[e] * y[e]; }
        const float rstd = rsqrtf(wave_sum(ss) * (1.f / 512.f) + RMS_EPS);
        const float* nw = P.norm_w + g * 512 + 8 * lane;
        u32x4 o; o.x = pk2(y[0] * rstd * nw[0], y[1] * rstd * nw[1]); o.y = pk2(y[2] * rstd * nw[2], y[3] * rstd * nw[3]);
        o.z = pk2(y[4] * rstd * nw[4], y[5] * rstd * nw[5]); o.w = pk2(y[6] * rstd * nw[6], y[7] * rstd * nw[7]);
        *(u32x4*)(P.YC + (size_t)(MP + b * 4 + t) * 4096 + g * 512 + 8 * lane) = o;
    }
    __syncthreads();
}
DI void cnorm_phase(const Frame& F, const CPtrs& P) {
    for (int row = F.gw; row < MP; row += F.NGW) {
#pragma unroll
        for (int k = 0; k < 8; ++k) {
            const int ch = 8 * (F.lane + 64 * k);
            const u32x4 v = ldg<u32x4>(P.YC, (unsigned)((row * 4096 + ch) * 2)), z = ldg<u32x4>(P.PC, (unsigned)((row * CINM + ch) * 2));
            const f32x4 n0 = ldg<f32x4>(P.norm_w, (unsigned)(ch * 4)), n1 = ldg<f32x4>(P.norm_w, (unsigned)((ch + 4) * 4));
            float y[8]; float ss = 0.f;
#pragma unroll
            for (int e = 0; e < 4; ++e) { y[2 * e] = bflo(v[e]) * silu_f(bflo(z[e])); y[2 * e + 1] = bfhi(v[e]) * silu_f(bfhi(z[e])); ss += y[2 * e] * y[2 * e] + y[2 * e + 1] * y[2 * e + 1]; }
            const float rstd = rsqrtf(wave_sum(ss) * (1.f / 512.f) + RMS_EPS);
            u32x4 o; o.x = pk2(y[0] * rstd * n0[0], y[1] * rstd * n0[1]); o.y = pk2(y[2] * rstd * n0[2], y[3] * rstd * n0[3]);
            o.z = pk2(y[4] * rstd * n1[0], y[5] * rstd * n1[1]); o.w = pk2(y[6] * rstd * n1[2], y[7] * rstd * n1[3]);
            stg<u32x4>(P.YC, (unsigned)((row * 4096 + ch) * 2), o);
        }
    }
}
template <class Fn>
DI void run_gemm(const Frame& F, const bf16* A, const bf16* Bt, int N, int K, const Fn& f) {
    pg8::Gemm g{A, Bt, MP, N, K}; pg8::StaticOrder S; S.init(MP, N, F.G, F.bid);
    EpiWrap<Fn> E{f};
    pg8::gemm_phase<EpiWrap<Fn>, pg8::StaticOrder, true, true>(F.lds, g, S, E, F.tid);
}
#define SKINNY_LOOP(u, count) for (int u = (F.G - 1 - F.bid); u < (count); u += F.G)
#define SIDE_LOOP(u, count, nres) for (int _ns = (F.G > (nres) ? F.G - (nres) : F.G), u = ((F.G - 1 - F.bid) < _ns ? (F.G - 1 - F.bid) : (count)); u < (count); u += _ns)

enum { PH_PRO = 0, PH_GU, PH_DN, PH_LN, PH_AQKV, PH_ATT, PH_AO, PH_BIN, PH_BPREP, PH_BCHAIN, PH_BOUT, PH_CIN, PH_CCHAIN, PH_CNORM, PH_COUT, PH_CPRE, PH_N };

DI void fill_b(BPtrs& P, const Args& args) {
    uchar* ws = args.ws;
    P.PB = (const bf16*)(ws + MB_PB); P.EB = (const float*)(ws + MB_EB); P.PBS = (const float*)(ws + MB_PBS);
    P.WG = (bf16*)(ws + MB_WG); P.UG = (bf16*)(ws + MB_UG); P.QG = (bf16*)(ws + MB_QG); P.KG = (bf16*)(ws + MB_KG); P.QKG = (bf16*)(ws + MB_QKG);
    P.GCG = (float*)(ws + MB_GCG); P.YB = (bf16*)(ws + MB_YB);
    P.conv_w = args.in[18]; P.a_log = args.in[19]; P.dt_bias = args.in[20]; P.norm_w = args.in[21]; P.ssm0 = args.in[5]; P.conv0 = args.in[6];
    P.ssm_p = args.out + O_BSSMP; P.ssm_s = args.out + O_BSSMS; P.conv_p = args.out + O_BCONVP; P.conv_s = args.out + O_BCONVS;
}
DI void fill_c(CPtrs& P, const Args& args) {
    uchar* ws = args.ws;
    P.PC = (const bf16*)(ws + MC_PC); P.EC = (const float*)(ws + MC_EC); P.PCS = (const float*)(ws + MC_PCS); P.DT = (float*)(ws + MC_SS); P.ACS = (float*)(ws + MC_ACS); P.XBC = (bf16*)(ws + MC_XBC); P.YC = (bf16*)(ws + MC_YC);
    P.conv_w = args.in[24]; P.conv_b = args.in[25]; P.dt_bias = args.in[26]; P.a_log = args.in[27]; P.dskip = args.in[28]; P.norm_w = args.in[29];
    P.ssm0 = args.in[7]; P.conv0 = args.in[8];
    P.ssm_p = args.out + O_CSSMP; P.ssm_s = args.out + O_CSSMS; P.conv_p = args.out + O_CCONVP; P.conv_s = args.out + O_CCONVS;
}
template <int PH>
DI void phase_body(const Frame& F, const Args& args, int hl, int zsi, int j) {
    uchar* ws = args.ws;
    float* X = args.out; bf16* XB = (bf16*)(ws + WS_XB); float* ZP = (float*)(ws + WS_ZP); bf16* HB = (bf16*)(ws + WS_H);
    float* ZS = (float*)(ws + WS_ZS + (size_t)zsi * ZS_ONE);
    if constexpr (PH == PH_PRO) prologue(F, args);
    if constexpr (PH == PH_GU) {
        const bf16* Wgu = (const bf16*)(ws + WS_W + (size_t)hl * FFN_BYTES);
        FSwiglu f{HB}; run_gemm(F, XB, Wgu, NGU, DM, f);
        SIDE_LOOP(u, NGU / 64, 128) skinny_unit<2>(F, XB, DM, MP, Wgu, DM, 64 * u, 0, DM, f);
        if (hl == 1) bg_slot(F, args, 2, 128);
        if (hl == 2) bg_slot(F, args, 3, 128);
    }
    if constexpr (PH == PH_DN) {
        const bf16* Wdn = (const bf16*)(ws + WS_W + (size_t)hl * FFN_BYTES + GU_BYTES);
        FResid f{X, ZP, 0, 0.5f, 0, 1}; run_gemm(F, HB, Wdn, DM, DFF, f);
        SKINNY_LOOP(u, 256) { const int ft = u >> 2, ks = u & 3; FResid fs{X, ZS, MP, 0.5f, 1, ks == 0}; skinny_unit<1>(F, HB, DFF, MP, Wdn, DFF, 32 * ft, ks * (DFF / 4), DFF / 4, fs); }
    }
    if constexpr (PH == PH_LN) ln_phase(F, ZP, ZS, args.in[9] + (size_t)zsi * DM, args.in[10] + (size_t)zsi * DM, X, XB);
    if constexpr (PH == PH_AQKV || PH == PH_ATT || PH == PH_AO) {
        const bf16* Wq = (const bf16*)(ws + WS_WA + (size_t)j * A_BYTES); const bf16* Wo = (const bf16*)(ws + WS_WA + (size_t)j * A_BYTES + AQ_BYTES);
        bf16* QKV = (bf16*)(ws + MA_QKV); float* QKVS = (float*)(ws + MA_QKVS); bf16* OG = (bf16*)(ws + MA_OG); float* LSE = (float*)(ws + MA_LSE); bf16* OA = (bf16*)(ws + MA_O);
        if constexpr (PH == PH_AQKV) {
            FQkv f; f.QKV = QKV; f.QKVS = QKVS; f.rope = (const float*)(ws + WS_ROPE); f.j = j;
            f.out = args.out;
            run_gemm(F, XB, Wq, AQKV, DM, f);
            SIDE_LOOP(u, AQKV / 64, 128) skinny_unit<2>(F, XB, DM, MP, Wq, DM, 64 * u, 0, DM, f);
        }
        if constexpr (PH == PH_ATT) {
            for (int u = F.bid; u < 128; u += F.G) attn_prompt_unit(F, u, QKV, OG, LSE, OA);
            SIDE_LOOP(u, 256, 128) attn_sample_unit(F, u, QKVS, args.in[2], args.in[3], args.in[4], j, OA);
            if (j == 0) bg_slot(F, args, 1, 128);
        }
        if constexpr (PH == PH_AO) {
            FResid f{X, ZP, 0, 1.f, 0, 1}; run_gemm(F, OA, Wo, DM, 1024, f);
            SKINNY_LOOP(u, 256) { const int ft = u >> 2, ks = u & 3; FResid fs{X, ZS, MP, 1.f, 1, ks == 0}; skinny_unit<1>(F, OA, 1024, MP, Wo, 1024, 32 * ft, ks * 256, 256, fs); }
        }
    }
    if constexpr (PH == PH_BIN || PH == PH_BPREP || PH == PH_BCHAIN || PH == PH_BOUT) {
        const bf16* Wi = (const bf16*)(ws + WS_WB); const bf16* Wo = (const bf16*)(ws + WS_WB + BI_BYTES);
        BPtrs P; fill_b(P, args);
        if constexpr (PH == PH_BIN) {
            FBf16 f{(bf16*)(ws + MB_PB), BINM}; run_gemm(F, XB, Wi, BINM, DM, f);
            FF32 fe{(float*)(ws + MB_EB), 64, 0, BINM};
            SKINNY_LOOP(u, 256) skinny_unit<2>(F, XB, DM, 32 * u, Wi, DM, BINM, 0, DM, fe);
            FF32 fs{(float*)(ws + MB_PBS), BIN, MP, 0};
            SKINNY_LOOP(u, BIN / 64) skinny_unit<2>(F, XB, DM, MP, Wi, DM, 64 * u, 0, DM, fs);
        }
        if constexpr (PH == PH_BPREP) {
            for (int u = F.bid; u < 2048; u += F.G) bprep_unit(F, u, P);
            for (int i = F.gw * 64 + F.lane; i < 2 * 3 * 8192; i += F.NGW * 64) { const int b = i / 24576, r = (i / 8192) % 3, c = i & 8191; P.conv_p[i] = bf2f(P.PB[((size_t)b * TP + TP - 3 + r) * BINM + c]); }
        }
        if constexpr (PH == PH_BCHAIN) {
            for (int u = F.bid; u < 64; u += F.G) bchain_unit(F, u, P);
            SIDE_LOOP(u, 256, 64) bsample_unit(F, u, P);
            bg_slot(F, args, 4, 64);
            if (F.bid >= 64 && F.G > 64) cache_copy(args, 0, args.slot[5][0], (F.bid - 64) * 512 + F.tid, (F.G - 64) * 512);
        }
        if constexpr (PH == PH_BOUT) {
            FResid f{X, ZP, 0, 1.f, 0, 1}; run_gemm(F, P.YB, Wo, DM, 4096, f);
            SKINNY_LOOP(u, 256) { const int ft = u >> 2, ks = u & 3; FResid fs{X, ZS, MP, 1.f, 1, ks == 0}; skinny_unit<1>(F, P.YB, 4096, MP, Wo, 4096, 32 * ft, ks * 1024, 1024, fs); }
        }
    }
    if constexpr (PH == PH_CIN || PH == PH_CCHAIN || PH == PH_CNORM || PH == PH_COUT || PH == PH_CPRE) {
        const bf16* Wi = (const bf16*)(ws + WS_WC); const bf16* Wo = (const bf16*)(ws + WS_WC + CI_BYTES);
        CPtrs P; fill_c(P, args);
        if constexpr (PH == PH_CIN) {
            FBf16 f{(bf16*)(ws + MC_PC), CINM}; run_gemm(F, XB, Wi, CINM, DM, f);
            FF32 fe{(float*)(ws + MC_EC), 64, 0, CINM};
            SKINNY_LOOP(u, 256) skinny_unit<2>(F, XB, DM, 32 * u, Wi, DM, CINM, 0, DM, fe);
            FF32 fs{(float*)(ws + MC_PCS), CIN, MP, 0};
            SKINNY_LOOP(u, CIN / 64) skinny_unit<2>(F, XB, DM, MP, Wi, DM, 64 * u, 0, DM, fs);
        }
        if constexpr (PH == PH_CCHAIN) {
            for (int u = F.bid; u < 128; u += F.G) cchain_unit(F, u, P);
            SIDE_LOOP(u, 64, 128) csample_unit(F, u, P);
            if (F.bid >= 128 && F.G > 128) cache_copy(args, args.slot[5][0], CC_TOT, (F.bid - 128) * 512 + F.tid, (F.G - 128) * 512);
            for (int i = F.gw * 64 + F.lane; i < 2 * 3 * 6144; i += F.NGW * 64) { const int b = i / 18432, r = (i / 6144) % 3, c = i % 6144; P.conv_p[i] = bf2f(P.PC[((size_t)b * TP + TP - 3 + r) * CINM + 4096 + c]); }
        }
        if constexpr (PH == PH_CPRE) cpre_phase(F, P);
        if constexpr (PH == PH_CNORM) cnorm_phase(F, P);
        if constexpr (PH == PH_COUT) {
            FResid f{X, ZP, 0, 1.f, 0, 1}; run_gemm(F, P.YC, Wo, DM, 4096, f);
            SKINNY_LOOP(u, 256) { const int ft = u >> 2, ks = u & 3; FResid fs{X, ZS, MP, 1.f, 1, ks == 0}; skinny_unit<1>(F, P.YC, 4096, MP, Wo, 4096, 32 * ft, ks * 1024, 1024, fs); }
        }
    }
}
DI void make_frame(Frame& F, unsigned char* lds_raw) {
    F.lds = (LAS uchar*)lds_raw;
    F.tid = threadIdx.x; F.lane = F.tid & 63; F.wave = __builtin_amdgcn_readfirstlane(F.tid >> 6);
    F.G = gridDim.x; F.bid = blockIdx.x; F.gw = F.bid * NWAVES + F.wave; F.NGW = F.G * NWAVES;
}
#if MK_MULTI
template <int PH>
__global__ void __launch_bounds__(NWAVES * 64, 2) mk_phase(Args args, int hl, int zsi, int j) {
    extern __shared__ __attribute__((aligned(16))) unsigned char lds_raw[];
    Frame F; make_frame(F, lds_raw);
    phase_body<PH>(F, args, hl, zsi, j);
}
#endif

static void fill_args(Args& a, void* const* d_in, void* d_out, void* d_ws) {
    for (int i = 0; i < 31; ++i) a.in[i] = (const float*)d_in[i];
    a.out = (float*)d_out; a.ws = (unsigned char*)d_ws;
    unsigned char* ws = (unsigned char*)d_ws;
    int nd = 0, items = 0;
    auto add = [&](const float* src, size_t dst_off, int K, int N, int mode) { a.wd[nd].src = src; a.wd[nd].dst = (bf16*)(ws + dst_off); a.wd[nd].K = K; a.wd[nd].N = N; a.wd[nd].mode = mode; a.wd[nd].item0 = items; items += (K / 64) * (N / 64); ++nd; };
    auto ffn = [&](int hl) { const int L = hl >> 1, wh = hl & 1;
        add(a.in[wh ? 13 : 11] + (size_t)L * DM * NGU, WS_W + (size_t)hl * FFN_BYTES, DM, NGU, 1);
        add(a.in[wh ? 14 : 12] + (size_t)L * DFF * DM, WS_W + (size_t)hl * FFN_BYTES + GU_BYTES, DFF, DM, 0); };
    auto mixa = [&](int j) { add(a.in[15] + (size_t)j * DM * AQKV, WS_WA + (size_t)j * A_BYTES, DM, AQKV, 0); add(a.in[16] + (size_t)j * 1024 * DM, WS_WA + (size_t)j * A_BYTES + AQ_BYTES, 1024, DM, 0); };
    a.slot[0][0] = items; ffn(0); mixa(0); a.slot[0][1] = items;
    a.slot[1][0] = items; ffn(1); ffn(2); a.slot[1][1] = items;
    a.slot[2][0] = items; add(a.in[17], WS_WB, DM, BIN, 0); a.slot[2][1] = items;
    a.slot[3][0] = items; add(a.in[22], WS_WB + BI_BYTES, 4096, DM, 0); a.slot[3][1] = items;
    a.slot[4][0] = items; ffn(3); ffn(4); add(a.in[23], WS_WC, DM, CIN, 0); add(a.in[30], WS_WC + CI_BYTES, 4096, DM, 0); ffn(5); ffn(6); mixa(1); ffn(7); a.slot[4][1] = items;
    a.slot[5][0] = (int)(0.40 * CC_TOT); a.slot[5][1] = CC_TOT;
    a.nitems = items; a.pad = 0;
}
#if MK_MULTI
template <int PH> static void launch_phase(const Args& a, int grid, hipStream_t stream, int hl, int zsi, int j) {
    static bool attr = false;
    if (!attr) { (void)hipFuncSetAttribute((const void*)mk_phase<PH>, hipFuncAttributeMaxDynamicSharedMemorySize, LDS_BYTES); attr = true; }
    hipLaunchKernelGGL(mk_phase<PH>, dim3(grid), dim3(NWAVES * 64), LDS_BYTES, stream, a, hl, zsi, j);
}
extern "C" void kernel_launch(void* const* d_in, const int* in_sizes, int n_in, void* d_out, int out_size, void* d_ws, size_t ws_size, hipStream_t stream) {
    static int grid = 0;
    if (grid == 0) {
        if (n_in != 31 || (size_t)out_size != O_END || ws_size < WS_END) {
            fprintf(stderr, "kernel_launch: expected 31 inputs, out %zu floats, ws >= %zu bytes; got n_in %d out %d ws %zu; nothing launched\n", (size_t)O_END, (size_t)WS_END, n_in, out_size, ws_size);
            grid = -1; return;
        }
        int dev = 0, cus = 0;
        if (hipGetDevice(&dev) != hipSuccess || hipDeviceGetAttribute(&cus, hipDeviceAttributeMultiprocessorCount, dev) != hipSuccess) { grid = -1; return; }
        grid = cus;
    }
    if (grid < 0) return;
    Args a{}; fill_args(a, d_in, d_out, d_ws);
    launch_phase<PH_PRO>(a, grid, stream, 0, 0, 0);
    for (int hl = 0; hl < 8; ++hl) {
        const int layer = hl >> 1, which = hl & 1, zf = 3 * layer + 2 * which, zm = 3 * layer + 1;
        launch_phase<PH_GU>(a, grid, stream, hl, zf, 0);
        launch_phase<PH_DN>(a, grid, stream, hl, zf, 0);
        launch_phase<PH_LN>(a, grid, stream, hl, zf, 0);
        if (which == 1) continue;
        if (layer == 0 || layer == 3) {
            const int j = layer == 0 ? 0 : 1;
            launch_phase<PH_AQKV>(a, grid, stream, hl, zm, j); launch_phase<PH_ATT>(a, grid, stream, hl, zm, j); launch_phase<PH_AO>(a, grid, stream, hl, zm, j);
        } else if (layer == 1) {
            launch_phase<PH_BIN>(a, grid, stream, hl, zm, 0); launch_phase<PH_BPREP>(a, grid, stream, hl, zm, 0); launch_phase<PH_BCHAIN>(a, grid, stream, hl, zm, 0); launch_phase<PH_BOUT>(a, grid, stream, hl, zm, 0);
        } else {
            launch_phase<PH_CIN>(a, grid, stream, hl, zm, 0); launch_phase<PH_CPRE>(a, grid, stream, hl, zm, 0); launch_phase<PH_CCHAIN>(a, grid, stream, hl, zm, 0); launch_phase<PH_CNORM>(a, grid, stream, hl, zm, 0); launch_phase<PH_COUT>(a, grid, stream, hl, zm, 0);
        }
        launch_phase<PH_LN>(a, grid, stream, hl, zm, 0);
    }
    const hipError_t le = hipPeekAtLastError();
    if (le != hipSuccess) fprintf(stderr, "kernel_launch: launch failed: %s\n", hipGetErrorName(le));
}
#endif
#if !MK_MULTI
DI void launder_frame(Frame& F) {
    int t_ = F.tid, l_ = F.lane, w_ = F.wave, g_ = F.G, b_ = F.bid; unsigned la_ = (unsigned)(size_t)F.lds;
    asm volatile("" : "+v"(t_), "+v"(l_)); asm volatile("" : "+s"(w_), "+s"(g_), "+s"(b_), "+s"(la_));
    F.tid = t_; F.lane = l_; F.wave = w_; F.G = g_; F.bid = b_; F.gw = b_ * NWAVES + w_; F.NGW = g_ * NWAVES; F.lds = (LAS uchar*)(size_t)la_;
}
__global__ void __launch_bounds__(NWAVES * 64, 2) mk_fwd(Args args) {
    extern __shared__ __attribute__((aligned(16))) unsigned char lds_raw[];
    Frame F; make_frame(F, lds_raw);
    volatile LAS unsigned* MISC = (volatile LAS unsigned*)(F.lds + MISC_OFF);
    for (int u = F.tid; u < (LDS_BYTES - MISC_OFF) / 4; u += NWAVES * 64) ((LAS unsigned*)(F.lds + MISC_OFF))[u] = 0u;
    __syncthreads();
    XcdBarrier bar = xcd_barrier_post((unsigned*)(args.ws + WS_CTL) + CW_BAR, MISC + 8);
#ifndef DUP_PH
#define DUP_PH -1
#endif
#define RUN1(PH, hl, zsi, j) do { asm volatile("; MARK_PHASE %0 %1" :: "i"(PH), "i"(zsi)); launder_frame(F); phase_body<PH>(F, args, hl, zsi, j); xcd_barrier(bar); } while (0)
#define RUN(PH, hl, zsi, j) do { RUN1(PH, hl, zsi, j); if (PH == DUP_PH) RUN1(PH, hl, zsi, j); } while (0)
#define FFN(hl, zsi) RUN(PH_GU, hl, zsi, 0); RUN(PH_DN, hl, zsi, 0); RUN(PH_LN, hl, zsi, 0)
#define MIXA(zsi, j) RUN(PH_AQKV, 0, zsi, j); RUN(PH_ATT, 0, zsi, j); RUN(PH_AO, 0, zsi, j); RUN(PH_LN, 0, zsi, 0)
#define MIXB(zsi) RUN(PH_BIN, 0, zsi, 0); RUN(PH_BPREP, 0, zsi, 0); RUN(PH_BCHAIN, 0, zsi, 0); RUN(PH_BOUT, 0, zsi, 0); RUN(PH_LN, 0, zsi, 0)
#define MIXC(zsi) RUN(PH_CIN, 0, zsi, 0); RUN(PH_CPRE, 0, zsi, 0); RUN(PH_CCHAIN, 0, zsi, 0); RUN(PH_CNORM, 0, zsi, 0); RUN(PH_COUT, 0, zsi, 0); RUN(PH_LN, 0, zsi, 0)
    RUN(PH_PRO, 0, 0, 0);
    FFN(0, 0); MIXA(1, 0); FFN(1, 2);
    FFN(2, 3); MIXB(4);    FFN(3, 5);
    FFN(4, 6); MIXC(7);    FFN(5, 8);
    FFN(6, 9); MIXA(10, 1); FFN(7, 11);
}
extern "C" void kernel_launch(void* const* d_in, const int* in_sizes, int n_in, void* d_out, int out_size, void* d_ws, size_t ws_size, hipStream_t stream) {
    static int grid = 0;
    if (grid == 0) {
        if (n_in != 31 || (size_t)out_size != O_END || ws_size < WS_END) {
            fprintf(stderr, "kernel_launch: expected 31 inputs, out %zu floats, ws >= %zu bytes; got n_in %d out %d ws %zu; nothing launched\n", (size_t)O_END, (size_t)WS_END, n_in, out_size, ws_size);
            grid = -1; return;
        }
        int dev = 0, cus = 0, per_cu = 0;
        if (hipGetDevice(&dev) != hipSuccess || hipDeviceGetAttribute(&cus, hipDeviceAttributeMultiprocessorCount, dev) != hipSuccess) { grid = -1; return; }
        if (hipFuncSetAttribute((const void*)mk_fwd, hipFuncAttributeMaxDynamicSharedMemorySize, LDS_BYTES) != hipSuccess) { fprintf(stderr, "kernel_launch: hipFuncSetAttribute failed\n"); grid = -1; return; }
        if (hipOccupancyMaxActiveBlocksPerMultiprocessor(&per_cu, (const void*)mk_fwd, NWAVES * 64, LDS_BYTES) != hipSuccess || per_cu < 1)
            fprintf(stderr, "kernel_launch: note: occupancy query reports %d workgroups per CU\n", per_cu);
        (void)hipGetLastError();
        grid = cus;
    }
    if (grid < 0) return;
    if (hipMemsetAsync((char*)d_ws + WS_CTL, 0, CTL_ZERO_BYTES, stream) != hipSuccess) { fprintf(stderr, "kernel_launch: memset failed\n"); return; }
    Args a{}; fill_args(a, d_in, d_out, d_ws);
    hipLaunchKernelGGL(mk_fwd, dim3(grid), dim3(NWAVES * 64), LDS_BYTES, stream, a);
    const hipError_t le = hipPeekAtLastError();
    if (le != hipSuccess) fprintf(stderr, "kernel_launch: launch failed: %s\n", hipGetErrorName(le));
}
#endif
```

```cpp
#include <hip/hip_runtime.h>
#include <cstdio>
#include <cstdint>
#ifndef MK_MULTI
#define MK_MULTI 0
#endif
#define DUP_PH -1
namespace pg8 {
#define PG8_LAS __attribute__((address_space(3)))
typedef unsigned short bf16_t;
typedef short bf16x8 __attribute__((ext_vector_type(8)));
typedef float f32x4 __attribute__((ext_vector_type(4)));
typedef unsigned u32x4 __attribute__((ext_vector_type(4)));
constexpr int BM = 256, BK = 64, HALF = 128, HTB = HALF * BK * 2  , STAGE_BYTES = 8 * HTB, NXCD = 8, WGM = 8;

__host__ __device__ __forceinline__ int lds_byte(int r, int c) { const int st = (r >> 4) * 2 + (c >> 5), rr = r & 15, cc = c & 31, ob = rr * 64 + cc * 2; return st * 1024 + (ob ^ (((ob >> 9) & 1) << 5)); }
__host__ __device__ __forceinline__ void stage_rc(int b, int& R, int& C) { const int st = b / 1024, sb = b % 1024, swz = sb ^ (((sb >> 9) & 1) << 5); R = (st >> 1) * 16 + swz / 64; C = (st & 1) * 32 + (swz % 64) / 2; }
__host__ __device__ __forceinline__ int perm32(int rho) { const int n = rho >> 4, i = rho & 15; return 8 * (i >> 2) + 4 * n + (i & 3); }

struct Unit { int pm, pn; };
struct Gemm { const bf16_t* A; const bf16_t* Bt; int M, N, K; };

struct StaticOrder {
    int nM, nN, nwg, G, c;
    __host__ __device__ void init(int M, int N, int G_, int c_) { nM = M / BM; nN = N / BM; nwg = nM * nN; G = G_; c = c_; }
    __host__ __device__ bool next(int i, Unit& u) const {
        const long L = (long)i * G + c; if (L >= nwg) return false;
        int wgid = (int)L; { const int q = nwg / NXCD, r = nwg % NXCD, xcd = wgid % NXCD, off = wgid / NXCD; wgid = (xcd < r ? xcd * (q + 1) : r * (q + 1) + (xcd - r) * q) + off; }
        const int nig = WGM * nN, gid = wgid / nig, fm = gid * WGM, gsz = (nM - fm) < WGM ? (nM - fm) : WGM;
        u.pm = fm + ((wgid % nig) % gsz); u.pn = (wgid % nig) / gsz; return true;
    }
    __device__ __forceinline__ void a_ready(const Unit&) const {}
    __device__ __forceinline__ void done(const Unit&) const {}
};


template <class Epi, class Sched, bool ALIGN_EPI = false, bool SP2 = false>
__device__ __forceinline__ void gemm_phase(PG8_LAS unsigned char* lds, const Gemm g, const Sched& S, const Epi& E, const int tid) {
    const int wid = __builtin_amdgcn_readfirstlane(tid >> 6), lane = tid & 63, wr = wid >> 2, wc = wid & 3, fr = lane & 15, fq = lane >> 4;
    const int K = g.K, nt = K / BK;
    unsigned voffA[2], voffB[2];
#pragma unroll
    for (int i = 0; i < 2; ++i) { int R, C; stage_rc(tid * 16 + i * 8192, R, C); const int Rb = Epi::PERM ? ((R & ~31) + perm32(R & 31)) : R;
        voffA[i] = (unsigned)(R * K + C) * 2u; voffB[i] = (unsigned)(Rb * K + C) * 2u; }
    const size_t kstep = (size_t)(BK * 2);
    const size_t hstep = (size_t)HALF * K * 2;
    const size_t tstep = 2 * hstep;
    const unsigned ldsw = (unsigned)wid * 1024u;
    const int aoff = lds_byte(wr * 64 + fr, fq * 8), boff = lds_byte(wc * 32 + fr, fq * 8);
#define PG8_SA(b, h) (((b) * 2 + (h)) * HTB)
#define PG8_SB(b, h) ((4 + (b) * 2 + (h)) * HTB)
#define PG8_STAGE(bufoff, gbase, voff) do { _Pragma("unroll") for (int _i = 0; _i < 2; ++_i) \
        __builtin_amdgcn_global_load_lds((const unsigned*)((const char*)(gbase) + (voff)[_i]), (PG8_LAS unsigned*)(lds + (bufoff) + ldsw + _i * 8192), 16, 0, 0); } while (0)
#define PG8_LDA(dst, b, h) do { _Pragma("unroll") for (int m = 0; m < 4; ++m) _Pragma("unroll") for (int k = 0; k < 2; ++k) dst[m][k] = *(const PG8_LAS bf16x8*)(lds + PG8_SA(b, h) + aoff + m * 2048 + k * 1024); } while (0)
#define PG8_LDB(dst, b, h) do { _Pragma("unroll") for (int n = 0; n < 2; ++n) _Pragma("unroll") for (int k = 0; k < 2; ++k) dst[n][k] = *(const PG8_LAS bf16x8*)(lds + PG8_SB(b, h) + boff + n * 2048 + k * 1024); } while (0)
#define PG8_MMA(ai, bj, At, Bt) do { __builtin_amdgcn_s_setprio(1); _Pragma("unroll") for (int m = 0; m < 4; ++m) _Pragma("unroll") for (int n = 0; n < 2; ++n) _Pragma("unroll") for (int k = 0; k < 2; ++k) \
        acc[ai][bj][m][n] = __builtin_amdgcn_mfma_f32_16x16x32_bf16(Bt[n][k], At[m][k], acc[ai][bj][m][n], 0, 0, 0); __builtin_amdgcn_s_setprio(0); } while (0)
#define PG8_WAIT_V(n) asm volatile("s_waitcnt vmcnt(" #n ")" ::: "memory")
#define PG8_WAIT_L(n) asm volatile("s_waitcnt lgkmcnt(" #n ")" ::: "memory")
#define PG8_BAR __builtin_amdgcn_s_barrier()
#define PG8_SCHED __builtin_amdgcn_sched_barrier(0)
    Unit cur, nxt; int ui = 0;
    if (!S.next(0, cur)) return;
    f32x4 acc[2][2][4][2];
#pragma unroll
    for (int a = 0; a < 2; ++a)
#pragma unroll
        for (int b = 0; b < 2; ++b)
#pragma unroll
            for (int m = 0; m < 4; ++m)
#pragma unroll
                for (int n = 0; n < 2; ++n) acc[a][b][m][n] = (f32x4){0.f, 0.f, 0.f, 0.f};
    bf16x8 At[4][2], B0[2][2], B1[2][2];
    const char* cA = (const char*)g.A + (size_t)cur.pm * tstep; const char* cB = (const char*)g.Bt + (size_t)cur.pn * tstep;
    S.a_ready(cur);
    if constexpr (SP2) {
        PG8_STAGE(PG8_SB(0, 0), cB, voffB); PG8_STAGE(PG8_SB(0, 1), cB + hstep, voffB); PG8_STAGE(PG8_SA(0, 0), cA, voffA); PG8_STAGE(PG8_SA(0, 1), cA + hstep, voffA);
        if (wr == 1) PG8_BAR;
        PG8_WAIT_V(2); PG8_BAR;
        PG8_STAGE(PG8_SB(1, 0), cB + kstep, voffB); PG8_STAGE(PG8_SA(1, 0), cA + kstep, voffA); PG8_STAGE(PG8_SB(1, 1), cB + hstep + kstep, voffB);
        PG8_WAIT_V(6); PG8_BAR;
    } else {
        PG8_STAGE(PG8_SB(0, 0), cB, voffB); PG8_STAGE(PG8_SA(0, 0), cA, voffA); PG8_STAGE(PG8_SB(0, 1), cB + hstep, voffB); PG8_STAGE(PG8_SA(0, 1), cA + hstep, voffA);
        if (wr == 1) PG8_BAR;
        PG8_WAIT_V(4); PG8_BAR;
        PG8_STAGE(PG8_SB(1, 0), cB + kstep, voffB); PG8_STAGE(PG8_SA(1, 0), cA + kstep, voffA); PG8_STAGE(PG8_SB(1, 1), cB + hstep + kstep, voffB);
        PG8_WAIT_V(6); PG8_BAR;
    }
    for (;;) {
        const bool has_next = S.next(ui + 1, nxt);
        const char* nA = has_next ? (const char*)g.A + (size_t)nxt.pm * tstep : cA; const char* nB = has_next ? (const char*)g.Bt + (size_t)nxt.pn * tstep : cB;
        for (int t = 0; t < nt; t += 2) {
            const bool last = (t == nt - 2);
            const char* a1 = cA + (size_t)(t + 1) * kstep;
            const char* a2 = last ? nA : cA + (size_t)(t + 2) * kstep; const char* b2 = last ? nB : cB + (size_t)(t + 2) * kstep;
            const char* a3 = a2 + kstep; const char* b3 = b2 + kstep;
            if (last && has_next) S.a_ready(nxt);
            if constexpr (SP2) {
            PG8_LDB(B0, 0, 0); PG8_LDB(B1, 0, 1); PG8_SCHED; PG8_LDA(At, 0, 0); PG8_STAGE(PG8_SA(1, 1), a1 + hstep, voffA);
            PG8_WAIT_V(8); PG8_WAIT_L(0); PG8_BAR; PG8_MMA(0, 0, At, B0); PG8_MMA(0, 1, At, B1); PG8_BAR; PG8_SCHED;
            PG8_LDA(At, 0, 1); PG8_STAGE(PG8_SB(0, 0), b2, voffB); PG8_STAGE(PG8_SB(0, 1), b2 + hstep, voffB); PG8_STAGE(PG8_SA(0, 0), a2, voffA);
            PG8_WAIT_V(8); PG8_WAIT_L(0); PG8_BAR; PG8_MMA(1, 0, At, B0); PG8_MMA(1, 1, At, B1); PG8_BAR; PG8_SCHED;
            PG8_LDB(B0, 1, 0); PG8_LDB(B1, 1, 1); PG8_SCHED; PG8_LDA(At, 1, 0); PG8_STAGE(PG8_SA(0, 1), a2 + hstep, voffA);
            PG8_WAIT_V(8); PG8_WAIT_L(0); PG8_BAR; PG8_MMA(0, 0, At, B0); PG8_MMA(0, 1, At, B1); PG8_BAR; PG8_SCHED;
            PG8_LDA(At, 1, 1); PG8_STAGE(PG8_SB(1, 0), b3, voffB); PG8_STAGE(PG8_SB(1, 1), b3 + hstep, voffB); PG8_STAGE(PG8_SA(1, 0), a3, voffA);
            PG8_WAIT_V(8); PG8_WAIT_L(0); PG8_BAR; PG8_MMA(1, 0, At, B0); PG8_MMA(1, 1, At, B1); PG8_BAR; PG8_SCHED;
            } else {
            PG8_LDB(B0, 0, 0); PG8_SCHED; PG8_LDA(At, 0, 0); PG8_STAGE(PG8_SA(1, 1), a1 + hstep, voffA);
            PG8_WAIT_L(8); PG8_BAR; PG8_WAIT_L(0); PG8_MMA(0, 0, At, B0); PG8_BAR; PG8_SCHED;
            PG8_LDB(B1, 0, 1); PG8_STAGE(PG8_SB(0, 0), b2, voffB);
            PG8_BAR; PG8_WAIT_L(0); PG8_MMA(0, 1, At, B1); PG8_BAR;
            PG8_LDA(At, 0, 1); PG8_STAGE(PG8_SA(0, 0), a2, voffA);
            PG8_BAR; PG8_WAIT_L(0); PG8_MMA(1, 0, At, B0); PG8_BAR; PG8_SCHED;
            PG8_STAGE(PG8_SB(0, 1), b2 + hstep, voffB);
            PG8_WAIT_V(6); PG8_BAR; PG8_MMA(1, 1, At, B1); PG8_BAR;
            PG8_LDB(B0, 1, 0); PG8_SCHED; PG8_LDA(At, 1, 0); PG8_STAGE(PG8_SA(0, 1), a2 + hstep, voffA);
            PG8_WAIT_L(8); PG8_BAR; PG8_WAIT_L(0); PG8_MMA(0, 0, At, B0); PG8_BAR; PG8_SCHED;
            PG8_LDB(B1, 1, 1); PG8_STAGE(PG8_SB(1, 0), b3, voffB);
            PG8_BAR; PG8_WAIT_L(0); PG8_MMA(0, 1, At, B1); PG8_BAR;
            PG8_LDA(At, 1, 1); PG8_STAGE(PG8_SA(1, 0), a3, voffA);
            PG8_BAR; PG8_WAIT_L(0); PG8_MMA(1, 0, At, B0); PG8_BAR; PG8_SCHED;
            PG8_STAGE(PG8_SB(1, 1), b3 + hstep, voffB);
            PG8_WAIT_V(6); PG8_BAR; PG8_MMA(1, 1, At, B1); PG8_BAR;
            }
        }
        if constexpr (ALIGN_EPI) { if (wr == 0) PG8_BAR; }
        if constexpr (!Epi::AFTER_DRAIN) { E(acc, cur, wr, wc, fr, fq); S.done(cur); }
        if (!has_next) break;
#pragma unroll
        for (int a = 0; a < 2; ++a)
#pragma unroll
            for (int b = 0; b < 2; ++b)
#pragma unroll
                for (int m = 0; m < 4; ++m)
#pragma unroll
                    for (int n = 0; n < 2; ++n) acc[a][b][m][n] = (f32x4){0.f, 0.f, 0.f, 0.f};
        cur = nxt; cA = nA; cB = nB; ++ui;
        if constexpr (ALIGN_EPI) { if (wr == 1) PG8_BAR; }
    }
    PG8_WAIT_V(0);
    if constexpr (!ALIGN_EPI) { if (wr == 0) PG8_BAR; }
    PG8_BAR;
    if constexpr (Epi::AFTER_DRAIN) { E.fused(acc, cur, wr, wc, fr, fq, lds, wid, lane); S.done(cur); }
#undef PG8_SA
#undef PG8_SB
#undef PG8_STAGE
#undef PG8_LDA
#undef PG8_LDB
#undef PG8_MMA
#undef PG8_WAIT_V
#undef PG8_WAIT_L
#undef PG8_BAR
#undef PG8_SCHED
}
}
#define GAS __attribute__((address_space(1)))
#define LAS __attribute__((address_space(3)))
typedef unsigned short bf16;
typedef unsigned char uchar;
typedef float f32x4 __attribute__((ext_vector_type(4)));
typedef float f32x2 __attribute__((ext_vector_type(2)));
typedef float f32x16 __attribute__((ext_vector_type(16)));
typedef short bf16x8 __attribute__((ext_vector_type(8)));
typedef short s16x4 __attribute__((ext_vector_type(4)));
typedef unsigned u32x4 __attribute__((ext_vector_type(4)));
typedef unsigned u32x2 __attribute__((ext_vector_type(2)));
typedef __bf16 hbf16x2 __attribute__((ext_vector_type(2)));
#define DI __device__ __forceinline__

DI unsigned pk2(float a, float b) { f32x2 v = {a, b}; hbf16x2 r = __builtin_convertvector(v, hbf16x2); return __builtin_bit_cast(unsigned, r); }
DI float bf2f(unsigned short b) { return __uint_as_float(((unsigned)b) << 16); }
DI float bflo(unsigned u) { return __uint_as_float(u << 16); }
DI float bfhi(unsigned u) { return __uint_as_float(u & 0xffff0000u); }
DI u32x2 pk4(f32x4 v) { u32x2 r; r.x = pk2(v[0], v[1]); r.y = pk2(v[2], v[3]); return r; }
DI float wave_sum(float v) {
#pragma unroll
    for (int o = 1; o < 64; o <<= 1) v += __shfl_xor(v, o);
    return v;
}
DI float wave_max(float v) {
#pragma unroll
    for (int o = 1; o < 64; o <<= 1) v = fmaxf(v, __shfl_xor(v, o));
    return v;
}
DI float silu_f(float x) { return x * __builtin_amdgcn_rcpf(1.f + __expf(-x)); }
DI float sigmoid_f(float x) { return __builtin_amdgcn_rcpf(1.f + __expf(-x)); }
DI float softplus_f(float x) { return x > 20.f ? x : log1pf(__expf(x)); }
#define LDS_BARRIER() do { asm volatile("s_waitcnt lgkmcnt(0)" ::: "memory"); __builtin_amdgcn_s_barrier(); asm volatile("" ::: "memory"); } while (0)
DI int crow(int r, int h) { return (r & 3) + 8 * (r >> 2) + 4 * h; }
template <class T> DI T ldg(const void* base, unsigned off) { return *(const T*)((const char*)base + off); }
template <class T> DI void stg(void* base, unsigned off, T v) { *(T*)((char*)base + off) = v; }

constexpr int DM = 2048, TP = 4096, NBP = 2, MP = NBP * TP, MS = 32, MALL = MP + MS, DFF = 5632, NGU = 2 * DFF;
constexpr int AQKV = 9216, BIN = 12352, BINM = 12288, CIN = 10304, CINM = 10240;
constexpr float DN_ALPHA = 1.6817928305074290f;
constexpr float LN_EPS = 1e-5f, RMS_EPS = 1e-6f;
constexpr int PASTLEN = 16384;

constexpr size_t O_YP = 0, O_YS = O_YP + (size_t)MP * DM, O_A128P = O_YS + (size_t)MS * DM,
    O_A128S = O_A128P + 1048576, O_A512P = O_A128S + 4194304, O_A512S = O_A512P + 4194304, O_A2048P = O_A512S + 16777216,
    O_A2048S = O_A2048P + 16777216, O_BSSMP = O_A2048S + 67108864, O_BSSMS = O_BSSMP + 1048576, O_BCONVP = O_BSSMS + 4194304,
    O_BCONVS = O_BCONVP + 49152, O_CSSMP = O_BCONVS + 196608, O_CSSMS = O_CSSMP + 1048576, O_CCONVP = O_CSSMS + 4194304,
    O_CCONVS = O_CCONVP + 36864, O_END = O_CCONVS + 147456;

constexpr size_t MiB = 1u << 20;
constexpr size_t WS_CTL = 0, CTL_ZERO_BYTES = 1 * MiB;
constexpr size_t WS_ROPE = 1 * MiB;
constexpr size_t WS_ZS = 2 * MiB, ZS_ONE = (size_t)MS * DM * 4;
constexpr size_t WS_W = 8 * MiB;
constexpr size_t GU_BYTES = (size_t)NGU * DM * 2, DN_BYTES = (size_t)DM * DFF * 2, FFN_BYTES = GU_BYTES + DN_BYTES;
constexpr size_t WS_WA = WS_W + 8 * FFN_BYTES, AQ_BYTES = (size_t)AQKV * DM * 2, AO_BYTES = (size_t)DM * 1024 * 2, A_BYTES = AQ_BYTES + AO_BYTES;
constexpr size_t WS_WB = WS_WA + 2 * A_BYTES, BI_BYTES = (size_t)BIN * DM * 2, BO_BYTES = (size_t)DM * 4096 * 2;
constexpr size_t WS_WC = WS_WB + BI_BYTES + BO_BYTES, CI_BYTES = (size_t)CIN * DM * 2, CO_BYTES = BO_BYTES;
constexpr size_t WS_XB = WS_WC + CI_BYTES + CO_BYTES;
constexpr size_t WS_ZP = WS_XB + (size_t)MALL * DM * 2;
constexpr size_t WS_H = WS_ZP + (size_t)MP * DM * 4;
constexpr size_t WS_MIX = WS_H + (size_t)MALL * DFF * 2;
constexpr size_t MA_QKV = WS_MIX, MA_QKVS = MA_QKV + (size_t)MP * AQKV * 2, MA_OG = MA_QKVS + (size_t)MS * AQKV * 4,
    MA_LSE = MA_OG + (size_t)3 * MP * 1024 * 2, MA_O = MA_LSE + (size_t)3 * MP * 8 * 4, MA_END = MA_O + (size_t)MALL * 1024 * 2;
constexpr size_t MB_PB = WS_MIX, MB_EB = MB_PB + (size_t)MP * BINM * 2, MB_PBS = MB_EB + (size_t)MP * 64 * 4, MB_WG = MB_PBS + (size_t)MS * BIN * 4,
    MB_UG = MB_WG + (size_t)MP * 32 * 128 * 2, MB_QG = MB_UG + (size_t)MP * 32 * 128 * 2, MB_KG = MB_QG + (size_t)MP * 16 * 128 * 2,
    MB_QKG = MB_KG + (size_t)MP * 16 * 128 * 2, MB_GCG = MB_QKG + (size_t)2 * 32 * 64 * 64 * 64 * 2, MB_YB = MB_GCG + (size_t)MP * 32 * 4,
    MB_SG = MB_YB + (size_t)MALL * 4096 * 2, MB_VNG = MB_SG + (size_t)4096 * 16384 * 2, MB_END = MB_VNG + (size_t)MP * 32 * 128 * 2;
constexpr size_t MC_PC = WS_MIX, MC_EC = MC_PC + (size_t)MP * CINM * 2, MC_PCS = MC_EC + (size_t)MP * 64 * 4, MC_SS = MC_PCS + (size_t)MS * CIN * 4,
    MC_YC = MC_SS + (size_t)MP * 64 * 4, MC_ACS = MC_YC + (size_t)MALL * 4096 * 2, MC_XBC = MC_ACS + (size_t)MP * 64 * 4, MC_END = MC_XBC + (size_t)MP * 6144 * 2;
constexpr size_t WS_END = (MB_END > MA_END ? (MB_END > MC_END ? MB_END : MC_END) : (MA_END > MC_END ? MA_END : MC_END));
static_assert(MA_QKVS % 256 == 0 && MA_OG % 256 == 0 && MA_O % 256 == 0 && MB_EB % 256 == 0 && MB_WG % 256 == 0 && MB_YB % 256 == 0 && MC_YC % 256 == 0 && WS_MIX % 256 == 0, "alignment");

constexpr int CW_BAR = 4096;
constexpr int SCR_BYTES = 143360, MISC_OFF = SCR_BYTES, LDS_BYTES = 147456;
constexpr int NWAVES = 8;

struct WDesc { const float* src; bf16* dst; int K, N, mode, item0; };
constexpr int NWD = 24;
struct Args { const float* in[31]; float* out; unsigned char* ws; WDesc wd[NWD]; int slot[6][2]; int cc[12]; int nitems; int pad; };

struct Frame {
    LAS uchar* lds;
    int tid, lane, wave, G, gw, NGW, bid;
};
#define XB_TMO      128
#define XB_XCNT(j)  (256  + 64 * (j))
#define XB_XSUB(j)  (1280 + 64 * (j))
#define XB_XGEN(j)  (2304 + 64 * (j))
#define XB_TOP      3328
#define XB_TOPGEN   3392
#define XCD_BAR_WORDS 3456
#define XB_SPIN_CAP (1u << 18)

__device__ __forceinline__ unsigned xb_ld(unsigned* p)              { return __hip_atomic_load(p, __ATOMIC_RELAXED, __HIP_MEMORY_SCOPE_AGENT); }
__device__ __forceinline__ unsigned xb_add(unsigned* p, unsigned v) { return __hip_atomic_fetch_add(p, v, __ATOMIC_RELAXED, __HIP_MEMORY_SCOPE_AGENT); }
__device__ __forceinline__ unsigned xb_xcc_id() { return (unsigned)__builtin_amdgcn_s_getreg((3 << 11) | 20) & 0xFu; }
#define XB_SPIN(cond, bar) do { unsigned _sp = 0; while (cond) { __builtin_amdgcn_s_sleep(1); \
    if ((++_sp & 255u) == 0u) { if (xb_ld(&(bar)[XB_TMO])) break; if (_sp > XB_SPIN_CAP) { atomicAdd(&(bar)[XB_TMO], 1u); break; } } } } while (0)

struct XcdBarrier {
    unsigned* bar; unsigned x;
    volatile LAS unsigned* st;
};

__device__ __forceinline__ XcdBarrier xcd_barrier_post(unsigned* bar, volatile LAS unsigned* st) {
    XcdBarrier b; b.bar = bar; b.x = xb_xcc_id(); b.st = st;
    if (threadIdx.x == 0) (void)xb_add(&bar[XB_XCNT(b.x)], 1u);
    return b;
}
__device__ __forceinline__ void xcd_barrier_complete(unsigned* bar, unsigned x, unsigned& nloc, unsigned& nx) {
    const unsigned G = gridDim.x * gridDim.y * gridDim.z;
    unsigned sum, cnt, mine, sp = 0u;
    for (;;) {
        sum = 0u; cnt = 0u; mine = 0u;
#pragma unroll
        for (unsigned j = 0; j < 16; ++j) { const unsigned c = xb_ld(&bar[XB_XCNT(j)]); sum += c; cnt += (c > 0u) ? 1u : 0u; mine = (j == x) ? c : mine; }
        if (sum == G) break;
        __builtin_amdgcn_s_sleep(1);
        if ((++sp & 255u) == 0u) { if (xb_ld(&bar[XB_TMO])) break; if (sp > XB_SPIN_CAP) { atomicAdd(&bar[XB_TMO], 1u); break; } }
    }
    nloc = mine > 0u ? mine : 1u; nx = cnt > 0u ? cnt : 1u;
}

__device__ __forceinline__ void xcd_barrier(const XcdBarrier& b) {
    asm volatile("s_waitcnt vmcnt(0)" ::: "memory");
    __syncthreads();
    if (threadIdx.x == 0) {
        unsigned* bar = b.bar;
        __builtin_amdgcn_s_waitcnt(0);
        unsigned nloc = b.st[0], nx = b.st[1];
        if (nloc == 0u) { xcd_barrier_complete(bar, b.x, nloc, nx); b.st[0] = nloc; b.st[1] = nx; }
        const unsigned old = xb_add(&bar[XB_XSUB(b.x)], 1u);
        const unsigned gen = old / nloc;
        if (old + 1u == (gen + 1u) * nloc) {
            __builtin_amdgcn_fence(__ATOMIC_RELEASE, "agent");
            asm volatile("s_waitcnt vmcnt(0)" ::: "memory");
            const unsigned og = xb_add(&bar[XB_TOP], 1u);
            const unsigned tg = og / nx;
            if (og + 1u == (tg + 1u) * nx) xb_add(&bar[XB_TOPGEN], 1u);
            else XB_SPIN(xb_ld(&bar[XB_TOPGEN]) == tg, bar);
            __builtin_amdgcn_fence(__ATOMIC_ACQUIRE, "agent");
            xb_add(&bar[XB_XGEN(b.x)], 1u);
            asm volatile("s_waitcnt vmcnt(0)" ::: "memory");
        } else {
            XB_SPIN(xb_ld(&bar[XB_XGEN(b.x)]) == gen, bar);
            __builtin_amdgcn_fence(__ATOMIC_ACQUIRE, "agent");
            asm volatile("s_waitcnt vmcnt(0)" ::: "memory");
        }
    }
    __syncthreads();
}
struct FSwiglu {
    bf16* H;
    DI void operator()(int row, int col, f32x4 lo, f32x4 hi) const {
        f32x4 r;
#pragma unroll
        for (int e = 0; e < 4; ++e) r[e] = silu_f(lo[e]) * hi[e];
        *(u32x2*)(H + (size_t)row * DFF + ((col >> 5) << 4) + (col & 15)) = pk4(r);
    }
};
struct FResid {
    const bf16* XB; float* Z; long zrow_off; float s; int atomic, add_x;
    DI void operator()(int row, int col, f32x4 lo, f32x4 hi) const {
        float* zp = Z + ((long)row - zrow_off) * DM + col;
        f32x4 a = lo * s, b = hi * s;
        if (add_x) {
            const u32x2 x0 = *(const u32x2*)(XB + (size_t)row * DM + col), x1 = *(const u32x2*)(XB + (size_t)row * DM + col + 16);
            a[0] += bflo(x0.x) * DN_ALPHA; a[1] += bfhi(x0.x) * DN_ALPHA; a[2] += bflo(x0.y) * DN_ALPHA; a[3] += bfhi(x0.y) * DN_ALPHA;
            b[0] += bflo(x1.x) * DN_ALPHA; b[1] += bfhi(x1.x) * DN_ALPHA; b[2] += bflo(x1.y) * DN_ALPHA; b[3] += bfhi(x1.y) * DN_ALPHA;
        }
        if (atomic) {
#pragma unroll
            for (int e = 0; e < 4; ++e) { atomicAdd(zp + e, a[e]); atomicAdd(zp + 16 + e, b[e]); }
        } else { *(f32x4*)zp = a; *(f32x4*)(zp + 16) = b; }
    }
};
struct FBf16 {
    bf16* P; int ld;
    DI void operator()(int row, int col, f32x4 lo, f32x4 hi) const {
        bf16* p = P + (size_t)row * ld + col;
        *(u32x2*)p = pk4(lo); *(u32x2*)(p + 16) = pk4(hi);
    }
};
struct FF32 {
    float* P; int ld, row_off, col_off;
    DI void operator()(int row, int col, f32x4 lo, f32x4 hi) const {
        float* p = P + (size_t)(row - row_off) * ld + (col - col_off);
        *(f32x4*)p = lo; *(f32x4*)(p + 16) = hi;
    }
};
struct FQkv {
    bf16* QKV; float* QKVS; const float* rope; float* out; int j;
    DI void operator()(int row, int col, f32x4 lo, f32x4 hi) const {
        const int s = col / 3072, rem = col - s * 3072, g = rem >> 10, hh = (rem >> 7) & 7, d = rem & 127;
        const bool smp = row >= MP;
        const int pidx = smp ? TP + ((row - MP) & 3) : (row & (TP - 1));
        if (s < 2 && d < 16) {
            const f32x4 c = *(const f32x4*)(rope + (size_t)pidx * 32 + d), sn = *(const f32x4*)(rope + (size_t)pidx * 32 + 16 + d);
            const f32x4 x1 = lo, x2 = hi;
            lo = x1 * c - x2 * sn; hi = x2 * c + x1 * sn;
        }
        const int keep = 128 << (2 * g);
        if (!smp) {
            bf16* p = QKV + (size_t)row * AQKV + col;
            *(u32x2*)p = pk4(lo); *(u32x2*)(p + 16) = pk4(hi);
            if (s >= 1) {
                const int t = row & (TP - 1), b = row >> 12;
                if (t >= TP - keep) {
                    float* dst = out + (g == 0 ? O_A128P : g == 1 ? O_A512P : O_A2048P) + ((((size_t)(j * NBP + b) * keep + (t - (TP - keep))) * 2 + (s - 1)) * 8 + hh) * 128 + d;
                    *(f32x4*)dst = lo; *(f32x4*)(dst + 16) = hi;
                }
            }
        } else {
            const int r = row - MP, b = r >> 2, t = r & 3;
            float* p = QKVS + (size_t)r * AQKV + col;
            *(f32x4*)p = lo; *(f32x4*)(p + 16) = hi;
            if (s >= 1) {
                float* dst = out + (g == 0 ? O_A128S : g == 1 ? O_A512S : O_A2048S) + ((((size_t)(j * 8 + b) * keep + (keep - 4 + t)) * 2 + (s - 1)) * 8 + hh) * 128 + d;
                *(f32x4*)dst = lo; *(f32x4*)(dst + 16) = hi;
            }
        }
    }
};
template <class F> struct EpiWrap {
    static constexpr bool PERM = false, AFTER_DRAIN = false;
    F f;
    DI void operator()(const pg8::f32x4 (&acc)[2][2][4][2], const pg8::Unit& u, int wr, int wc, int fr, int fq) const {
#pragma unroll
        for (int ai = 0; ai < 2; ++ai)
#pragma unroll
            for (int m = 0; m < 4; ++m) {
                const int row = u.pm * 256 + ai * 128 + wr * 64 + m * 16 + fr;
#pragma unroll
                for (int bj = 0; bj < 2; ++bj) f(row, u.pn * 256 + bj * 128 + wc * 32 + 4 * fq, acc[ai][bj][m][0], acc[ai][bj][m][1]);
            }
    }
};

template <int NF, class F>
DI void skinny_unit(const Frame& Fr, const bf16* A, int lda, int row0, const bf16* Wt, int K, int f0, int kbeg, int klen, const F& f) {
    const int lane = Fr.lane, w = Fr.wave, r = lane & 31, h = lane >> 5;
    const int kw = klen >> 3, k0 = kbeg + w * kw;
    f32x16 acc[NF];
#pragma unroll
    for (int nf = 0; nf < NF; ++nf)
#pragma unroll
        for (int i = 0; i < 16; ++i) acc[nf][i] = 0.f;
    const bf16* ap = A + (size_t)(row0 + r) * lda + k0 + 8 * h;
    const bf16* wp = Wt + (size_t)(f0 + r) * K + k0 + 8 * h;
#pragma unroll 4
    for (int k = 0; k < kw; k += 16) {
        const bf16x8 b = *(const bf16x8*)(ap + k);
#pragma unroll
        for (int nf = 0; nf < NF; ++nf) {
            const bf16x8 a = *(const bf16x8*)(wp + (size_t)nf * 32 * K + k);
            acc[nf] = __builtin_amdgcn_mfma_f32_32x32x16_bf16(a, b, acc[nf], 0, 0, 0);
        }
    }
    LAS float* red = (LAS float*)Fr.lds;
#pragma unroll
    for (int nf = 0; nf < NF; ++nf)
#pragma unroll
        for (int i = 0; i < 16; ++i) red[((w * NF + nf) * 16 + i) * 64 + lane] = acc[nf][i];
    __syncthreads();
    if (w < 2 * NF) {
        const int nf = w >> 1, g = w & 1;
        f32x4 lo = {0.f, 0.f, 0.f, 0.f}, hi = {0.f, 0.f, 0.f, 0.f};
#pragma unroll
        for (int ww = 0; ww < 8; ++ww)
#pragma unroll
            for (int e = 0; e < 4; ++e) {
                lo[e] += red[((ww * NF + nf) * 16 + 4 * g + e) * 64 + lane];
                hi[e] += red[((ww * NF + nf) * 16 + 4 * g + 8 + e) * 64 + lane];
            }
        f(row0 + r, f0 + 32 * nf + 8 * g + 4 * h, lo, hi);
    }
    __syncthreads();
}
#define MFMA32(a, b, c) __builtin_amdgcn_mfma_f32_32x32x16_bf16((a), (b), (c), 0, 0, 0)
DI s16x4 lds_tr(LAS const uchar* p) { return __builtin_amdgcn_ds_read_tr16_b64_v4i16((LAS s16x4*)p); }
DI bf16x8 frag_xk(LAS const uchar* base, int ld, int x0, int k0, int lane) {
    return *(LAS const bf16x8*)(base + (x0 + (lane & 31)) * ld + (k0 + 8 * (lane >> 5)) * 2);
}
DI bf16x8 frag_kx(LAS const uchar* base, int ld, int x0, int k0, int lane) {
    const int h = lane >> 5, blk = (lane >> 4) & 1, q = (lane & 15) >> 2, p = lane & 3;
    LAS const uchar* a = base + (k0 + 8 * h + q) * ld + (x0 + 16 * blk + 4 * p) * 2;
    const s16x4 lo = lds_tr(a), hi = lds_tr(a + 4 * ld);
    return __builtin_shufflevector(lo, hi, 0, 1, 2, 3, 4, 5, 6, 7);
}
DI bf16x8 frag_kx_perm(LAS const uchar* base, int ld, int x0, int k0, int lane) {
    const int h = lane >> 5, blk = (lane >> 4) & 1, q = (lane & 15) >> 2, p = lane & 3;
    LAS const uchar* a = base + (k0 + 4 * h + q) * ld + (x0 + 16 * blk + 4 * p) * 2;
    const s16x4 lo = lds_tr(a), hi = lds_tr(a + 8 * ld);
    return __builtin_shufflevector(lo, hi, 0, 1, 2, 3, 4, 5, 6, 7);
}
DI bf16x8 pack_step(const f32x16& x, int s) {
    u32x4 p;
    p.x = pk2(x[8 * s + 0], x[8 * s + 1]); p.y = pk2(x[8 * s + 2], x[8 * s + 3]); p.z = pk2(x[8 * s + 4], x[8 * s + 5]); p.w = pk2(x[8 * s + 6], x[8 * s + 7]);
    return __builtin_bit_cast(bf16x8, p);
}
DI f32x16 zero16() { f32x16 z;
#pragma unroll
    for (int i = 0; i < 16; ++i) z[i] = 0.f; return z; }
template <bool A_KX, bool B_KX>
DI f32x16 mm_tile(f32x16 acc, LAS const uchar* A, int lda, int am0, LAS const uchar* B, int ldb, int bn0, int ksteps, int lane) {
#pragma unroll 4
    for (int s = 0; s < ksteps; ++s) {
        const bf16x8 a = A_KX ? frag_kx(A, lda, am0, 16 * s, lane) : frag_xk(A, lda, am0, 16 * s, lane);
        const bf16x8 b = B_KX ? frag_kx(B, ldb, bn0, 16 * s, lane) : frag_xk(B, ldb, bn0, 16 * s, lane);
        acc = MFMA32(a, b, acc);
    }
    return acc;
}

DI void tr_item(const WDesc& d, int item, LAS float* scr, int lane) {
    const int nnt = d.N >> 6, kt = item / nnt, nt = item - kt * nnt, k0 = kt << 6, n0 = nt << 6;
    const float* src = d.src + (size_t)k0 * d.N + n0 + 4 * (lane & 15);
#pragma unroll 8
    for (int i = 0; i < 16; ++i) {
        const int kk = 4 * i + (lane >> 4);
        const f32x4 v = *(const f32x4*)(src + (size_t)kk * d.N);
        LAS float* s = scr + kk * 65 + 4 * (lane & 15);
        s[0] = v[0]; s[1] = v[1]; s[2] = v[2]; s[3] = v[3];
    }
    asm volatile("s_waitcnt lgkmcnt(0)" ::: "memory");
    const int c = lane & 7;
#pragma unroll
    for (int j = 0; j < 8; ++j) {
        const int n = (lane >> 3) + 8 * j;
        LAS const float* s = scr + (8 * c) * 65 + n;
        u32x4 o; o.x = pk2(s[0], s[65]); o.y = pk2(s[2 * 65], s[3 * 65]); o.z = pk2(s[4 * 65], s[5 * 65]); o.w = pk2(s[6 * 65], s[7 * 65]);
        const int ns = n0 + n;
        int drow = ns;
        if (d.mode == 1) { const int jj = ns < DFF ? ns : ns - DFF; drow = ((jj >> 4) << 5) + (ns < DFF ? 0 : 16) + (jj & 15); }
        *(u32x4*)(d.dst + (size_t)drow * d.K + k0 + 8 * c) = o;
    }
    asm volatile("s_waitcnt lgkmcnt(0)" ::: "memory");
}
DI void convert_items(const Frame& F, const Args& a, int i0, int i1, int gw, int ngw) {
    LAS float* scr = (LAS float*)(F.lds + F.wave * 16640);
    for (int it = i0 + gw; it < i1; it += ngw) {
        int m = 0;
#pragma unroll 1
        for (int q = 1; q < NWD; ++q) if (it >= a.wd[q].item0) m = q;
        tr_item(a.wd[m], it - a.wd[m].item0, scr, F.lane);
    }
}
constexpr int CC_PER0 = 124 * 512, CC_PER1 = 508 * 512, CC_PER2 = 2044 * 512, CC_T0 = 16 * CC_PER0, CC_T1 = CC_T0 + 16 * CC_PER1, CC_TOT = CC_T1 + 16 * CC_PER2;
DI void cache_copy(const Args& a, int f0, int f1, int gt, int nt) {
    for (int i = f0 + gt; i < f1; i += nt) {
        const int g = i < CC_T0 ? 0 : i < CC_T1 ? 1 : 2;
        const int li = i - (g == 0 ? 0 : g == 1 ? CC_T0 : CC_T1), per = g == 0 ? CC_PER0 : g == 1 ? CC_PER1 : CC_PER2, wb = 128 << (2 * g);
        const int blk = li / per, o = li - blk * per;
        const float* src = g == 0 ? a.in[2] : g == 1 ? a.in[3] : a.in[4];
        float* dst = a.out + (g == 0 ? O_A128S : g == 1 ? O_A512S : O_A2048S);
        const size_t base = (size_t)blk * wb * 2048;
        *(f32x4*)(dst + base + (size_t)o * 4) = *(const f32x4*)(src + base + 8192 + (size_t)o * 4);
    }
}
DI void bg_slot(const Frame& F, const Args& a, int k, int first) {
    if (F.bid < first || F.G <= first) return;
    convert_items(F, a, a.slot[k][0], a.slot[k][1], (F.bid - first) * NWAVES + F.wave, (F.G - first) * NWAVES);
}
DI void prologue(const Frame& F, const Args& a) {
    uchar* ws = a.ws;
    convert_items(F, a, a.slot[0][0], a.slot[0][1], F.gw, F.NGW);
    const int gt = F.gw * 64 + F.lane, NT = F.NGW * 64;
    {
        float* rope = (float*)(ws + WS_ROPE);
        for (int i = gt; i < 4100 * 16; i += NT) {
            const int pidx = i >> 4, f = i & 15;
            const int pos = pidx < TP ? pidx : PASTLEN + (pidx - TP);
            const float inv = (float)exp2(-(double)f * (18.931568569324174 / 16.0));
            const float ang = (float)pos * inv;
            const double rev = (double)ang * 0.15915494309189535;
            const float fr = (float)(rev - floor(rev));
            rope[(size_t)pidx * 32 + f] = __builtin_amdgcn_cosf(fr);
            rope[(size_t)pidx * 32 + 16 + f] = __builtin_amdgcn_sinf(fr);
        }
    }
    { f32x4* z = (f32x4*)(ws + WS_ZS); const f32x4 zz = {0.f, 0.f, 0.f, 0.f}; for (int i = gt; i < (int)(12 * ZS_ONE / 16); i += NT) z[i] = zz; }
    {
        bf16* XB = (bf16*)(ws + WS_XB);
        for (int i = gt; i < MALL * DM / 4; i += NT) {
            const size_t e = (size_t)i * 4;
            const f32x4 v = e < (size_t)MP * DM ? *(const f32x4*)(a.in[0] + e) : *(const f32x4*)(a.in[1] + (e - (size_t)MP * DM));
            *(u32x2*)(XB + e) = pk4(v);
        }
    }
}

DI void ln_phase(const Frame& F, const float* Zp, const float* Zs, const float* g, const float* b, float* Xf  , bf16* XB) {
    f32x4 gv[8], bv[8];
#pragma unroll
    for (int j = 0; j < 8; ++j) { gv[j] = *(const f32x4*)(g + 4 * F.lane + 256 * j); bv[j] = *(const f32x4*)(b + 4 * F.lane + 256 * j); }
    for (int row = F.gw; row < MALL; row += F.NGW) {
        const float* z = row < MP ? Zp + (size_t)row * DM : Zs + (size_t)(row - MP) * DM;
        f32x4 v[8]; float s = 0.f;
#pragma unroll
        for (int j = 0; j < 8; ++j) { v[j] = *(const f32x4*)(z + 4 * F.lane + 256 * j); s += (v[j][0] + v[j][1]) + (v[j][2] + v[j][3]); }
        const float mean = wave_sum(s) * (1.f / DM); float s2 = 0.f;
#pragma unroll
        for (int j = 0; j < 8; ++j) { v[j] = v[j] - mean; s2 += (v[j][0] * v[j][0] + v[j][1] * v[j][1]) + (v[j][2] * v[j][2] + v[j][3] * v[j][3]); }
        const float rstd = 1.f / sqrtf(wave_sum(s2) * (1.f / DM) + LN_EPS);
        bf16* xb = XB + (size_t)row * DM + 4 * F.lane;
#pragma unroll
        for (int j = 0; j < 8; ++j) { const f32x4 y = v[j] * rstd * gv[j] + bv[j]; *(u32x2*)(xb + 256 * j) = pk4(y); if (Xf) *(f32x4*)(Xf + (size_t)row * DM + 4 * F.lane + 256 * j) = y; }
    }
}
DI void attn_prompt_unit(const Frame& F, int u, const bf16* QKV, bf16* OG, float* LSE, bf16* O) {
    const int b = u >> 7, hd = (u >> 4) & 7, ck = u & 15;
    const int lane = F.lane, w = F.wave, qi = lane & 31, h = lane >> 5;
    constexpr int LDV = 272;
    LAS uchar* Vl = F.lds + w * (32 * LDV);
    const float SC = 0.08838834764831845f * 1.4426950408889634f;
    for (int it = 0; it < 4; ++it) {
        const int tl = w + 8 * it, g = tl < 8 ? 0 : tl < 16 ? 1 : 2, idx = tl < 16 ? (tl & 7) : tl - 16;
        const int dil = 1 << (2 * g);
        int r, Lb, nq = 32;
        if (g == 0) { r = 0; Lb = ck * 256 + 32 * idx; } else if (g == 1) { r = idx & 3; Lb = ck * 64 + 32 * (idx >> 2); } else { r = idx; Lb = ck * 16; nq = 16; }
        const int qv = qi < nq ? qi : nq - 1;
        const int rowb = b * TP;
        const int colQ = g * 1024 + hd * 128, colK = 3072 + colQ, colV = 6144 + colQ;
        bf16x8 qf[8];
        {
            const unsigned qo = (unsigned)(((rowb + r + dil * (Lb + qv)) * AQKV + colQ + 8 * h) * 2);
#pragma unroll
            for (int s = 0; s < 8; ++s) qf[s] = ldg<bf16x8>(QKV, qo + 32 * s);
        }
        f32x16 st[5];
#pragma unroll
        for (int kb = 0; kb < 5; ++kb) {
            int Lk = Lb - 128 + 32 * kb + qi; if (Lk < 0) Lk = 0; if (Lk > Lb + nq - 1) Lk = Lb + nq - 1;
            const unsigned ko = (unsigned)(((rowb + r + dil * Lk) * AQKV + colK + 8 * h) * 2);
            f32x16 acc = zero16();
#pragma unroll
            for (int s = 0; s < 8; ++s) { const bf16x8 kf = ldg<bf16x8>(QKV, ko + 32 * s); acc = MFMA32(kf, qf[s], acc); }
            st[kb] = acc;
        }
        float m = -INFINITY;
        {
            int lo = qv; if (128 - Lb > lo) lo = 128 - Lb;
            const int a0 = 4 * h - lo, b0 = 128 + qv - 4 * h;
#pragma unroll
            for (int kb = 0; kb < 5; ++kb)
#pragma unroll
                for (int i = 0; i < 16; ++i) {
                    const int cst = 32 * kb + (i & 3) + 8 * (i >> 2);
                    const unsigned msk = (unsigned)(((a0 + cst) | (b0 - cst)) >> 31);
                    const unsigned xb = __float_as_uint(st[kb][i] * SC);
                    const float sv = __uint_as_float((xb & ~msk) | (0xff800000u & msk));
                    st[kb][i] = sv; m = fmaxf(m, sv);
                }
        }
        m = fmaxf(m, __shfl_xor(m, 32));
        float l = 0.f;
#pragma unroll
        for (int kb = 0; kb < 5; ++kb)
#pragma unroll
            for (int i = 0; i < 16; ++i) { const float p = exp2f(st[kb][i] - m); st[kb][i] = p; l += p; }
        l += __shfl_xor(l, 32);
        f32x16 ot[4];
#pragma unroll
        for (int c = 0; c < 4; ++c) ot[c] = zero16();
#pragma unroll
        for (int kb = 0; kb < 5; ++kb) {
#pragma unroll
            for (int i = 0; i < 8; ++i) {
                const int cid = lane + 64 * i, key = cid >> 4, ch = cid & 15;
                int Lk = Lb - 128 + 32 * kb + key; if (Lk < 0) Lk = 0; if (Lk > Lb + nq - 1) Lk = Lb + nq - 1;
                const u32x4 v = ldg<u32x4>(QKV, (unsigned)(((rowb + r + dil * Lk) * AQKV + colV + 8 * ch) * 2));
                *(LAS u32x4*)(Vl + key * LDV + ch * 16) = v;
            }
#pragma unroll
            for (int s = 0; s < 2; ++s) {
                const bf16x8 pb = pack_step(st[kb], s);
#pragma unroll
                for (int c = 0; c < 4; ++c) { const bf16x8 af = frag_kx_perm(Vl, LDV, 32 * c, 16 * s, lane); ot[c] = MFMA32(af, pb, ot[c]); }
            }
        }
        const float rl = 1.f / l;
        const int orow = rowb + r + dil * (Lb + qv);
        if (qi < nq) {
        const unsigned oo = (unsigned)((((g * MP + orow) * 1024) + hd * 128 + 4 * h) * 2);
#pragma unroll
        for (int c = 0; c < 4; ++c)
#pragma unroll
            for (int gq = 0; gq < 4; ++gq) {
                f32x4 v = {ot[c][4 * gq] * rl, ot[c][4 * gq + 1] * rl, ot[c][4 * gq + 2] * rl, ot[c][4 * gq + 3] * rl};
                stg<u32x2>(OG, oo + (32 * c + 8 * gq) * 2, pk4(v));
            }
        if (h == 0) stg<float>(LSE, (unsigned)(((g * MP + orow) * 8 + hd) * 4), (m + log2f(l)) * 0.6931471805599453f);
        }
    }
    asm volatile("s_waitcnt vmcnt(0)" ::: "memory");
    __syncthreads();
    __builtin_amdgcn_fence(__ATOMIC_ACQUIRE, "agent");
    const int l16 = F.tid & 15;
#pragma unroll 2
    for (int it = 0; it < 8; ++it) {
        const int tok = ck * 256 + (F.tid >> 4) + 32 * it;
        const int row = b * TP + tok;
        const float l0 = ldg<float>(LSE, (unsigned)((row * 8 + hd) * 4)), l1 = ldg<float>(LSE, (unsigned)(((MP + row) * 8 + hd) * 4)), l2 = ldg<float>(LSE, (unsigned)(((2 * MP + row) * 8 + hd) * 4));
        const float mx = fmaxf(l0, fmaxf(l1, l2));
        float w0 = __expf(l0 - mx), w1 = __expf(l1 - mx), w2 = __expf(l2 - mx);
        const float ws = 1.f / (w0 + w1 + w2); w0 *= ws; w1 *= ws; w2 *= ws;
        const unsigned off = (unsigned)((row * 1024 + hd * 128 + 8 * l16) * 2);
        const u32x4 a0 = ldg<u32x4>(OG, off), a1 = ldg<u32x4>(OG, off + MP * 1024 * 2), a2 = ldg<u32x4>(OG, off + 2 * MP * 1024 * 2);
        u32x4 o;
#pragma unroll
        for (int e = 0; e < 4; ++e)
            o[e] = pk2(w0 * bflo(a0[e]) + w1 * bflo(a1[e]) + w2 * bflo(a2[e]), w0 * bfhi(a0[e]) + w1 * bfhi(a1[e]) + w2 * bfhi(a2[e]));
        stg<u32x4>(O, off, o);
    }
    __syncthreads();
}

DI void attn_sample_unit(const Frame& F, int su, const float* QKVS, const float* cache0, const float* cache1, const float* cache2, int j, bf16* O) {
    const int b = su >> 5, hd = (su >> 2) & 7, t = su & 3;
    const int lane = F.lane, w = F.wave, l32 = lane & 31, hw = lane >> 5;
    LAS float* sc = (LAS float*)F.lds;
    LAS float* part = (LAS float*)(F.lds + 4096);
    if (w < 6) {
        const int g = w >> 1, half = w & 1, dil = 1 << (2 * g), wb = 128 << (2 * g);
        const int j0 = half * 65, cnt = half ? 64 : 65;
        const float* cg = (g == 0 ? cache0 : g == 1 ? cache1 : cache2) + ((size_t)(j * 8 + b) * wb) * 2048 + hd * 128 + 4 * l32;
        const float* qn = QKVS + (size_t)(b * 4) * AQKV + g * 1024 + hd * 128 + 4 * l32;
        const f32x4 q4 = *(const f32x4*)(qn + (size_t)t * AQKV);
#pragma unroll 11
        for (int it = 0; it < 33; ++it) {
            const int jl = 2 * it + hw;
            float s = 0.f;
            if (jl < cnt) {
                const int idx = wb + t - dil * (j0 + jl);
                const float* kp = idx >= wb ? qn + (size_t)(idx - wb) * AQKV + 3072 : cg + (size_t)idx * 2048;
                const f32x4 k4 = *(const f32x4*)kp;
                s = q4[0] * k4[0] + q4[1] * k4[1] + q4[2] * k4[2] + q4[3] * k4[3];
            }
#pragma unroll
            for (int o = 1; o < 32; o <<= 1) s += __shfl_xor(s, o);
            if (l32 == 0 && jl < cnt) sc[w * 80 + jl] = s * 0.08838834764831845f;
        }
        asm volatile("s_waitcnt lgkmcnt(0)" ::: "memory");
        float m = lane < cnt ? sc[w * 80 + lane] : -INFINITY;
        if (lane == 0 && cnt == 65) m = fmaxf(m, sc[w * 80 + 64]);
        m = wave_max(m);
        float lsum = 0.f; f32x4 acc = {0.f, 0.f, 0.f, 0.f};
#pragma unroll 11
        for (int it = 0; it < 33; ++it) {
            const int jl = 2 * it + hw;
            if (jl < cnt) {
                const int idx = wb + t - dil * (j0 + jl);
                const float* vp = idx >= wb ? qn + (size_t)(idx - wb) * AQKV + 6144 : cg + (size_t)idx * 2048 + 1024;
                const f32x4 v4 = *(const f32x4*)vp;
                const float p = __expf(sc[w * 80 + jl] - m);
                lsum += p; acc += v4 * p;
            }
        }
        lsum += __shfl_xor(lsum, 32);
#pragma unroll
        for (int e = 0; e < 4; ++e) acc[e] += __shfl_xor(acc[e], 32);
        if (lane == 0) { part[w * 136] = m; part[w * 136 + 1] = lsum; }
        if (lane < 32) *(LAS f32x4*)(part + w * 136 + 8 + 4 * l32) = acc;
    }
    __syncthreads();
    if (w == 0 && lane < 32) {
        float M = -INFINITY;
#pragma unroll
        for (int ww = 0; ww < 6; ++ww) M = fmaxf(M, part[ww * 136]);
        float L = 0.f; f32x4 o = {0.f, 0.f, 0.f, 0.f};
#pragma unroll
        for (int ww = 0; ww < 6; ++ww) { const float e = __expf(part[ww * 136] - M); L += part[ww * 136 + 1] * e; o += *(LAS const f32x4*)(part + ww * 136 + 8 + 4 * l32) * e; }
        o = o * (1.f / L);
        *(u32x2*)(O + (size_t)(MP + b * 4 + t) * 1024 + hd * 128 + 4 * l32) = pk4(o);
    }
    __syncthreads();
}
struct BPtrs {
    const bf16* PB; const float* EB; const float* PBS; bf16 *WG, *UG, *QG, *KG, *QKG; float* GCG; bf16* YB; bf16 *SG, *VNG;
    const float *conv_w, *a_log, *dt_bias, *norm_w, *ssm0, *conv0;
    float *ssm_p, *ssm_s, *conv_p, *conv_s;
};
DI void bprep_unit(const Frame& F, int pu, const BPtrs& P) {
    const int b = pu >> 10, n = (pu >> 4) & 63, hq = pu & 15;
    int lane = F.lane, tid = F.tid; asm volatile("" : "+v"(lane), "+v"(tid));
    const int w = F.wave, t0 = n * 64;
    constexpr int LD = 272, LDT = 144;
    LAS uchar* Kl = F.lds; LAS uchar* V0l = F.lds + 17408; LAS uchar* V1l = F.lds + 34816; LAS uchar* Ql = F.lds + 52224;
    LAS float* Gkk = (LAS float*)(F.lds + 69632); LAS float* Gqk = (LAS float*)(F.lds + 86016);
    LAS float* LT = (LAS float*)(F.lds + 102400);
    LAS uchar* Tb = F.lds + 52224;
    LAS float* betaL = (LAS float*)(F.lds + 135168); LAS float* gcL = betaL + 128; LAS float* egL = gcL + 128;
    for (int it = 0; it < 8; ++it) {
        const int task = w + 8 * it, mt = task >> 4, rg = task & 15;
        const int i = 4 * rg + (lane >> 4), ch = lane & 15, t = t0 + i;
        const int cb = mt == 0 ? hq * 128 : mt == 1 ? 2048 + hq * 128 : 4096 + (2 * hq + (mt - 2)) * 128;
        const int col = cb + 8 * ch;
        float y[8];
#pragma unroll
        for (int e = 0; e < 8; ++e) y[e] = 0.f;
#pragma unroll
        for (int jj = 0; jj < 4; ++jj) {
            const int tt = t - 3 + jj;
            u32x4 x = {0u, 0u, 0u, 0u};
            if (tt >= 0) x = ldg<u32x4>(P.PB, (unsigned)(((b * TP + tt) * BINM + col) * 2));
            const f32x4 w0 = ldg<f32x4>(P.conv_w, (unsigned)((jj * 8192 + col) * 4)), w1 = ldg<f32x4>(P.conv_w, (unsigned)((jj * 8192 + col + 4) * 4));
            y[0] += bflo(x[0]) * w0[0]; y[1] += bfhi(x[0]) * w0[1]; y[2] += bflo(x[1]) * w0[2]; y[3] += bfhi(x[1]) * w0[3];
            y[4] += bflo(x[2]) * w1[0]; y[5] += bfhi(x[2]) * w1[1]; y[6] += bflo(x[3]) * w1[2]; y[7] += bfhi(x[3]) * w1[3];
        }
        float ss = 0.f;
#pragma unroll
        for (int e = 0; e < 8; ++e) { y[e] = silu_f(y[e]); ss += y[e] * y[e]; }
        if (mt < 2) {
#pragma unroll
            for (int o = 1; o < 16; o <<= 1) ss += __shfl_xor(ss, o);
            const float rn = rsqrtf(ss + 1e-6f) * (mt == 0 ? 0.08838834764831845f : 1.f);
#pragma unroll
            for (int e = 0; e < 8; ++e) y[e] *= rn;
        }
        u32x4 o; o.x = pk2(y[0], y[1]); o.y = pk2(y[2], y[3]); o.z = pk2(y[4], y[5]); o.w = pk2(y[6], y[7]);
        LAS uchar* dst = mt == 0 ? Ql : mt == 1 ? Kl : mt == 2 ? V0l : V1l;
        *(LAS u32x4*)(dst + i * LD + ch * 16) = o;
        if (mt == 0) stg<u32x4>(P.QG, (unsigned)((((b * 16 + hq) * TP + t) * 128 + 8 * ch) * 2), o);
        if (mt == 1) stg<u32x4>(P.KG, (unsigned)((((b * 16 + hq) * TP + t) * 128 + 8 * ch) * 2), o);
    }
    __syncthreads();
    {
        const int which = w >> 2, ti = (w >> 1) & 1, tj = w & 1;
        f32x16 acc = mm_tile<false, false>(zero16(), which ? Ql : Kl, LD, 32 * ti, Kl, LD, 32 * tj, 8, lane);
        LAS float* G = which ? Gqk : Gkk;
#pragma unroll
        for (int i = 0; i < 16; ++i) G[(32 * ti + crow(i, lane >> 5)) * 64 + 32 * tj + (lane & 31)] = acc[i];
    }
    if (w < 2) {
        const int hv = 2 * hq + w, t = t0 + lane;
        const float braw = ldg<float>(P.EB, (unsigned)(((b * TP + t) * 64 + hv) * 4)), araw = ldg<float>(P.EB, (unsigned)(((b * TP + t) * 64 + 32 + hv) * 4));
        const float beta = sigmoid_f(braw);
        float gc = -__expf(P.a_log[hv]) * softplus_f(araw + P.dt_bias[hv]);
#pragma unroll
        for (int o = 1; o < 64; o <<= 1) { const float v = __shfl_up(gc, o); if (lane >= o) gc += v; }
        betaL[w * 64 + lane] = beta; gcL[w * 64 + lane] = gc; egL[w * 64 + lane] = __expf(gc);
        stg<float>(P.GCG, (unsigned)(((b * 32 + hv) * TP + t) * 4), gc);
    }
    __syncthreads();
#pragma unroll 1
    for (int hvl = 0; hvl < 2; ++hvl) {
        const int hv = 2 * hq + hvl;
        for (int idx = tid; idx < 4096; idx += 512) {
            const int r = idx >> 6, c = idx & 63;
            const float gj = gcL[hvl * 64 + c], gr = gcL[hvl * 64 + r];
            LT[(hvl * 64 + r) * 64 + c] = (c > r) ? betaL[hvl * 64 + c] * Gkk[c * 64 + r] * __expf(gj - gr) : 0.f;
            const float qv = (r >= c) ? Gqk[r * 64 + c] * __expf(gr - gj) : 0.f;
            stg<bf16>(P.QKG, (unsigned)((((((b * 32 + hv) * 64 + n) * 64 + r) * 64) + c) * 2), (bf16)(pk2(qv, 0.f) & 0xffffu));
        }
    }
    __syncthreads();
    asm volatile("" : "+v"(lane), "+v"(tid));
    if (w < 2) {
        float t[64];
#pragma unroll
        for (int c = 0; c < 64; ++c) t[c] = 0.f;
        unsigned lt_a = (unsigned)(size_t)(LT + w * 4096), be_a = (unsigned)(size_t)(betaL + w * 64), eg_a = (unsigned)(size_t)(egL + w * 64);
        asm volatile("" : "+v"(lt_a), "+v"(be_a), "+v"(eg_a));
        LAS const float* lt = (LAS const float*)(size_t)lt_a; LAS const float* bel = (LAS const float*)(size_t)be_a; LAS const float* egl = (LAS const float*)(size_t)eg_a;
#pragma unroll
        for (int c = 63; c >= 0; --c) {
            asm volatile("" ::: "memory");
            float a0 = (lane == c) ? 1.f : 0.f, a1 = 0.f, a2 = 0.f, a3 = 0.f;
#pragma unroll
            for (int jb = (c + 1) >> 2; jb < 16; ++jb) {
                const f32x4 l4 = *(LAS const f32x4*)(lt + c * 64 + 4 * jb);
                a0 -= t[4 * jb] * l4[0]; a1 -= t[4 * jb + 1] * l4[1]; a2 -= t[4 * jb + 2] * l4[2]; a3 -= t[4 * jb + 3] * l4[3];
            }
            float acc = (a0 + a1) + (a2 + a3);
            asm volatile("" : "+v"(acc) :: "memory");
            t[c] = acc;
        }
        LAS uchar* tb0 = Tb + (w * 2 + 0) * (64 * LDT) + lane * LDT; LAS uchar* tb1 = Tb + (w * 2 + 1) * (64 * LDT) + lane * LDT;
#pragma unroll
        for (int q = 0; q < 8; ++q) {
            float a[8], c2[8];
            const f32x4 b0 = *(LAS const f32x4*)(bel + 8 * q), b1 = *(LAS const f32x4*)(bel + 8 * q + 4), e0 = *(LAS const f32x4*)(egl + 8 * q), e1 = *(LAS const f32x4*)(egl + 8 * q + 4);
#pragma unroll
            for (int e = 0; e < 4; ++e) { a[e] = t[8 * q + e] * b0[e]; c2[e] = a[e] * e0[e]; a[4 + e] = t[8 * q + 4 + e] * b1[e]; c2[4 + e] = a[4 + e] * e1[e]; }
            u32x4 o0, o1; o0.x = pk2(a[0], a[1]); o0.y = pk2(a[2], a[3]); o0.z = pk2(a[4], a[5]); o0.w = pk2(a[6], a[7]);
            o1.x = pk2(c2[0], c2[1]); o1.y = pk2(c2[2], c2[3]); o1.z = pk2(c2[4], c2[5]); o1.w = pk2(c2[6], c2[7]);
            *(LAS u32x4*)(tb0 + 16 * q) = o0; *(LAS u32x4*)(tb1 + 16 * q) = o1;
        }
    }
    __syncthreads();
    asm volatile("" : "+v"(lane), "+v"(tid));
    {
        const int hvl = w >> 2, hv = 2 * hq + hvl;
#pragma unroll 1
        for (int tt = 0; tt < 4; ++tt) {
            const int id = (w & 3) * 4 + tt, which = id >> 3, ti = (id >> 2) & 1, c = id & 3;
            f32x16 acc = mm_tile<false, true>(zero16(), Tb + (hvl * 2 + which) * (64 * LDT), LDT, 32 * ti, which ? Kl : (hvl ? V1l : V0l), LD, 32 * c, 4, lane);
            bf16* dstb = which ? P.WG : P.UG;
            const unsigned dof = (unsigned)(((((b * 32 + hv) * TP + t0 + 32 * ti + 4 * (lane >> 5)) * 128) + 32 * c + (lane & 31)) * 2);
#pragma unroll
            for (int i = 0; i < 16; ++i) stg<bf16>(dstb, dof + ((i & 3) + 8 * (i >> 2)) * 256, (bf16)(pk2(acc[i], 0.f) & 0xffffu));
        }
    }
    __syncthreads();
}
DI void bchain_unit(const Frame& F, int cu, const BPtrs& P) {
    const int b = cu >> 5, hv = cu & 31, hq = hv >> 1;
    const int lane = F.lane, w = F.wave, tid_ = F.tid, tid = tid_, h = lane >> 5, l32 = lane & 31;
    constexpr int LD = 272, LDS_ = 320;
    LAS uchar* Wl = F.lds; LAS uchar* Kl = F.lds + 17408;
    LAS uchar* Sb = F.lds + 37888; LAS uchar* VNl = F.lds + 78848; LAS uchar* VNd = F.lds + 99328;
    LAS float* gcL = (LAS float*)(F.lds + 119808);
    const bf16* wg = P.WG + ((size_t)b * 32 + hv) * TP * 128; const bf16* ug = P.UG + ((size_t)b * 32 + hv) * TP * 128;
    const bf16* kg = P.KG + ((size_t)b * 16 + hq) * TP * 128; const float* gcg = P.GCG + ((size_t)b * 32 + hv) * TP;
    bf16* sg = P.SG + ((size_t)b * 32 + hv) * 64 * 16384; bf16* vng = P.VNG + ((size_t)b * 32 + hv) * TP * 128;
    const int kb = w & 3, c0 = 2 * (w >> 2);
    f32x16 S0 = zero16(), S1 = zero16();
    for (int i = tid; i < 128 * LDS_ / 4; i += 512) ((LAS unsigned*)Sb)[i] = 0u;
    const int ti = w >> 2, tc = w & 3;
    u32x4 pw[2], pk[2]; float pg = 0.f;
    {
#pragma unroll
        for (int k = 0; k < 2; ++k) { const unsigned go = (unsigned)((tid + 512 * k) * 16); pw[k] = ldg<u32x4>(wg, go); pk[k] = ldg<u32x4>(kg, go); }
        if (tid < 64) pg = ldg<float>(gcg, (unsigned)(tid * 4));
    }
#pragma unroll 1
    for (int n = 0; n < 64; ++n) {
        const int t0 = n * 64;
        int tid = tid_; asm volatile("" : "+v"(tid));
        const int lane = tid & 63, h = lane >> 5, l32 = lane & 31;
#pragma unroll
        for (int k = 0; k < 2; ++k) {
            const int cid = tid + 512 * k, r = cid >> 4, ch = cid & 15;
            *(LAS u32x4*)(Wl + r * LD + ch * 16) = pw[k]; *(LAS u32x4*)(Kl + r * LDS_ + ch * 16) = pk[k];
        }
        if (tid < 64) gcL[tid] = pg;
        LDS_BARRIER();
        if (n < 63) {
            const unsigned nx = (unsigned)((t0 + 64) * 256);
#pragma unroll
            for (int k = 0; k < 2; ++k) { const unsigned go = nx + (unsigned)((tid + 512 * k) * 16); pw[k] = ldg<u32x4>(wg, go); pk[k] = ldg<u32x4>(kg, go); }
            if (tid < 64) pg = ldg<float>(gcg, (unsigned)((t0 + 64 + tid) * 4));
        }
        const float glast = gcL[63];
        float uu[16];
        {
            const char* upb = (const char*)(ug + (size_t)(t0 + 32 * ti) * 128 + 32 * tc);
            const unsigned uo = (unsigned)((4 * h * 128 + l32) * 2);
#pragma unroll
            for (int i = 0; i < 16; ++i) uu[i] = bf2f(*(const bf16*)(upb + uo + (unsigned)(((i & 3) + 8 * (i >> 2)) * 256)));
        }
#pragma unroll
        for (int k = 0; k < 4; ++k) { const int cid = tid + 512 * k, r = cid >> 4, ch = cid & 15; stg<u32x4>(sg, (unsigned)(n * 32768 + cid * 16), *(LAS const u32x4*)(Sb + r * LDS_ + ch * 16)); }
        f32x16 vn = mm_tile<false, true>(zero16(), Wl, LD, 32 * ti, Sb, LDS_, 32 * tc, 8, lane);
        {
#pragma unroll
            for (int i = 0; i < 16; ++i) {
                const int r = crow(i, h);
                const float v = uu[i] - vn[i];
                const float vd = v * __expf(glast - gcL[32 * ti + r]);
                *(LAS bf16*)(VNl + (32 * ti + r) * LDS_ + (32 * tc + l32) * 2) = (bf16)(pk2(v, 0.f) & 0xffffu);
                *(LAS bf16*)(VNd + (32 * ti + r) * LDS_ + (32 * tc + l32) * 2) = (bf16)(pk2(vd, 0.f) & 0xffffu);
            }
        }
        LDS_BARRIER();
#pragma unroll
        for (int k = 0; k < 2; ++k) { const int cid = tid + 512 * k, r = cid >> 4, ch = cid & 15; stg<u32x4>(vng, (unsigned)(t0 * 256 + cid * 16), *(LAS const u32x4*)(VNl + r * LDS_ + ch * 16)); }
        {
            const float el = __expf(glast);
#pragma unroll
            for (int i = 0; i < 16; ++i) { S0[i] *= el; S1[i] *= el; }
            S0 = mm_tile<true, true>(S0, Kl, LDS_, 32 * kb, VNd, LDS_, 32 * c0, 4, lane);
            S1 = mm_tile<true, true>(S1, Kl, LDS_, 32 * kb, VNd, LDS_, 32 * (c0 + 1), 4, lane);
        }
        LDS_BARRIER();
#pragma unroll
        for (int i = 0; i < 16; ++i) {
            const int r = 32 * kb + crow(i, h);
            *(LAS bf16*)(Sb + r * LDS_ + (32 * c0 + l32) * 2) = (bf16)(pk2(S0[i], 0.f) & 0xffffu);
            *(LAS bf16*)(Sb + r * LDS_ + (32 * (c0 + 1) + l32) * 2) = (bf16)(pk2(S1[i], 0.f) & 0xffffu);
        }
    }
    {
        float* sp = P.ssm_p + ((size_t)b * 32 + hv) * 16384;
#pragma unroll
        for (int i = 0; i < 16; ++i) {
            const int r = 32 * kb + crow(i, h);
            sp[r * 128 + 32 * c0 + l32] = S0[i]; sp[r * 128 + 32 * (c0 + 1) + l32] = S1[i];
        }
    }
    __syncthreads();
}
DI void bout_unit(const Frame& F, int item, const BPtrs& P) {
    const int b = item >> 11, hv = (item >> 6) & 31, n = item & 63, hq = hv >> 1, t0 = n * 64;
    int tid = F.tid; asm volatile("" : "+v"(tid));
    const int lane = tid & 63, w = F.wave, h = lane >> 5, l32 = lane & 31;
    constexpr int LD = 272, LDS_ = 320, LDQ = 144, LDO = 528;
    LAS uchar* Ql = F.lds; LAS uchar* QKl = F.lds + 17408; LAS uchar* Sl = F.lds + 26624; LAS uchar* VNl = F.lds + 67584;
    LAS uchar* Ol = F.lds + 88064;
    LAS float* egL = (LAS float*)(F.lds + 121856);
    {
        const bf16* qg = P.QG + (((size_t)b * 16 + hq) * TP + t0) * 128; const bf16* vng = P.VNG + (((size_t)b * 32 + hv) * TP + t0) * 128;
        const bf16* sg = P.SG + (((size_t)b * 32 + hv) * 64 + n) * 16384; const bf16* qkg = P.QKG + (((size_t)b * 32 + hv) * 64 + n) * 4096;
#pragma unroll
        for (int k = 0; k < 2; ++k) {
            const int cid = tid + 512 * k, r = cid >> 4, ch = cid & 15;
            *(LAS u32x4*)(Ql + r * LD + ch * 16) = ldg<u32x4>(qg, (unsigned)(cid * 16)); *(LAS u32x4*)(VNl + r * LDS_ + ch * 16) = ldg<u32x4>(vng, (unsigned)(cid * 16));
        }
#pragma unroll
        for (int k = 0; k < 4; ++k) { const int cid = tid + 512 * k, r = cid >> 4, ch = cid & 15; *(LAS u32x4*)(Sl + r * LDS_ + ch * 16) = ldg<u32x4>(sg, (unsigned)(cid * 16)); }
        { const int r = tid >> 3, ch = tid & 7; *(LAS u32x4*)(QKl + r * LDQ + ch * 16) = ldg<u32x4>(qkg, (unsigned)(tid * 16)); }
        if (tid < 64) egL[tid] = __expf(ldg<float>(P.GCG, (unsigned)((((b * 32 + hv) * TP) + t0 + tid) * 4)));
    }
    u32x4 z0, z1;
    {
        const int r = tid >> 3, part = tid & 7;
        z0 = ldg<u32x4>(P.PB, (unsigned)((((b * TP + t0 + r) * BINM) + 8192 + hv * 128 + 16 * part) * 2)); z1 = ldg<u32x4>(P.PB, (unsigned)((((b * TP + t0 + r) * BINM) + 8192 + hv * 128 + 16 * part + 8) * 2));
    }
    __syncthreads();
    {
        const int ti = w >> 2, tc = w & 3;
        f32x16 o = mm_tile<false, true>(zero16(), Ql, LD, 32 * ti, Sl, LDS_, 32 * tc, 8, lane);
#pragma unroll
        for (int i = 0; i < 16; ++i) o[i] *= egL[32 * ti + crow(i, h)];
        o = mm_tile<false, true>(o, QKl, LDQ, 32 * ti, VNl, LDS_, 32 * tc, 4, lane);
#pragma unroll
        for (int i = 0; i < 16; ++i) *(LAS float*)(Ol + (32 * ti + crow(i, h)) * LDO + (32 * tc + l32) * 4) = o[i];
    }
    __syncthreads();
    {
        const int r = tid >> 3, part = tid & 7;
        float ov[16]; float ss = 0.f;
#pragma unroll
        for (int q = 0; q < 4; ++q) { const f32x4 v = *(LAS const f32x4*)(Ol + r * LDO + (16 * part + 4 * q) * 4); ov[4 * q] = v[0]; ov[4 * q + 1] = v[1]; ov[4 * q + 2] = v[2]; ov[4 * q + 3] = v[3]; }
#pragma unroll
        for (int e = 0; e < 16; ++e) ss += ov[e] * ov[e];
        ss += __shfl_xor(ss, 1); ss += __shfl_xor(ss, 2); ss += __shfl_xor(ss, 4);
        const float rstd = rsqrtf(ss * (1.f / 128.f) + RMS_EPS);
        float nw[16];
#pragma unroll
        for (int q = 0; q < 4; ++q) { const f32x4 nv = ldg<f32x4>(P.norm_w, (unsigned)((16 * part + 4 * q) * 4)); nw[4 * q] = nv[0]; nw[4 * q + 1] = nv[1]; nw[4 * q + 2] = nv[2]; nw[4 * q + 3] = nv[3]; }
        u32x4 y0, y1;
#pragma unroll
        for (int e = 0; e < 4; ++e) {
            y0[e] = pk2(ov[2 * e] * rstd * nw[2 * e] * silu_f(bflo(z0[e])), ov[2 * e + 1] * rstd * nw[2 * e + 1] * silu_f(bfhi(z0[e])));
            y1[e] = pk2(ov[8 + 2 * e] * rstd * nw[8 + 2 * e] * silu_f(bflo(z1[e])), ov[8 + 2 * e + 1] * rstd * nw[8 + 2 * e + 1] * silu_f(bfhi(z1[e])));
        }
        const unsigned yo = (unsigned)((((b * TP + t0 + r) * 4096) + hv * 128 + 16 * part) * 2);
        stg<u32x4>(P.YB, yo, y0); stg<u32x4>(P.YB, yo + 16, y1);
    }
    __syncthreads();
}
DI void bsample_unit(const Frame& F, int su, const BPtrs& P) {
    const int b = su >> 5, hv = su & 31, hq = hv >> 1;
    const int tid = F.tid, lane = F.lane, w = F.wave, dv = tid & 127, qd = tid >> 7;
    LAS float* raw = (LAS float*)F.lds;
    LAS float* qv = raw + 1536; LAS float* kv = qv + 512; LAS float* vv = kv + 512;
    LAS float* part = vv + 512;
    LAS float* ov = part + 512;
    LAS float* scal = ov + 512;
    float s[32];
    {
        const float* s0 = P.ssm0 + ((size_t)b * 32 + hv) * 16384 + (32 * qd) * 128 + dv;
#pragma unroll
        for (int i = 0; i < 32; ++i) s[i] = s0[i * 128];
    }
    if (tid < 384) {
        const int which = tid >> 7, d = tid & 127;
        const int col = which == 0 ? hq * 128 + d : which == 1 ? 2048 + hq * 128 + d : 4096 + hv * 128 + d;
        float full[7];
#pragma unroll
        for (int r = 0; r < 3; ++r) full[r] = P.conv0[((size_t)b * 3 + r) * 8192 + col];
#pragma unroll
        for (int t = 0; t < 4; ++t) full[3 + t] = P.PBS[(size_t)(b * 4 + t) * BIN + col];
        const float w0 = P.conv_w[col], w1 = P.conv_w[8192 + col], w2 = P.conv_w[2 * 8192 + col], w3 = P.conv_w[3 * 8192 + col];
#pragma unroll
        for (int t = 0; t < 4; ++t) raw[(which * 4 + t) * 128 + d] = silu_f(full[t] * w0 + full[t + 1] * w1 + full[t + 2] * w2 + full[t + 3] * w3);
#pragma unroll
        for (int r = 0; r < 3; ++r) P.conv_s[((size_t)b * 3 + r) * 8192 + col] = full[4 + r];
    }
    if (tid < 4) {
        const float braw = P.PBS[(size_t)(b * 4 + tid) * BIN + 12288 + hv], araw = P.PBS[(size_t)(b * 4 + tid) * BIN + 12320 + hv];
        scal[tid] = sigmoid_f(braw); scal[4 + tid] = __expf(-__expf(P.a_log[hv]) * softplus_f(araw + P.dt_bias[hv]));
    }
    __syncthreads();
    {
        const int which = w >> 2, t = w & 3;
        const float a0 = raw[(which * 4 + t) * 128 + lane], a1 = raw[(which * 4 + t) * 128 + 64 + lane];
        const float rn = rsqrtf(wave_sum(a0 * a0 + a1 * a1) + 1e-6f) * (which == 0 ? 0.08838834764831845f : 1.f);
        LAS float* dst = which == 0 ? qv : kv;
        dst[t * 128 + lane] = a0 * rn; dst[t * 128 + 64 + lane] = a1 * rn;
        vv[tid] = raw[1024 + tid];
    }
    __syncthreads();
    for (int t = 0; t < 4; ++t) {
        const float beta = scal[t], eg = scal[4 + t];
        float p = 0.f;
#pragma unroll
        for (int i = 0; i < 32; ++i) p += kv[t * 128 + 32 * qd + i] * s[i];
        part[qd * 128 + dv] = p;
        __syncthreads();
        const float kS = (part[dv] + part[128 + dv]) + (part[256 + dv] + part[384 + dv]);
        const float vt = vv[t * 128 + dv];
        float po = 0.f;
#pragma unroll
        for (int i = 0; i < 32; ++i) {
            const float kk = kv[t * 128 + 32 * qd + i];
            s[i] = eg * (s[i] - beta * kk * kS) + beta * kk * vt;
            po += s[i] * qv[t * 128 + 32 * qd + i];
        }
        __syncthreads();
        part[qd * 128 + dv] = po;
        __syncthreads();
        if (qd == 0) ov[t * 128 + dv] = (part[dv] + part[128 + dv]) + (part[256 + dv] + part[384 + dv]);
        __syncthreads();
    }
    if (w < 4) {
        const int t = w;
        const float o0 = ov[t * 128 + lane], o1 = ov[t * 128 + 64 + lane];
        const float rstd = rsqrtf(wave_sum(o0 * o0 + o1 * o1) * (1.f / 128.f) + RMS_EPS);
        const float* zp = P.PBS + (size_t)(b * 4 + t) * BIN + 8192 + hv * 128;
        bf16* yp = P.YB + (size_t)(MP + b * 4 + t) * 4096 + hv * 128;
        yp[lane] = (bf16)(pk2(o0 * rstd * P.norm_w[lane] * silu_f(zp[lane]), 0.f) & 0xffffu);
        yp[64 + lane] = (bf16)(pk2(o1 * rstd * P.norm_w[64 + lane] * silu_f(zp[64 + lane]), 0.f) & 0xffffu);
    }
    {
        float* so = P.ssm_s + ((size_t)b * 32 + hv) * 16384 + (32 * qd) * 128 + dv;
#pragma unroll
        for (int i = 0; i < 32; ++i) so[i * 128] = s[i];
    }
    __syncthreads();
}
struct CPtrs {
    const bf16* PC; const float* EC; const float* PCS; float* DT; float* ACS; bf16* XBC; bf16* YC;
    const float *conv_w, *conv_b, *dt_bias, *a_log, *dskip, *norm_w, *ssm0, *conv0;
    float *ssm_p, *ssm_s, *conv_p, *conv_s;
};
DI void cpre_phase(const Frame& F, const CPtrs& P) {
    const int lane = F.lane;
    for (int it = F.gw; it < 1536 + 128; it += F.NGW) {
        if (it < 1536) {
            const int b = it / 768, cg = (it / 64) % 12, rb = it & 63, cc = cg * 512 + 8 * lane, t0 = rb * 64;
            float wt[4][8], bs[8];
#pragma unroll
            for (int jj = 0; jj < 4; ++jj) { const f32x4 w0 = ldg<f32x4>(P.conv_w, (unsigned)((jj * 6144 + cc) * 4)), w1 = ldg<f32x4>(P.conv_w, (unsigned)((jj * 6144 + cc + 4) * 4));
                wt[jj][0] = w0[0]; wt[jj][1] = w0[1]; wt[jj][2] = w0[2]; wt[jj][3] = w0[3]; wt[jj][4] = w1[0]; wt[jj][5] = w1[1]; wt[jj][6] = w1[2]; wt[jj][7] = w1[3]; }
            { const f32x4 b0 = ldg<f32x4>(P.conv_b, (unsigned)(cc * 4)), b1 = ldg<f32x4>(P.conv_b, (unsigned)((cc + 4) * 4)); bs[0] = b0[0]; bs[1] = b0[1]; bs[2] = b0[2]; bs[3] = b0[3]; bs[4] = b1[0]; bs[5] = b1[1]; bs[6] = b1[2]; bs[7] = b1[3]; }
            const unsigned src0 = (unsigned)(((b * TP + t0) * CINM + 4096 + cc) * 2), dst0 = (unsigned)(((b * TP + t0) * 6144 + cc) * 2);
            u32x4 r[19];
#pragma unroll
            for (int q = 0; q < 3; ++q) { r[q] = (u32x4){0u, 0u, 0u, 0u}; if (t0 > 0) r[q] = ldg<u32x4>(P.PC, src0 - (unsigned)((3 - q) * CINM * 2)); }
#pragma unroll 1
            for (int blk = 0; blk < 4; ++blk) {
#pragma unroll
                for (int q = 0; q < 16; ++q) r[3 + q] = ldg<u32x4>(P.PC, src0 + (unsigned)((blk * 16 + q) * CINM * 2));
#pragma unroll
                for (int q = 0; q < 16; ++q) {
                    float y[8];
#pragma unroll
                    for (int e = 0; e < 8; ++e) y[e] = bs[e];
#pragma unroll
                    for (int jj = 0; jj < 4; ++jj) {
                        const u32x4 x = r[q + jj];
                        y[0] += bflo(x[0]) * wt[jj][0]; y[1] += bfhi(x[0]) * wt[jj][1]; y[2] += bflo(x[1]) * wt[jj][2]; y[3] += bfhi(x[1]) * wt[jj][3];
                        y[4] += bflo(x[2]) * wt[jj][4]; y[5] += bfhi(x[2]) * wt[jj][5]; y[6] += bflo(x[3]) * wt[jj][6]; y[7] += bfhi(x[3]) * wt[jj][7];
                    }
#pragma unroll
                    for (int e = 0; e < 8; ++e) y[e] = silu_f(y[e]);
                    u32x4 o; o.x = pk2(y[0], y[1]); o.y = pk2(y[2], y[3]); o.z = pk2(y[4], y[5]); o.w = pk2(y[6], y[7]);
                    stg<u32x4>(P.XBC, dst0 + (unsigned)((blk * 16 + q) * 6144 * 2), o);
                }
                r[0] = r[16]; r[1] = r[17]; r[2] = r[18];
            }
        } else {
            const int id = it - 1536, b = id >> 6, n = id & 63;
            const float a = -__expf(P.a_log[lane]), db = P.dt_bias[lane];
            float acc = 0.f;
            const unsigned o0 = (unsigned)(((b * TP + n * 64) * 64 + lane) * 4);
#pragma unroll 8
            for (int t = 0; t < 64; ++t) {
                const float dt = softplus_f(ldg<float>(P.EC, o0 + t * 256) + db);
                acc += dt * a;
                stg<float>(P.DT, o0 + t * 256, dt); stg<float>(P.ACS, o0 + t * 256, acc);
            }
        }
    }
}
DI void cchain_unit(const Frame& F, int cu, const CPtrs& P) {
    const int b = cu >> 6, hd = cu & 63, g = hd >> 3;
    const int lane = F.lane, w = F.wave, tid = F.tid, h = lane >> 5, l32 = lane & 31;
    constexpr int LDX = 144, LDB = 272, LDY = 272;
    LAS uchar* Xl = F.lds; LAS uchar* XDl = F.lds + 9216; LAS uchar* XWl = F.lds + 18432;
    LAS uchar* Bl = F.lds + 27648; LAS uchar* Cl = F.lds + 45056;
    LAS uchar* Gl = F.lds + 62464;
    LAS uchar* Hl = F.lds + 71680;
    LAS uchar* Yl = F.lds + 89088;
    LAS float* dtL = (LAS float*)(F.lds + 106496);
    LAS float* acsL = dtL + 128;
    const int nb = w & 3, pb = w >> 2;
    f32x16 hst = zero16();
    for (int i = tid; i < 64 * LDB / 4; i += 512) ((LAS unsigned*)Hl)[i] = 0u;
    unsigned soff[5]; int srow[5], sch[5];
#pragma unroll
    for (int it = 0; it < 5; ++it) {
        const int id = tid + 512 * it, i = id / 40, ch = id - i * 40;
        const int c8 = ch < 8 ? hd * 64 + 8 * ch : ch < 24 ? 4096 + g * 128 + 8 * (ch - 8) : 5120 + g * 128 + 8 * (ch - 24);
        srow[it] = i; sch[it] = ch; soff[it] = (unsigned)(((b * TP + i) * 6144 + c8) * 2);
    }
    u32x4 pre[5];
#pragma unroll
    for (int it = 0; it < 5; ++it) pre[it] = ldg<u32x4>(P.XBC, soff[it]);
    const unsigned sc0 = (unsigned)(((b * TP) * 64 + hd) * 4);
    if (w == 7) { dtL[lane] = ldg<float>(P.DT, sc0 + lane * 256); acsL[lane] = ldg<float>(P.ACS, sc0 + lane * 256); }
    const float dsk = P.dskip[hd];
    __syncthreads();
#pragma unroll 1
    for (int n = 0; n < 64; ++n) {
        const int t0 = n * 64, cur = n & 1;
        LAS const float* dtc = dtL + cur * 64; LAS const float* acs = acsL + cur * 64;
        const float alast = acs[63];
#pragma unroll
        for (int it = 0; it < 5; ++it) {
            const int i = srow[it], ch = sch[it]; const u32x4 o = pre[it];
            if (ch < 8) {
                const float d1 = dtc[i], d2 = d1 * __expf(alast - acs[i]);
                u32x4 o1, o2;
#pragma unroll
                for (int e = 0; e < 4; ++e) { const float lo = bflo(o[e]), hi = bfhi(o[e]); o1[e] = pk2(lo * d1, hi * d1); o2[e] = pk2(lo * d2, hi * d2); }
                *(LAS u32x4*)(Xl + i * LDX + ch * 16) = o; *(LAS u32x4*)(XDl + i * LDX + ch * 16) = o1; *(LAS u32x4*)(XWl + i * LDX + ch * 16) = o2;
            } else if (ch < 24) *(LAS u32x4*)(Bl + i * LDB + (ch - 8) * 16) = o;
            else *(LAS u32x4*)(Cl + i * LDB + (ch - 24) * 16) = o;
        }
        LDS_BARRIER();
        if (n < 63) {
#pragma unroll
            for (int it = 0; it < 5; ++it) pre[it] = ldg<u32x4>(P.XBC, soff[it] + (unsigned)((t0 + 64) * 6144 * 2));
        }
        f32x16 yacc = zero16();
        const int ti = (w >> 1) & 1, tq = w & 1;
        if (w >= 4) {
            if (!(ti == 0 && tq == 1)) {
                f32x16 cbt = mm_tile<false, false>(zero16(), Cl, LDB, 32 * ti, Bl, LDB, 32 * tq, 8, lane);
                const int j = 32 * tq + l32; const float aj = acs[j];
#pragma unroll
                for (int r = 0; r < 16; ++r) {
                    const int i = 32 * ti + crow(r, h);
                    const float v = (i >= j) ? cbt[r] * __expf(acs[i] - aj) : 0.f;
                    *(LAS bf16*)(Gl + i * LDX + j * 2) = (bf16)(pk2(v, 0.f) & 0xffffu);
                }
            } else {
#pragma unroll
                for (int r = 0; r < 16; ++r) *(LAS bf16*)(Gl + crow(r, h) * LDX + (32 + l32) * 2) = (bf16)0;
            }
        } else {
            yacc = mm_tile<false, false>(yacc, Cl, LDB, 32 * ti, Hl, LDB, 32 * tq, 8, lane);
#pragma unroll
            for (int r = 0; r < 16; ++r) yacc[r] *= __expf(acs[32 * ti + crow(r, h)]);
        }
        LDS_BARRIER();
        if (w < 4) {
            yacc = mm_tile<false, true>(yacc, Gl, LDX, 32 * ti, XDl, LDX, 32 * tq, 4, lane);
#pragma unroll
            for (int r = 0; r < 16; ++r) *(LAS float*)(Yl + (32 * ti + crow(r, h)) * LDY + (32 * tq + l32) * 4) = yacc[r];
        }
        {
            const float el = __expf(alast);
#pragma unroll
            for (int r = 0; r < 16; ++r) hst[r] *= el;
            hst = mm_tile<true, true>(hst, Bl, LDB, 32 * nb, XWl, LDX, 32 * pb, 4, lane);
        }
        LDS_BARRIER();
#pragma unroll
        for (int q = 0; q < 4; ++q) {
            f32x4 v = {hst[4 * q], hst[4 * q + 1], hst[4 * q + 2], hst[4 * q + 3]};
            *(LAS u32x2*)(Hl + (32 * pb + l32) * LDB + (32 * nb + 8 * q + 4 * h) * 2) = pk4(v);
        }
        if (w == 7 && n < 63) { dtL[(cur ^ 1) * 64 + lane] = ldg<float>(P.DT, sc0 + (unsigned)((t0 + 64 + lane) * 256)); acsL[(cur ^ 1) * 64 + lane] = ldg<float>(P.ACS, sc0 + (unsigned)((t0 + 64 + lane) * 256)); }
        {
            const int i = tid >> 3, part = tid & 7;
            const f32x4 ya = *(LAS const f32x4*)(Yl + i * LDY + (8 * part) * 4), yb = *(LAS const f32x4*)(Yl + i * LDY + (8 * part + 4) * 4);
            const u32x4 xv = *(LAS const u32x4*)(Xl + i * LDX + part * 16);
            u32x4 o;
            o.x = pk2(ya[0] + dsk * bflo(xv[0]), ya[1] + dsk * bfhi(xv[0])); o.y = pk2(ya[2] + dsk * bflo(xv[1]), ya[3] + dsk * bfhi(xv[1]));
            o.z = pk2(yb[0] + dsk * bflo(xv[2]), yb[1] + dsk * bfhi(xv[2])); o.w = pk2(yb[2] + dsk * bflo(xv[3]), yb[3] + dsk * bfhi(xv[3]));
            stg<u32x4>(P.YC, (unsigned)((((b * TP + t0 + i) * 4096) + hd * 64 + 8 * part) * 2), o);
        }
        LDS_BARRIER();
    }
    {
        float* sp = P.ssm_p + (((size_t)b * 64 + hd) * 64 + 32 * pb + l32) * 128 + 32 * nb + 4 * h;
#pragma unroll
        for (int q = 0; q < 4; ++q) { f32x4 v = {hst[4 * q], hst[4 * q + 1], hst[4 * q + 2], hst[4 * q + 3]}; *(f32x4*)(sp + 8 * q) = v; }
    }
    __syncthreads();
}

DI void csample_unit(const Frame& F, int su, const CPtrs& P) {
    const int b = su >> 3, g = su & 7;
    const int tid = F.tid, lane = F.lane, w = F.wave, hd = g * 8 + w;
    LAS float* xs = (LAS float*)F.lds;
    LAS float* Bs = xs + 2048; LAS float* Cs = Bs + 512;
    LAS float* ys = Cs + 512;
    for (int c = tid; c < 768; c += 512) {
        const int cc = c < 512 ? g * 512 + c : c < 640 ? 4096 + g * 128 + (c - 512) : 5120 + g * 128 + (c - 640);
        float full[7];
#pragma unroll
        for (int r = 0; r < 3; ++r) full[r] = P.conv0[((size_t)b * 3 + r) * 6144 + cc];
#pragma unroll
        for (int t = 0; t < 4; ++t) full[3 + t] = P.PCS[(size_t)(b * 4 + t) * CIN + 4096 + cc];
        const float w0 = P.conv_w[cc], w1 = P.conv_w[6144 + cc], w2 = P.conv_w[2 * 6144 + cc], w3 = P.conv_w[3 * 6144 + cc], cb = P.conv_b[cc];
#pragma unroll
        for (int t = 0; t < 4; ++t) {
            const float v = silu_f(full[t] * w0 + full[t + 1] * w1 + full[t + 2] * w2 + full[t + 3] * w3 + cb);
            if (c < 512) xs[t * 512 + c]= v; else if (c < 640) Bs[t * 128 + (c - 512)] = v; else Cs[t * 128 + (c - 640)] = v;
        }
#pragma unroll
        for (int r = 0; r < 3; ++r) P.conv_s[((size_t)b * 3 + r) * 6144 + cc] = full[4 + r];
    }
    __syncthreads();
    float dt[4], dA[4];
    {
        const float a = -__expf(P.a_log[hd]), db = P.dt_bias[hd];
#pragma unroll
        for (int t = 0; t < 4; ++t) { dt[t] = softplus_f(P.PCS[(size_t)(b * 4 + t) * CIN + 10240 + hd] + db); dA[t] = __expf(dt[t] * a); }
    }
    const float dsk = P.dskip[hd];
#pragma unroll 1
    for (int ph = 0; ph < 2; ++ph) {
        float hs[32][2];
        const float* h0 = P.ssm0 + (((size_t)b * 64 + hd) * 64 + 32 * ph) * 128 + lane;
#pragma unroll
        for (int pi = 0; pi < 32; ++pi) { hs[pi][0] = h0[pi * 128]; hs[pi][1] = h0[pi * 128 + 64]; }
#pragma unroll 1
        for (int t = 0; t < 4; ++t) {
            const float b0 = Bs[t * 128 + lane], b1 = Bs[t * 128 + 64 + lane], c0 = Cs[t * 128 + lane], c1 = Cs[t * 128 + 64 + lane];
#pragma unroll
            for (int pi = 0; pi < 32; ++pi) {
                const float x = xs[t * 512 + w * 64 + 32 * ph + pi], dx = dt[t] * x;
                hs[pi][0] = hs[pi][0] * dA[t] + dx * b0; hs[pi][1] = hs[pi][1] * dA[t] + dx * b1;
                const float yv = wave_sum(hs[pi][0] * c0 + hs[pi][1] * c1);
                if (lane == 0) ys[t * 512 + w * 64 + 32 * ph + pi] = yv + dsk * x;
            }
        }
        float* ho = P.ssm_s + (((size_t)b * 64 + hd) * 64 + 32 * ph) * 128 + lane;
#pragma unroll
        for (int pi = 0; pi < 32; ++pi) { ho[pi * 128] = hs[pi][0]; ho[pi * 128 + 64] = hs[pi][1]; }
    }
    __syncthreads();
    if (w < 4) {
        const int t = w;
        const float* zp = P.PCS + (size_t)(b * 4 + t) * CIN + g * 512 + 8 * lane;
        float y[8]; float ss = 0.f;
#pragma unroll
        for (int e = 0; e < 8; ++e) { y[e] = ys[t * 512 + 8 * lane + e] * silu_f(zp[e]); ss += y[e] * y[e]; }
        const float rstd = rsqrtf(wave_sum(ss) * (1.f / 512.f) + RMS_EPS);
        const float* nw = P.norm_w + g * 512 + 8 * lane;
        u32x4 o; o.x = pk2(y[0] * rstd * nw[0], y[1] * rstd * nw[1]); o.y = pk2(y[2] * rstd * nw[2], y[3] * rstd * nw[3]);
        o.z = pk2(y[4] * rstd * nw[4], y[5] * rstd * nw[5]); o.w = pk2(y[6] * rstd * nw[6], y[7] * rstd * nw[7]);
        *(u32x4*)(P.YC + (size_t)(MP + b * 4 + t) * 4096 + g * 512 + 8 * lane) = o;
    }
    __syncthreads();
}
DI void cnorm_phase(const Frame& F, const CPtrs& P) {
    for (int row = F.gw; row < MP; row += F.NGW) {
#pragma unroll
        for (int k = 0; k < 8; ++k) {
            const int ch = 8 * (F.lane + 64 * k);
            const u32x4 v = ldg<u32x4>(P.YC, (unsigned)((row * 4096 + ch) * 2)), z = ldg<u32x4>(P.PC, (unsigned)((row * CINM + ch) * 2));
            const f32x4 n0 = ldg<f32x4>(P.norm_w, (unsigned)(ch * 4)), n1 = ldg<f32x4>(P.norm_w, (unsigned)((ch + 4) * 4));
            float y[8]; float ss = 0.f;
#pragma unroll
            for (int e = 0; e < 4; ++e) { y[2 * e] = bflo(v[e]) * silu_f(bflo(z[e])); y[2 * e + 1] = bfhi(v[e]) * silu_f(bfhi(z[e])); ss += y[2 * e] * y[2 * e] + y[2 * e + 1] * y[2 * e + 1]; }
            const float rstd = rsqrtf(wave_sum(ss) * (1.f / 512.f) + RMS_EPS);
            u32x4 o; o.x = pk2(y[0] * rstd * n0[0], y[1] * rstd * n0[1]); o.y = pk2(y[2] * rstd * n0[2], y[3] * rstd * n0[3]);
            o.z = pk2(y[4] * rstd * n1[0], y[5] * rstd * n1[1]); o.w = pk2(y[6] * rstd * n1[2], y[7] * rstd * n1[3]);
            stg<u32x4>(P.YC, (unsigned)((row * 4096 + ch) * 2), o);
        }
    }
}
template <class Fn>
DI void run_gemm(const Frame& F, const bf16* A, const bf16* Bt, int N, int K, const Fn& f) {
    pg8::Gemm g{A, Bt, MP, N, K}; pg8::StaticOrder S; S.init(MP, N, F.G, F.bid);
    EpiWrap<Fn> E{f};
    pg8::gemm_phase<EpiWrap<Fn>, pg8::StaticOrder, true, true>(F.lds, g, S, E, F.tid);
}
#define SKINNY_LOOP(u, count) for (int u = (F.G - 1 - F.bid); u < (count); u += F.G)
#define SIDE_LOOP(u, count, nres) for (int _ns = (F.G > (nres) ? F.G - (nres) : F.G), u = ((F.G - 1 - F.bid) < _ns ? (F.G - 1 - F.bid) : (count)); u < (count); u += _ns)

enum { PH_PRO = 0, PH_GU, PH_DN, PH_LN, PH_AQKV, PH_ATT, PH_AO, PH_BIN, PH_BPREP, PH_BCHAIN, PH_BOUT, PH_CIN, PH_CCHAIN, PH_CNORM, PH_COUT, PH_CPRE, PH_BO, PH_N };

DI void fill_b(BPtrs& P, const Args& args) {
    uchar* ws = args.ws;
    P.PB = (const bf16*)(ws + MB_PB); P.EB = (const float*)(ws + MB_EB); P.PBS = (const float*)(ws + MB_PBS);
    P.WG = (bf16*)(ws + MB_WG); P.UG = (bf16*)(ws + MB_UG); P.QG = (bf16*)(ws + MB_QG); P.KG = (bf16*)(ws + MB_KG); P.QKG = (bf16*)(ws + MB_QKG);
    P.GCG = (float*)(ws + MB_GCG); P.YB = (bf16*)(ws + MB_YB); P.SG = (bf16*)(ws + MB_SG); P.VNG = (bf16*)(ws + MB_VNG);
    P.conv_w = args.in[18]; P.a_log = args.in[19]; P.dt_bias = args.in[20]; P.norm_w = args.in[21]; P.ssm0 = args.in[5]; P.conv0 = args.in[6];
    P.ssm_p = args.out + O_BSSMP; P.ssm_s = args.out + O_BSSMS; P.conv_p = args.out + O_BCONVP; P.conv_s = args.out + O_BCONVS;
}
DI void fill_c(CPtrs& P, const Args& args) {
    uchar* ws = args.ws;
    P.PC = (const bf16*)(ws + MC_PC); P.EC = (const float*)(ws + MC_EC); P.PCS = (const float*)(ws + MC_PCS); P.DT = (float*)(ws + MC_SS); P.ACS = (float*)(ws + MC_ACS); P.XBC = (bf16*)(ws + MC_XBC); P.YC = (bf16*)(ws + MC_YC);
    P.conv_w = args.in[24]; P.conv_b = args.in[25]; P.dt_bias = args.in[26]; P.a_log = args.in[27]; P.dskip = args.in[28]; P.norm_w = args.in[29];
    P.ssm0 = args.in[7]; P.conv0 = args.in[8];
    P.ssm_p = args.out + O_CSSMP; P.ssm_s = args.out + O_CSSMS; P.conv_p = args.out + O_CCONVP; P.conv_s = args.out + O_CCONVS;
}
template <int PH>
DI void phase_body(const Frame& F, const Args& args, int hl, int zsi, int j, bool isdup = false) {
    uchar* ws = args.ws;
    float* X = args.out; bf16* XB = (bf16*)(ws + WS_XB); float* ZP = (float*)(ws + WS_ZP); bf16* HB = (bf16*)(ws + WS_H);
    float* ZS = (float*)(ws + WS_ZS + (size_t)zsi * ZS_ONE);
    if constexpr (PH == PH_PRO) prologue(F, args);
    if constexpr (PH == PH_GU) {
        const bf16* Wgu = (const bf16*)(ws + WS_W + (size_t)hl * FFN_BYTES);
        FSwiglu f{HB}; run_gemm(F, XB, Wgu, NGU, DM, f);
        SIDE_LOOP(u, NGU / 64, 128) skinny_unit<2>(F, XB, DM, MP, Wgu, DM, 64 * u, 0, DM, f);
        if (hl == 1) bg_slot(F, args, 2, 128);
        if (hl == 2) bg_slot(F, args, 3, 128);
        { const int ci = hl == 0 ? 1 : hl >= 3 ? hl - 1 : -1;
          if (ci >= 0 && F.bid >= 128 && F.G > 128) cache_copy(args, args.cc[ci], args.cc[ci + 1], (F.bid - 128) * 512 + F.tid, (F.G - 128) * 512); }
    }
    if constexpr (PH == PH_DN) {
        const bf16* Wdn = (const bf16*)(ws + WS_W + (size_t)hl * FFN_BYTES + GU_BYTES);
        FResid f{XB, ZP, 0, 0.5f, 0, 1}; run_gemm(F, HB, Wdn, DM, DFF, f);
        if (!isdup) SKINNY_LOOP(u, 256) { const int ft = u >> 2, ks = u & 3; FResid fs{XB, ZS, MP, 0.5f, 1, ks == 0}; skinny_unit<1>(F, HB, DFF, MP, Wdn, DFF, 32 * ft, ks * (DFF / 4), DFF / 4, fs); }
    }
    if constexpr (PH == PH_LN) ln_phase(F, ZP, ZS, args.in[9] + (size_t)zsi * DM, args.in[10] + (size_t)zsi * DM, zsi == 11 ? X : (float*)nullptr, XB);
    if constexpr (PH == PH_AQKV || PH == PH_ATT || PH == PH_AO) {
        const bf16* Wq = (const bf16*)(ws + WS_WA + (size_t)j * A_BYTES); const bf16* Wo = (const bf16*)(ws + WS_WA + (size_t)j * A_BYTES + AQ_BYTES);
        bf16* QKV = (bf16*)(ws + MA_QKV); float* QKVS = (float*)(ws + MA_QKVS); bf16* OG = (bf16*)(ws + MA_OG); float* LSE = (float*)(ws + MA_LSE); bf16* OA = (bf16*)(ws + MA_O);
        if constexpr (PH == PH_AQKV) {
            FQkv f; f.QKV = QKV; f.QKVS = QKVS; f.rope = (const float*)(ws + WS_ROPE); f.j = j;
            f.out = args.out;
            run_gemm(F, XB, Wq, AQKV, DM, f);
            SIDE_LOOP(u, AQKV / 64, 128) skinny_unit<2>(F, XB, DM, MP, Wq, DM, 64 * u, 0, DM, f);
            if (F.bid >= 128 && F.G > 128) cache_copy(args, args.cc[7 + j], args.cc[8 + j], (F.bid - 128) * 512 + F.tid, (F.G - 128) * 512);
        }
        if constexpr (PH == PH_ATT) {
            for (int u = F.bid; u < 256; u += F.G) attn_prompt_unit(F, u, QKV, OG, LSE, OA);
            for (int u = F.bid; u < 256; u += F.G) attn_sample_unit(F, u, QKVS, args.in[2], args.in[3], args.in[4], j, OA);
            if (j == 0) bg_slot(F, args, 1, 0);
            if (j == 1) cache_copy(args, args.cc[0], args.cc[1], F.bid * 512 + F.tid, F.G * 512);
        }
        if constexpr (PH == PH_AO) {
            FResid f{XB, ZP, 0, 1.f, 0, 1}; run_gemm(F, OA, Wo, DM, 1024, f);
            if (!isdup) SKINNY_LOOP(u, 256) { const int ft = u >> 2, ks = u & 3; FResid fs{XB, ZS, MP, 1.f, 1, ks == 0}; skinny_unit<1>(F, OA, 1024, MP, Wo, 1024, 32 * ft, ks * 256, 256, fs); }
        }
    }
    if constexpr (PH == PH_BIN || PH == PH_BPREP || PH == PH_BCHAIN || PH == PH_BOUT || PH == PH_BO) {
        const bf16* Wi = (const bf16*)(ws + WS_WB); const bf16* Wo = (const bf16*)(ws + WS_WB + BI_BYTES);
        BPtrs P; fill_b(P, args);
        if constexpr (PH == PH_BIN) {
            FBf16 f{(bf16*)(ws + MB_PB), BINM}; run_gemm(F, XB, Wi, BINM, DM, f);
            FF32 fe{(float*)(ws + MB_EB), 64, 0, BINM};
            SKINNY_LOOP(u, 256) skinny_unit<2>(F, XB, DM, 32 * u, Wi, DM, BINM, 0, DM, fe);
            FF32 fs{(float*)(ws + MB_PBS), BIN, MP, 0};
            SKINNY_LOOP(u, BIN / 64) skinny_unit<2>(F, XB, DM, MP, Wi, DM, 64 * u, 0, DM, fs);
        }
        if constexpr (PH == PH_BPREP) {
            for (int u = F.bid; u < 2048; u += F.G) bprep_unit(F, u, P);
            for (int i = F.gw * 64 + F.lane; i < 2 * 3 * 8192; i += F.NGW * 64) { const int b = i / 24576, r = (i / 8192) % 3, c = i & 8191; P.conv_p[i] = bf2f(P.PB[((size_t)b * TP + TP - 3 + r) * BINM + c]); }
        }
        if constexpr (PH == PH_BCHAIN) {
            for (int u = F.bid; u < 64; u += F.G) bchain_unit(F, u, P);
            SIDE_LOOP(u, 256, 64) bsample_unit(F, u, P);
            bg_slot(F, args, 4, 64);
        }
        if constexpr (PH == PH_BO) { for (int u = F.bid; u < 4096; u += F.G) bout_unit(F, u, P); }
        if constexpr (PH == PH_BOUT) {
            FResid f{XB, ZP, 0, 1.f, 0, 1}; run_gemm(F, P.YB, Wo, DM, 4096, f);
            if (!isdup) SKINNY_LOOP(u, 256) { const int ft = u >> 2, ks = u & 3; FResid fs{XB, ZS, MP, 1.f, 1, ks == 0}; skinny_unit<1>(F, P.YB, 4096, MP, Wo, 4096, 32 * ft, ks * 1024, 1024, fs); }
        }
    }
    if constexpr (PH == PH_CIN || PH == PH_CCHAIN || PH == PH_CNORM || PH == PH_COUT || PH == PH_CPRE) {
        const bf16* Wi = (const bf16*)(ws + WS_WC); const bf16* Wo = (const bf16*)(ws + WS_WC + CI_BYTES);
        CPtrs P; fill_c(P, args);
        if constexpr (PH == PH_CIN) {
            FBf16 f{(bf16*)(ws + MC_PC), CINM}; run_gemm(F, XB, Wi, CINM, DM, f);
            FF32 fe{(float*)(ws + MC_EC), 64, 0, CINM};
            SKINNY_LOOP(u, 256) skinny_unit<2>(F, XB, DM, 32 * u, Wi, DM, CINM, 0, DM, fe);
            FF32 fs{(float*)(ws + MC_PCS), CIN, MP, 0};
            SKINNY_LOOP(u, CIN / 64) skinny_unit<2>(F, XB, DM, MP, Wi, DM, 64 * u, 0, DM, fs);
        }
        if constexpr (PH == PH_CCHAIN) {
            for (int u = F.bid; u < 128; u += F.G) cchain_unit(F, u, P);
            SIDE_LOOP(u, 64, 128) csample_unit(F, u, P);
            bg_slot(F, args, 5, 128);
            for (int i = F.gw * 64 + F.lane; i < 2 * 3 * 6144; i += F.NGW * 64) { const int b = i / 18432, r = (i / 6144) % 3, c = i % 6144; P.conv_p[i] = bf2f(P.PC[((size_t)b * TP + TP - 3 + r) * CINM + 4096 + c]); }
        }
        if constexpr (PH == PH_CPRE) cpre_phase(F, P);
        if constexpr (PH == PH_CNORM) cnorm_phase(F, P);
        if constexpr (PH == PH_COUT) {
            FResid f{XB, ZP, 0, 1.f, 0, 1}; run_gemm(F, P.YC, Wo, DM, 4096, f);
            if (!isdup) SKINNY_LOOP(u, 256) { const int ft = u >> 2, ks = u & 3; FResid fs{XB, ZS, MP, 1.f, 1, ks == 0}; skinny_unit<1>(F, P.YC, 4096, MP, Wo, 4096, 32 * ft, ks * 1024, 1024, fs); }
        }
    }
}
DI void make_frame(Frame& F, unsigned char* lds_raw) {
    F.lds = (LAS uchar*)lds_raw;
    F.tid = threadIdx.x; F.lane = F.tid & 63; F.wave = __builtin_amdgcn_readfirstlane(F.tid >> 6);
    F.G = gridDim.x; F.bid = blockIdx.x; F.gw = F.bid * NWAVES + F.wave; F.NGW = F.G * NWAVES;
}
#if MK_MULTI
template <int PH>
__global__ void __launch_bounds__(NWAVES * 64, 2) mk_phase(Args args, int hl, int zsi, int j) {
    extern __shared__ __attribute__((aligned(16))) unsigned char lds_raw[];
    Frame F; make_frame(F, lds_raw);
    phase_body<PH>(F, args, hl, zsi, j);
}
#endif

static void fill_args(Args& a, void* const* d_in, void* d_out, void* d_ws) {
    for (int i = 0; i < 31; ++i) a.in[i] = (const float*)d_in[i];
    a.out = (float*)d_out; a.ws = (unsigned char*)d_ws;
    unsigned char* ws = (unsigned char*)d_ws;
    int nd = 0, items = 0;
    auto add = [&](const float* src, size_t dst_off, int K, int N, int mode) { a.wd[nd].src = src; a.wd[nd].dst = (bf16*)(ws + dst_off); a.wd[nd].K = K; a.wd[nd].N = N; a.wd[nd].mode = mode; a.wd[nd].item0 = items; items += (K / 64) * (N / 64); ++nd; };
    auto ffn = [&](int hl) { const int L = hl >> 1, wh = hl & 1;
        add(a.in[wh ? 13 : 11] + (size_t)L * DM * NGU, WS_W + (size_t)hl * FFN_BYTES, DM, NGU, 1);
        add(a.in[wh ? 14 : 12] + (size_t)L * DFF * DM, WS_W + (size_t)hl * FFN_BYTES + GU_BYTES, DFF, DM, 0); };
    auto mixa = [&](int j) { add(a.in[15] + (size_t)j * DM * AQKV, WS_WA + (size_t)j * A_BYTES, DM, AQKV, 0); add(a.in[16] + (size_t)j * 1024 * DM, WS_WA + (size_t)j * A_BYTES + AQ_BYTES, 1024, DM, 0); };
    a.slot[0][0] = items; ffn(0); mixa(0); ffn(2); a.slot[0][1] = items;
    a.slot[1][0] = items; ffn(1); a.slot[1][1] = items;
    a.slot[2][0] = items; add(a.in[17], WS_WB, DM, BIN, 0); a.slot[2][1] = items;
    a.slot[3][0] = items; add(a.in[22], WS_WB + BI_BYTES, 4096, DM, 0); a.slot[3][1] = items;
    a.slot[4][0] = items; ffn(3); ffn(4); add(a.in[23], WS_WC, DM, CIN, 0); add(a.in[30], WS_WC + CI_BYTES, 4096, DM, 0); ffn(5); a.slot[4][1] = items;
    a.slot[5][0] = items; ffn(6); mixa(1); ffn(7); a.slot[5][1] = items;
    { const double fr[10] = {0.0, 0.35, 0.44, 0.53, 0.62, 0.71, 0.80, 0.89, 0.945, 1.0}; for (int i = 0; i < 10; ++i) a.cc[i] = (int)(fr[i] * CC_TOT); a.cc[9] = CC_TOT; a.cc[10] = CC_TOT; a.cc[11] = CC_TOT; }
    a.nitems = items; a.pad = 0;
}
#if MK_MULTI
template <int PH> static void launch_phase(const Args& a, int grid, hipStream_t stream, int hl, int zsi, int j) {
    static bool attr = false;
    if (!attr) { (void)hipFuncSetAttribute((const void*)mk_phase<PH>, hipFuncAttributeMaxDynamicSharedMemorySize, LDS_BYTES); attr = true; }
    hipLaunchKernelGGL(mk_phase<PH>, dim3(grid), dim3(NWAVES * 64), LDS_BYTES, stream, a, hl, zsi, j);
}
extern "C" void kernel_launch(void* const* d_in, const int* in_sizes, int n_in, void* d_out, int out_size, void* d_ws, size_t ws_size, hipStream_t stream) {
    static int grid = 0;
    if (grid == 0) {
        if (n_in != 31 || (size_t)out_size != O_END || ws_size < WS_END) {
            fprintf(stderr, "kernel_launch: expected 31 inputs, out %zu floats, ws >= %zu bytes; got n_in %d out %d ws %zu; nothing launched\n", (size_t)O_END, (size_t)WS_END, n_in, out_size, ws_size);
            grid = -1; return;
        }
        int dev = 0, cus = 0;
        if (hipGetDevice(&dev) != hipSuccess || hipDeviceGetAttribute(&cus, hipDeviceAttributeMultiprocessorCount, dev) != hipSuccess) { grid = -1; return; }
        grid = cus;
    }
    if (grid < 0) return;
    Args a{}; fill_args(a, d_in, d_out, d_ws);
    launch_phase<PH_PRO>(a, grid, stream, 0, 0, 0);
    for (int hl = 0; hl < 8; ++hl) {
        const int layer = hl >> 1, which = hl & 1, zf = 3 * layer + 2 * which, zm = 3 * layer + 1;
        launch_phase<PH_GU>(a, grid, stream, hl, zf, 0);
        launch_phase<PH_DN>(a, grid, stream, hl, zf, 0);
        launch_phase<PH_LN>(a, grid, stream, hl, zf, 0);
        if (which == 1) continue;
        if (layer == 0 || layer == 3) {
            const int j = layer == 0 ? 0 : 1;
            launch_phase<PH_AQKV>(a, grid, stream, hl, zm, j); launch_phase<PH_ATT>(a, grid, stream, hl, zm, j); launch_phase<PH_AO>(a, grid, stream, hl, zm, j);
        } else if (layer == 1) {
            launch_phase<PH_BIN>(a, grid, stream, hl, zm, 0); launch_phase<PH_BPREP>(a, grid, stream, hl, zm, 0); launch_phase<PH_BCHAIN>(a, grid, stream, hl, zm, 0); launch_phase<PH_BO>(a, grid, stream, hl, zm, 0); launch_phase<PH_BOUT>(a, grid, stream, hl, zm, 0);
        } else {
            launch_phase<PH_CIN>(a, grid, stream, hl, zm, 0); launch_phase<PH_CPRE>(a, grid, stream, hl, zm, 0); launch_phase<PH_CCHAIN>(a, grid, stream, hl, zm, 0); launch_phase<PH_CNORM>(a, grid, stream, hl, zm, 0); launch_phase<PH_COUT>(a, grid, stream, hl, zm, 0);
        }
        launch_phase<PH_LN>(a, grid, stream, hl, zm, 0);
    }
    const hipError_t le = hipPeekAtLastError();
    if (le != hipSuccess) fprintf(stderr, "kernel_launch: launch failed: %s\n", hipGetErrorName(le));
}
#endif
#if !MK_MULTI
DI void launder_frame(Frame& F) {
    int t_ = F.tid, l_ = F.lane, w_ = F.wave, g_ = F.G, b_ = F.bid; unsigned la_ = (unsigned)(size_t)F.lds;
    asm volatile("" : "+v"(t_), "+v"(l_)); asm volatile("" : "+s"(w_), "+s"(g_), "+s"(b_), "+s"(la_));
    F.tid = t_; F.lane = l_; F.wave = w_; F.G = g_; F.bid = b_; F.gw = b_ * NWAVES + w_; F.NGW = g_ * NWAVES; F.lds = (LAS uchar*)(size_t)la_;
}
__global__ void __launch_bounds__(NWAVES * 64, 2) mk_fwd(Args args) {
    extern __shared__ __attribute__((aligned(16))) unsigned char lds_raw[];
    Frame F; make_frame(F, lds_raw);
    volatile LAS unsigned* MISC = (volatile LAS unsigned*)(F.lds + MISC_OFF);
    for (int u = F.tid; u < (LDS_BYTES - MISC_OFF) / 4; u += NWAVES * 64) ((LAS unsigned*)(F.lds + MISC_OFF))[u] = 0u;
    __syncthreads();
    XcdBarrier bar = xcd_barrier_post((unsigned*)(args.ws + WS_CTL) + CW_BAR, MISC + 8);
#ifndef DUP_PH
#define DUP_PH -1
#endif
#define RUN1(PH, hl, zsi, j) do { asm volatile("; MARK_PHASE %0 %1" :: "i"(PH), "i"(zsi)); launder_frame(F); phase_body<PH>(F, args, hl, zsi, j); xcd_barrier(bar); } while (0)
#define RUN(PH, hl, zsi, j) do { RUN1(PH, hl, zsi, j); if (PH == DUP_PH) { launder_frame(F); phase_body<PH>(F, args, hl, zsi, j, true); xcd_barrier(bar); } } while (0)
#define FFN(hl, zsi) RUN(PH_GU, hl, zsi, 0); RUN(PH_DN, hl, zsi, 0); RUN(PH_LN, hl, zsi, 0)
#define MIXA(zsi, j) RUN(PH_AQKV, 0, zsi, j); RUN(PH_ATT, 0, zsi, j); RUN(PH_AO, 0, zsi, j); RUN(PH_LN, 0, zsi, 0)
#define MIXB(zsi) RUN(PH_BIN, 0, zsi, 0); RUN(PH_BPREP, 0, zsi, 0); RUN(PH_BCHAIN, 0, zsi, 0); RUN(PH_BO, 0, zsi, 0); RUN(PH_BOUT, 0, zsi, 0); RUN(PH_LN, 0, zsi, 0)
#define MIXC(zsi) RUN(PH_CIN, 0, zsi, 0); RUN(PH_CPRE, 0, zsi, 0); RUN(PH_CCHAIN, 0, zsi, 0); RUN(PH_CNORM, 0, zsi, 0); RUN(PH_COUT, 0, zsi, 0); RUN(PH_LN, 0, zsi, 0)
    RUN(PH_PRO, 0, 0, 0);
    FFN(0, 0); MIXA(1, 0); FFN(1, 2);
    FFN(2, 3); MIXB(4);    FFN(3, 5);
    FFN(4, 6); MIXC(7);    FFN(5, 8);
    FFN(6, 9); MIXA(10, 1); FFN(7, 11);
}
extern "C" void kernel_launch(void* const* d_in, const int* in_sizes, int n_in, void* d_out, int out_size, void* d_ws, size_t ws_size, hipStream_t stream) {
    static int grid = 0;
    if (grid == 0) {
        if (n_in != 31 || (size_t)out_size != O_END || ws_size < WS_END) {
            fprintf(stderr, "kernel_launch: expected 31 inputs, out %zu floats, ws >= %zu bytes; got n_in %d out %d ws %zu; nothing launched\n", (size_t)O_END, (size_t)WS_END, n_in, out_size, ws_size);
            grid = -1; return;
        }
        int dev = 0, cus = 0, per_cu = 0;
        if (hipGetDevice(&dev) != hipSuccess || hipDeviceGetAttribute(&cus, hipDeviceAttributeMultiprocessorCount, dev) != hipSuccess) { grid = -1; return; }
        if (hipFuncSetAttribute((const void*)mk_fwd, hipFuncAttributeMaxDynamicSharedMemorySize, LDS_BYTES) != hipSuccess) { fprintf(stderr, "kernel_launch: hipFuncSetAttribute failed\n"); grid = -1; return; }
        if (hipOccupancyMaxActiveBlocksPerMultiprocessor(&per_cu, (const void*)mk_fwd, NWAVES * 64, LDS_BYTES) != hipSuccess || per_cu < 1)
            fprintf(stderr, "kernel_launch: note: occupancy query reports %d workgroups per CU\n", per_cu);
        (void)hipGetLastError();
        grid = cus;
    }
    if (grid < 0) return;
    if (hipMemsetAsync((char*)d_ws + WS_CTL, 0, CTL_ZERO_BYTES, stream) != hipSuccess) { fprintf(stderr, "kernel_launch: memset failed\n"); return; }
    Args a{}; fill_args(a, d_in, d_out, d_ws);
    hipLaunchKernelGGL(mk_fwd, dim3(grid), dim3(NWAVES * 64), LDS_BYTES, stream, a);
    const hipError_t le = hipPeekAtLastError();
    if (le != hipSuccess) fprintf(stderr, "kernel_launch: launch failed: %s\n", hipGetErrorName(le));
}
#endif
```

```cpp
#include <hip/hip_runtime.h>
#include <cstdio>
#include <cstdint>
#ifndef MK_MULTI
#define MK_MULTI 0
#endif
#define DUP_PH -1
#define DUP_SUB 0
namespace pg8 {
#define PG8_LAS __attribute__((address_space(3)))
typedef unsigned short bf16_t;
typedef short bf16x8 __attribute__((ext_vector_type(8)));
typedef float f32x4 __attribute__((ext_vector_type(4)));
typedef unsigned u32x4 __attribute__((ext_vector_type(4)));
constexpr int BM = 256, BK = 64, HALF = 128, HTB = HALF * BK * 2  , STAGE_BYTES = 8 * HTB, NXCD = 8, WGM = 8;

__host__ __device__ __forceinline__ int lds_byte(int r, int c) { const int st = (r >> 4) * 2 + (c >> 5), rr = r & 15, cc = c & 31, ob = rr * 64 + cc * 2; return st * 1024 + (ob ^ (((ob >> 9) & 1) << 5)); }
__host__ __device__ __forceinline__ void stage_rc(int b, int& R, int& C) { const int st = b / 1024, sb = b % 1024, swz = sb ^ (((sb >> 9) & 1) << 5); R = (st >> 1) * 16 + swz / 64; C = (st & 1) * 32 + (swz % 64) / 2; }
__host__ __device__ __forceinline__ int perm32(int rho) { const int n = rho >> 4, i = rho & 15; return 8 * (i >> 2) + 4 * n + (i & 3); }

struct Unit { int pm, pn; };
struct Gemm { const bf16_t* A; const bf16_t* Bt; int M, N, K, ld; };

struct StaticOrder {
    int nM, nN, nwg, G, c;
    __host__ __device__ void init(int M, int N, int G_, int c_) { nM = M / BM; nN = N / BM; nwg = nM * nN; G = G_; c = c_; }
    __host__ __device__ bool next(int i, Unit& u) const {
        const long L = (long)i * G + c; if (L >= nwg) return false;
        int wgid = (int)L; { const int q = nwg / NXCD, r = nwg % NXCD, xcd = wgid % NXCD, off = wgid / NXCD; wgid = (xcd < r ? xcd * (q + 1) : r * (q + 1) + (xcd - r) * q) + off; }
        const int nig = WGM * nN, gid = wgid / nig, fm = gid * WGM, gsz = (nM - fm) < WGM ? (nM - fm) : WGM;
        u.pm = fm + ((wgid % nig) % gsz); u.pn = (wgid % nig) / gsz; return true;
    }
    __device__ __forceinline__ void a_ready(const Unit&) const {}
    __device__ __forceinline__ void done(const Unit&) const {}
};


template <class Epi, class Sched, bool ALIGN_EPI = false, bool SP2 = false>
__device__ __forceinline__ void gemm_phase(PG8_LAS unsigned char* lds, const Gemm g, const Sched& S, const Epi& E, const int tid) {
    const int wid = __builtin_amdgcn_readfirstlane(tid >> 6), lane = tid & 63, wr = wid >> 2, wc = wid & 3, fr = lane & 15, fq = lane >> 4;
    const int K = g.ld, nt = g.K / BK;
    unsigned voffA[2], voffB[2];
#pragma unroll
    for (int i = 0; i < 2; ++i) { int R, C; stage_rc(tid * 16 + i * 8192, R, C); const int Rb = Epi::PERM ? ((R & ~31) + perm32(R & 31)) : R;
        voffA[i] = (unsigned)(R * K + C) * 2u; voffB[i] = (unsigned)(Rb * K + C) * 2u; }
    const size_t kstep = (size_t)(BK * 2);
    const size_t hstep = (size_t)HALF * K * 2;
    const size_t tstep = 2 * hstep;
    const unsigned ldsw = (unsigned)wid * 1024u;
    const int aoff = lds_byte(wr * 64 + fr, fq * 8), boff = lds_byte(wc * 32 + fr, fq * 8);
#define PG8_SA(b, h) (((b) * 2 + (h)) * HTB)
#define PG8_SB(b, h) ((4 + (b) * 2 + (h)) * HTB)
#define PG8_STAGE(bufoff, gbase, voff) do { _Pragma("unroll") for (int _i = 0; _i < 2; ++_i) \
        __builtin_amdgcn_global_load_lds((const unsigned*)((const char*)(gbase) + (voff)[_i]), (PG8_LAS unsigned*)(lds + (bufoff) + ldsw + _i * 8192), 16, 0, 0); } while (0)
#define PG8_LDA(dst, b, h) do { _Pragma("unroll") for (int m = 0; m < 4; ++m) _Pragma("unroll") for (int k = 0; k < 2; ++k) dst[m][k] = *(const PG8_LAS bf16x8*)(lds + PG8_SA(b, h) + aoff + m * 2048 + k * 1024); } while (0)
#define PG8_LDB(dst, b, h) do { _Pragma("unroll") for (int n = 0; n < 2; ++n) _Pragma("unroll") for (int k = 0; k < 2; ++k) dst[n][k] = *(const PG8_LAS bf16x8*)(lds + PG8_SB(b, h) + boff + n * 2048 + k * 1024); } while (0)
#define PG8_MMA(ai, bj, At, Bt) do { __builtin_amdgcn_s_setprio(1); _Pragma("unroll") for (int m = 0; m < 4; ++m) _Pragma("unroll") for (int n = 0; n < 2; ++n) _Pragma("unroll") for (int k = 0; k < 2; ++k) \
        acc[ai][bj][m][n] = __builtin_amdgcn_mfma_f32_16x16x32_bf16(Bt[n][k], At[m][k], acc[ai][bj][m][n], 0, 0, 0); __builtin_amdgcn_s_setprio(0); } while (0)
#define PG8_WAIT_V(n) asm volatile("s_waitcnt vmcnt(" #n ")" ::: "memory")
#define PG8_WAIT_L(n) asm volatile("s_waitcnt lgkmcnt(" #n ")" ::: "memory")
#define PG8_BAR __builtin_amdgcn_s_barrier()
#define PG8_SCHED __builtin_amdgcn_sched_barrier(0)
    Unit cur, nxt; int ui = 0;
    if (!S.next(0, cur)) return;
    f32x4 acc[2][2][4][2];
#pragma unroll
    for (int a = 0; a < 2; ++a)
#pragma unroll
        for (int b = 0; b < 2; ++b)
#pragma unroll
            for (int m = 0; m < 4; ++m)
#pragma unroll
                for (int n = 0; n < 2; ++n) acc[a][b][m][n] = (f32x4){0.f, 0.f, 0.f, 0.f};
    bf16x8 At[4][2], B0[2][2], B1[2][2];
    const char* cA = (const char*)g.A + (size_t)cur.pm * tstep; const char* cB = (const char*)g.Bt + (size_t)cur.pn * tstep;
    S.a_ready(cur);
    if constexpr (SP2) {
        PG8_STAGE(PG8_SB(0, 0), cB, voffB); PG8_STAGE(PG8_SB(0, 1), cB + hstep, voffB); PG8_STAGE(PG8_SA(0, 0), cA, voffA); PG8_STAGE(PG8_SA(0, 1), cA + hstep, voffA);
        if (wr == 1) PG8_BAR;
        PG8_WAIT_V(2); PG8_BAR;
        PG8_STAGE(PG8_SB(1, 0), cB + kstep, voffB); PG8_STAGE(PG8_SA(1, 0), cA + kstep, voffA); PG8_STAGE(PG8_SB(1, 1), cB + hstep + kstep, voffB);
        PG8_WAIT_V(6); PG8_BAR;
    } else {
        PG8_STAGE(PG8_SB(0, 0), cB, voffB); PG8_STAGE(PG8_SA(0, 0), cA, voffA); PG8_STAGE(PG8_SB(0, 1), cB + hstep, voffB); PG8_STAGE(PG8_SA(0, 1), cA + hstep, voffA);
        if (wr == 1) PG8_BAR;
        PG8_WAIT_V(4); PG8_BAR;
        PG8_STAGE(PG8_SB(1, 0), cB + kstep, voffB); PG8_STAGE(PG8_SA(1, 0), cA + kstep, voffA); PG8_STAGE(PG8_SB(1, 1), cB + hstep + kstep, voffB);
        PG8_WAIT_V(6); PG8_BAR;
    }
    for (;;) {
        const bool has_next = S.next(ui + 1, nxt);
        const char* nA = has_next ? (const char*)g.A + (size_t)nxt.pm * tstep : cA; const char* nB = has_next ? (const char*)g.Bt + (size_t)nxt.pn * tstep : cB;
        for (int t = 0; t < nt; t += 2) {
            const bool last = (t == nt - 2);
            const char* a1 = cA + (size_t)(t + 1) * kstep;
            const char* a2 = last ? nA : cA + (size_t)(t + 2) * kstep; const char* b2 = last ? nB : cB + (size_t)(t + 2) * kstep;
            const char* a3 = a2 + kstep; const char* b3 = b2 + kstep;
            if (last && has_next) S.a_ready(nxt);
            if constexpr (SP2) {
            PG8_LDB(B0, 0, 0); PG8_LDB(B1, 0, 1); PG8_SCHED; PG8_LDA(At, 0, 0); PG8_STAGE(PG8_SA(1, 1), a1 + hstep, voffA);
            PG8_WAIT_V(8); PG8_WAIT_L(0); PG8_BAR; PG8_MMA(0, 0, At, B0); PG8_MMA(0, 1, At, B1); PG8_BAR; PG8_SCHED;
            PG8_LDA(At, 0, 1); PG8_STAGE(PG8_SB(0, 0), b2, voffB); PG8_STAGE(PG8_SB(0, 1), b2 + hstep, voffB); PG8_STAGE(PG8_SA(0, 0), a2, voffA);
            PG8_WAIT_V(8); PG8_WAIT_L(0); PG8_BAR; PG8_MMA(1, 0, At, B0); PG8_MMA(1, 1, At, B1); PG8_BAR; PG8_SCHED;
            PG8_LDB(B0, 1, 0); PG8_LDB(B1, 1, 1); PG8_SCHED; PG8_LDA(At, 1, 0); PG8_STAGE(PG8_SA(0, 1), a2 + hstep, voffA);
            PG8_WAIT_V(8); PG8_WAIT_L(0); PG8_BAR; PG8_MMA(0, 0, At, B0); PG8_MMA(0, 1, At, B1); PG8_BAR; PG8_SCHED;
            PG8_LDA(At, 1, 1); PG8_STAGE(PG8_SB(1, 0), b3, voffB); PG8_STAGE(PG8_SB(1, 1), b3 + hstep, voffB); PG8_STAGE(PG8_SA(1, 0), a3, voffA);
            PG8_WAIT_V(8); PG8_WAIT_L(0); PG8_BAR; PG8_MMA(1, 0, At, B0); PG8_MMA(1, 1, At, B1); PG8_BAR; PG8_SCHED;
            } else {
            PG8_LDB(B0, 0, 0); PG8_SCHED; PG8_LDA(At, 0, 0); PG8_STAGE(PG8_SA(1, 1), a1 + hstep, voffA);
            PG8_WAIT_L(8); PG8_BAR; PG8_WAIT_L(0); PG8_MMA(0, 0, At, B0); PG8_BAR; PG8_SCHED;
            PG8_LDB(B1, 0, 1); PG8_STAGE(PG8_SB(0, 0), b2, voffB);
            PG8_BAR; PG8_WAIT_L(0); PG8_MMA(0, 1, At, B1); PG8_BAR;
            PG8_LDA(At, 0, 1); PG8_STAGE(PG8_SA(0, 0), a2, voffA);
            PG8_BAR; PG8_WAIT_L(0); PG8_MMA(1, 0, At, B0); PG8_BAR; PG8_SCHED;
            PG8_STAGE(PG8_SB(0, 1), b2 + hstep, voffB);
            PG8_WAIT_V(6); PG8_BAR; PG8_MMA(1, 1, At, B1); PG8_BAR;
            PG8_LDB(B0, 1, 0); PG8_SCHED; PG8_LDA(At, 1, 0); PG8_STAGE(PG8_SA(0, 1), a2 + hstep, voffA);
            PG8_WAIT_L(8); PG8_BAR; PG8_WAIT_L(0); PG8_MMA(0, 0, At, B0); PG8_BAR; PG8_SCHED;
            PG8_LDB(B1, 1, 1); PG8_STAGE(PG8_SB(1, 0), b3, voffB);
            PG8_BAR; PG8_WAIT_L(0); PG8_MMA(0, 1, At, B1); PG8_BAR;
            PG8_LDA(At, 1, 1); PG8_STAGE(PG8_SA(1, 0), a3, voffA);
            PG8_BAR; PG8_WAIT_L(0); PG8_MMA(1, 0, At, B0); PG8_BAR; PG8_SCHED;
            PG8_STAGE(PG8_SB(1, 1), b3 + hstep, voffB);
            PG8_WAIT_V(6); PG8_BAR; PG8_MMA(1, 1, At, B1); PG8_BAR;
            }
        }
        if constexpr (ALIGN_EPI) { if (wr == 0) PG8_BAR; }
        if constexpr (!Epi::AFTER_DRAIN) { E(acc, cur, wr, wc, fr, fq); S.done(cur); }
        if (!has_next) break;
#pragma unroll
        for (int a = 0; a < 2; ++a)
#pragma unroll
            for (int b = 0; b < 2; ++b)
#pragma unroll
                for (int m = 0; m < 4; ++m)
#pragma unroll
                    for (int n = 0; n < 2; ++n) acc[a][b][m][n] = (f32x4){0.f, 0.f, 0.f, 0.f};
        cur = nxt; cA = nA; cB = nB; ++ui;
        if constexpr (ALIGN_EPI) { if (wr == 1) PG8_BAR; }
    }
    PG8_WAIT_V(0);
    if constexpr (!ALIGN_EPI) { if (wr == 0) PG8_BAR; }
    PG8_BAR;
    if constexpr (Epi::AFTER_DRAIN) { E.fused(acc, cur, wr, wc, fr, fq, lds, wid, lane); S.done(cur); }
#undef PG8_SA
#undef PG8_SB
#undef PG8_STAGE
#undef PG8_LDA
#undef PG8_LDB
#undef PG8_MMA
#undef PG8_WAIT_V
#undef PG8_WAIT_L
#undef PG8_BAR
#undef PG8_SCHED
}
}
#define GAS __attribute__((address_space(1)))
#define LAS __attribute__((address_space(3)))
typedef unsigned short bf16;
typedef unsigned char uchar;
typedef float f32x4 __attribute__((ext_vector_type(4)));
typedef float f32x2 __attribute__((ext_vector_type(2)));
typedef float f32x16 __attribute__((ext_vector_type(16)));
typedef short bf16x8 __attribute__((ext_vector_type(8)));
typedef short s16x4 __attribute__((ext_vector_type(4)));
typedef unsigned u32x4 __attribute__((ext_vector_type(4)));
typedef unsigned u32x2 __attribute__((ext_vector_type(2)));
typedef __bf16 hbf16x2 __attribute__((ext_vector_type(2)));
#define DI __device__ __forceinline__

DI unsigned pk2(float a, float b) { f32x2 v = {a, b}; hbf16x2 r = __builtin_convertvector(v, hbf16x2); return __builtin_bit_cast(unsigned, r); }
DI float bf2f(unsigned short b) { return __uint_as_float(((unsigned)b) << 16); }
DI float bflo(unsigned u) { return __uint_as_float(u << 16); }
DI float bfhi(unsigned u) { return __uint_as_float(u & 0xffff0000u); }
DI u32x2 pk4(f32x4 v) { u32x2 r; r.x = pk2(v[0], v[1]); r.y = pk2(v[2], v[3]); return r; }
DI float wave_sum(float v) {
#pragma unroll
    for (int o = 1; o < 64; o <<= 1) v += __shfl_xor(v, o);
    return v;
}
DI float wave_max(float v) {
#pragma unroll
    for (int o = 1; o < 64; o <<= 1) v = fmaxf(v, __shfl_xor(v, o));
    return v;
}
DI float silu_f(float x) { return x * __builtin_amdgcn_rcpf(1.f + __expf(-x)); }
DI float sigmoid_f(float x) { return __builtin_amdgcn_rcpf(1.f + __expf(-x)); }
DI float softplus_f(float x) { return x > 20.f ? x : log1pf(__expf(x)); }
#define LDS_BARRIER() do { asm volatile("s_waitcnt lgkmcnt(0)" ::: "memory"); __builtin_amdgcn_s_barrier(); asm volatile("" ::: "memory"); } while (0)
DI int crow(int r, int h) { return (r & 3) + 8 * (r >> 2) + 4 * h; }
template <class T> DI T ldg(const void* base, unsigned off) { return *(const T*)((const char*)base + off); }
template <class T> DI void stg(void* base, unsigned off, T v) { *(T*)((char*)base + off) = v; }

constexpr int DM = 2048, TP = 4096, NBP = 2, MP = NBP * TP, MS = 32, MALL = MP + MS, DFF = 5632, NGU = 2 * DFF;
constexpr int AQKV = 9216, BIN = 12352, BINM = 12288, CIN = 10304, CINM = 10240;
constexpr float DN_ALPHA = 1.6817928305074290f;
constexpr float LN_EPS = 1e-5f, RMS_EPS = 1e-6f;
constexpr int PASTLEN = 16384;

constexpr size_t O_YP = 0, O_YS = O_YP + (size_t)MP * DM, O_A128P = O_YS + (size_t)MS * DM,
    O_A128S = O_A128P + 1048576, O_A512P = O_A128S + 4194304, O_A512S = O_A512P + 4194304, O_A2048P = O_A512S + 16777216,
    O_A2048S = O_A2048P + 16777216, O_BSSMP = O_A2048S + 67108864, O_BSSMS = O_BSSMP + 1048576, O_BCONVP = O_BSSMS + 4194304,
    O_BCONVS = O_BCONVP + 49152, O_CSSMP = O_BCONVS + 196608, O_CSSMS = O_CSSMP + 1048576, O_CCONVP = O_CSSMS + 4194304,
    O_CCONVS = O_CCONVP + 36864, O_END = O_CCONVS + 147456;

constexpr size_t MiB = 1u << 20;
constexpr size_t WS_CTL = 0, CTL_ZERO_BYTES = 1 * MiB;
constexpr size_t WS_ROPE = 1 * MiB;
constexpr size_t CTL_SPLIT = 65536;
constexpr size_t WS_ZS = 2 * MiB, ZS_ONE = (size_t)MS * DM * 4;
constexpr size_t WS_W = 8 * MiB;
constexpr size_t GU_BYTES = (size_t)NGU * DM * 2, DN_BYTES = (size_t)DM * DFF * 2, FFN_BYTES = GU_BYTES + DN_BYTES;
constexpr size_t WS_WA = WS_W + 8 * FFN_BYTES, AQ_BYTES = (size_t)AQKV * DM * 2, AO_BYTES = (size_t)DM * 1024 * 2, A_BYTES = AQ_BYTES + AO_BYTES;
constexpr size_t WS_WB = WS_WA + 2 * A_BYTES, BI_BYTES = (size_t)BIN * DM * 2, BO_BYTES = (size_t)DM * 4096 * 2;
constexpr size_t WS_WC = WS_WB + BI_BYTES + BO_BYTES, CI_BYTES = (size_t)CIN * DM * 2, CO_BYTES = BO_BYTES;
constexpr size_t WS_XB = WS_WC + CI_BYTES + CO_BYTES;
constexpr size_t WS_ZP = WS_XB + (size_t)MALL * DM * 2;
constexpr size_t WS_H = WS_ZP + (size_t)MP * DM * 4;
constexpr size_t WS_MIX = WS_H + (size_t)MALL * DFF * 2;
constexpr size_t MA_QKV = WS_MIX, MA_QKVS = MA_QKV + (size_t)MP * AQKV * 2, MA_OG = MA_QKVS + (size_t)MS * AQKV * 4,
    MA_LSE = MA_OG + (size_t)3 * MP * 1024 * 2, MA_O = MA_LSE + (size_t)3 * MP * 8 * 4, MA_END = MA_O + (size_t)MALL * 1024 * 2;
constexpr size_t MB_PB = WS_MIX, MB_EB = MB_PB + (size_t)MP * BINM * 2, MB_PBS = MB_EB + (size_t)MP * 64 * 4, MB_WG = MB_PBS + (size_t)MS * BIN * 4,
    MB_UG = MB_WG + (size_t)MP * 32 * 128 * 2, MB_QG = MB_UG + (size_t)MP * 32 * 128 * 2, MB_KG = MB_QG + (size_t)MP * 16 * 128 * 2,
    MB_QKG = MB_KG + (size_t)MP * 16 * 128 * 2, MB_GCG = MB_QKG + (size_t)2 * 32 * 64 * 64 * 64 * 2, MB_YB = MB_GCG + (size_t)MP * 32 * 4,
    MB_SG = MB_YB + (size_t)MALL * 4096 * 2, MB_VNG = MB_SG + (size_t)4096 * 16384 * 2, MB_END = MB_VNG + (size_t)MP * 32 * 128 * 2;
constexpr size_t MC_PC = WS_MIX, MC_EC = MC_PC + (size_t)MP * CINM * 2, MC_PCS = MC_EC + (size_t)MP * 64 * 4, MC_SS = MC_PCS + (size_t)MS * CIN * 4,
    MC_YC = MC_SS + (size_t)MP * 64 * 4, MC_ACS = MC_YC + (size_t)MALL * 4096 * 2, MC_XBC = MC_ACS + (size_t)MP * 64 * 4, MC_END = MC_XBC + (size_t)MP * 6144 * 2;
constexpr size_t WS_SLAB = (MB_END > MA_END ? (MB_END > MC_END ? MB_END : MC_END) : (MA_END > MC_END ? MA_END : MC_END));
constexpr size_t WS_END_OLD = (MB_END > MA_END ? (MB_END > MC_END ? MB_END : MC_END) : (MA_END > MC_END ? MA_END : MC_END));
constexpr size_t WS_END = WS_SLAB + (size_t)128 * 65536 * 4;
static_assert(CTL_SPLIT + 10 * 128 * 256 <= CTL_ZERO_BYTES && WS_SLAB % 256 == 0, "split");
static_assert(MA_QKVS % 256 == 0 && MA_OG % 256 == 0 && MA_O % 256 == 0 && MB_EB % 256 == 0 && MB_WG % 256 == 0 && MB_YB % 256 == 0 && MC_YC % 256 == 0 && WS_MIX % 256 == 0, "alignment");

constexpr int CW_BAR = 4096;
constexpr int SCR_BYTES = 143360, MISC_OFF = SCR_BYTES, LDS_BYTES = 147456;
constexpr int NWAVES = 8;

struct WDesc { const float* src; bf16* dst; int K, N, mode, item0; };
constexpr int NWD = 24;
struct Args { const float* in[31]; float* out; unsigned char* ws; WDesc wd[NWD]; int slot[6][2]; int cc[12]; int nitems; int pad; };

struct Frame {
    LAS uchar* lds;
    int tid, lane, wave, G, gw, NGW, bid;
};
#define XB_TMO      128
#define XB_XCNT(j)  (256  + 64 * (j))
#define XB_XSUB(j)  (1280 + 64 * (j))
#define XB_XGEN(j)  (2304 + 64 * (j))
#define XB_TOP      3328
#define XB_TOPGEN   3392
#define XCD_BAR_WORDS 3456
#define XB_SPIN_CAP (1u << 18)

__device__ __forceinline__ unsigned xb_ld(unsigned* p)              { return __hip_atomic_load(p, __ATOMIC_RELAXED, __HIP_MEMORY_SCOPE_AGENT); }
__device__ __forceinline__ unsigned xb_add(unsigned* p, unsigned v) { return __hip_atomic_fetch_add(p, v, __ATOMIC_RELAXED, __HIP_MEMORY_SCOPE_AGENT); }
__device__ __forceinline__ unsigned xb_xcc_id() { return (unsigned)__builtin_amdgcn_s_getreg((3 << 11) | 20) & 0xFu; }
#define XB_SPIN(cond, bar) do { unsigned _sp = 0; while (cond) { __builtin_amdgcn_s_sleep(1); \
    if ((++_sp & 255u) == 0u) { if (xb_ld(&(bar)[XB_TMO])) break; if (_sp > XB_SPIN_CAP) { atomicAdd(&(bar)[XB_TMO], 1u); break; } } } } while (0)

struct XcdBarrier {
    unsigned* bar; unsigned x;
    volatile LAS unsigned* st;
};

__device__ __forceinline__ XcdBarrier xcd_barrier_post(unsigned* bar, volatile LAS unsigned* st) {
    XcdBarrier b; b.bar = bar; b.x = xb_xcc_id(); b.st = st;
    if (threadIdx.x == 0) (void)xb_add(&bar[XB_XCNT(b.x)], 1u);
    return b;
}
__device__ __forceinline__ void xcd_barrier_complete(unsigned* bar, unsigned x, unsigned& nloc, unsigned& nx) {
    const unsigned G = gridDim.x * gridDim.y * gridDim.z;
    unsigned sum, cnt, mine, sp = 0u;
    for (;;) {
        sum = 0u; cnt = 0u; mine = 0u;
#pragma unroll
        for (unsigned j = 0; j < 16; ++j) { const unsigned c = xb_ld(&bar[XB_XCNT(j)]); sum += c; cnt += (c > 0u) ? 1u : 0u; mine = (j == x) ? c : mine; }
        if (sum == G) break;
        __builtin_amdgcn_s_sleep(1);
        if ((++sp & 255u) == 0u) { if (xb_ld(&bar[XB_TMO])) break; if (sp > XB_SPIN_CAP) { atomicAdd(&bar[XB_TMO], 1u); break; } }
    }
    nloc = mine > 0u ? mine : 1u; nx = cnt > 0u ? cnt : 1u;
}

__device__ __forceinline__ void xcd_barrier(const XcdBarrier& b) {
    asm volatile("s_waitcnt vmcnt(0)" ::: "memory");
    __syncthreads();
    if (threadIdx.x == 0) {
        unsigned* bar = b.bar;
        __builtin_amdgcn_s_waitcnt(0);
        unsigned nloc = b.st[0], nx = b.st[1];
        if (nloc == 0u) { xcd_barrier_complete(bar, b.x, nloc, nx); b.st[0] = nloc; b.st[1] = nx; }
        const unsigned old = xb_add(&bar[XB_XSUB(b.x)], 1u);
        const unsigned gen = old / nloc;
        if (old + 1u == (gen + 1u) * nloc) {
            __builtin_amdgcn_fence(__ATOMIC_RELEASE, "agent");
            asm volatile("s_waitcnt vmcnt(0)" ::: "memory");
            const unsigned og = xb_add(&bar[XB_TOP], 1u);
            const unsigned tg = og / nx;
            if (og + 1u == (tg + 1u) * nx) xb_add(&bar[XB_TOPGEN], 1u);
            else XB_SPIN(xb_ld(&bar[XB_TOPGEN]) == tg, bar);
            __builtin_amdgcn_fence(__ATOMIC_ACQUIRE, "agent");
            xb_add(&bar[XB_XGEN(b.x)], 1u);
            asm volatile("s_waitcnt vmcnt(0)" ::: "memory");
        } else {
            XB_SPIN(xb_ld(&bar[XB_XGEN(b.x)]) == gen, bar);
            __builtin_amdgcn_fence(__ATOMIC_ACQUIRE, "agent");
            asm volatile("s_waitcnt vmcnt(0)" ::: "memory");
        }
    }
    __syncthreads();
}
#define MFMA32(a, b, c) __builtin_amdgcn_mfma_f32_32x32x16_bf16((a), (b), (c), 0, 0, 0)
DI s16x4 lds_tr(LAS const uchar* p) { return __builtin_amdgcn_ds_read_tr16_b64_v4i16((LAS s16x4*)p); }
DI bf16x8 frag_xk(LAS const uchar* base, int ld, int x0, int k0, int lane) {
    return *(LAS const bf16x8*)(base + (x0 + (lane & 31)) * ld + (k0 + 8 * (lane >> 5)) * 2);
}
DI bf16x8 frag_kx(LAS const uchar* base, int ld, int x0, int k0, int lane) {
    const int h = lane >> 5, blk = (lane >> 4) & 1, q = (lane & 15) >> 2, p = lane & 3;
    LAS const uchar* a = base + (k0 + 8 * h + q) * ld + (x0 + 16 * blk + 4 * p) * 2;
    const s16x4 lo = lds_tr(a), hi = lds_tr(a + 4 * ld);
    return __builtin_shufflevector(lo, hi, 0, 1, 2, 3, 4, 5, 6, 7);
}
DI bf16x8 frag_kx_perm(LAS const uchar* base, int ld, int x0, int k0, int lane) {
    const int h = lane >> 5, blk = (lane >> 4) & 1, q = (lane & 15) >> 2, p = lane & 3;
    LAS const uchar* a = base + (k0 + 4 * h + q) * ld + (x0 + 16 * blk + 4 * p) * 2;
    const s16x4 lo = lds_tr(a), hi = lds_tr(a + 8 * ld);
    return __builtin_shufflevector(lo, hi, 0, 1, 2, 3, 4, 5, 6, 7);
}
DI bf16x8 pack_step(const f32x16& x, int s) {
    u32x4 p;
    p.x = pk2(x[8 * s + 0], x[8 * s + 1]); p.y = pk2(x[8 * s + 2], x[8 * s + 3]); p.z = pk2(x[8 * s + 4], x[8 * s + 5]); p.w = pk2(x[8 * s + 6], x[8 * s + 7]);
    return __builtin_bit_cast(bf16x8, p);
}
DI f32x16 zero16() { f32x16 z;
#pragma unroll
    for (int i = 0; i < 16; ++i) z[i] = 0.f; return z; }
template <bool A_KX, bool B_KX>
DI f32x16 mm_tile(f32x16 acc, LAS const uchar* A, int lda, int am0, LAS const uchar* B, int ldb, int bn0, int ksteps, int lane) {
#pragma unroll 4
    for (int s = 0; s < ksteps; ++s) {
        const bf16x8 a = A_KX ? frag_kx(A, lda, am0, 16 * s, lane) : frag_xk(A, lda, am0, 16 * s, lane);
        const bf16x8 b = B_KX ? frag_kx(B, ldb, bn0, 16 * s, lane) : frag_xk(B, ldb, bn0, 16 * s, lane);
        acc = MFMA32(a, b, acc);
    }
    return acc;
}

struct FSwiglu {
    bf16* H;
    DI void operator()(int row, int col, f32x4 lo, f32x4 hi) const {
        f32x4 r;
#pragma unroll
        for (int e = 0; e < 4; ++e) r[e] = silu_f(lo[e]) * hi[e];
        *(u32x2*)(H + (size_t)row * DFF + ((col >> 5) << 4) + (col & 15)) = pk4(r);
    }
};
struct FResid {
    const bf16* XB; float* Z; long zrow_off; float s; int atomic, add_x;
    DI void operator()(int row, int col, f32x4 lo, f32x4 hi) const {
        float* zp = Z + ((long)row - zrow_off) * DM + col;
        f32x4 a = lo * s, b = hi * s;
        if (add_x) {
            const u32x2 x0 = *(const u32x2*)(XB + (size_t)row * DM + col), x1 = *(const u32x2*)(XB + (size_t)row * DM + col + 16);
            a[0] += bflo(x0.x) * DN_ALPHA; a[1] += bfhi(x0.x) * DN_ALPHA; a[2] += bflo(x0.y) * DN_ALPHA; a[3] += bfhi(x0.y) * DN_ALPHA;
            b[0] += bflo(x1.x) * DN_ALPHA; b[1] += bfhi(x1.x) * DN_ALPHA; b[2] += bflo(x1.y) * DN_ALPHA; b[3] += bfhi(x1.y) * DN_ALPHA;
        }
        if (atomic) {
#pragma unroll
            for (int e = 0; e < 4; ++e) { atomicAdd(zp + e, a[e]); atomicAdd(zp + 16 + e, b[e]); }
        } else { *(f32x4*)zp = a; *(f32x4*)(zp + 16) = b; }
    }
};
struct FBf16 {
    bf16* P; int ld;
    DI void operator()(int row, int col, f32x4 lo, f32x4 hi) const {
        bf16* p = P + (size_t)row * ld + col;
        *(u32x2*)p = pk4(lo); *(u32x2*)(p + 16) = pk4(hi);
    }
};
struct FF32 {
    float* P; int ld, row_off, col_off;
    DI void operator()(int row, int col, f32x4 lo, f32x4 hi) const {
        float* p = P + (size_t)(row - row_off) * ld + (col - col_off);
        *(f32x4*)p = lo; *(f32x4*)(p + 16) = hi;
    }
};
struct FQkv {
    bf16* QKV; float* QKVS; const float* rope; float* out; int j;
    DI void operator()(int row, int col, f32x4 lo, f32x4 hi) const {
        const int s = col / 3072, rem = col - s * 3072, g = rem >> 10, hh = (rem >> 7) & 7, d = rem & 127;
        const bool smp = row >= MP;
        const int pidx = smp ? TP + ((row - MP) & 3) : (row & (TP - 1));
        if (s < 2 && d < 16) {
            const f32x4 c = *(const f32x4*)(rope + (size_t)pidx * 32 + d), sn = *(const f32x4*)(rope + (size_t)pidx * 32 + 16 + d);
            const f32x4 x1 = lo, x2 = hi;
            lo = x1 * c - x2 * sn; hi = x2 * c + x1 * sn;
        }
        const int keep = 128 << (2 * g);
        if (!smp) {
            bf16* p = QKV + (size_t)row * AQKV + col;
            *(u32x2*)p = pk4(lo); *(u32x2*)(p + 16) = pk4(hi);
            if (s >= 1) {
                const int t = row & (TP - 1), b = row >> 12;
                if (t >= TP - keep) {
                    float* dst = out + (g == 0 ? O_A128P : g == 1 ? O_A512P : O_A2048P) + ((((size_t)(j * NBP + b) * keep + (t - (TP - keep))) * 2 + (s - 1)) * 8 + hh) * 128 + d;
                    *(f32x4*)dst = lo; *(f32x4*)(dst + 16) = hi;
                }
            }
        } else {
            const int r = row - MP, b = r >> 2, t = r & 3;
            float* p = QKVS + (size_t)r * AQKV + col;
            *(f32x4*)p = lo; *(f32x4*)(p + 16) = hi;
            if (s >= 1) {
                float* dst = out + (g == 0 ? O_A128S : g == 1 ? O_A512S : O_A2048S) + ((((size_t)(j * 8 + b) * keep + (keep - 4 + t)) * 2 + (s - 1)) * 8 + hh) * 128 + d;
                *(f32x4*)dst = lo; *(f32x4*)(dst + 16) = hi;
            }
        }
    }
};
template <class F> struct EpiWrap {
    static constexpr bool PERM = false, AFTER_DRAIN = false;
    F f;
    DI void operator()(const pg8::f32x4 (&acc)[2][2][4][2], const pg8::Unit& u, int wr, int wc, int fr, int fq) const {
#pragma unroll
        for (int ai = 0; ai < 2; ++ai)
#pragma unroll
            for (int m = 0; m < 4; ++m) {
                const int row = u.pm * 256 + ai * 128 + wr * 64 + m * 16 + fr;
#pragma unroll
                for (int bj = 0; bj < 2; ++bj) f(row, u.pn * 256 + bj * 128 + wc * 32 + 4 * fq, acc[ai][bj][m][0], acc[ai][bj][m][1]);
            }
    }
};


struct EpiSplitPartner {
    static constexpr bool PERM = false, AFTER_DRAIN = false;
    float* slab; unsigned* cnt;
    DI void operator()(const pg8::f32x4 (&acc)[2][2][4][2], const pg8::Unit&, int wr, int wc, int fr, int fq) const {
        const int t = (wr * 4 + wc) * 64 + fq * 16 + fr;
        __amdgpu_buffer_rsrc_t rs = __builtin_amdgcn_make_buffer_rsrc(slab, 0, 65536 * 4, 0x00020000);
#pragma unroll
        for (int ai = 0; ai < 2; ++ai)
#pragma unroll
            for (int bj = 0; bj < 2; ++bj)
#pragma unroll
                for (int m = 0; m < 4; ++m)
#pragma unroll
                    for (int n = 0; n < 2; ++n) {
                        const int q = ((ai * 2 + bj) * 4 + m) * 2 + n;
                        __builtin_amdgcn_raw_buffer_store_b128(__builtin_bit_cast(u32x4, acc[ai][bj][m][n]), rs, (q * 512 + t) * 16, 0, 16);
                    }
        asm volatile("s_waitcnt vmcnt(0)" ::: "memory");
        if (fq == 0 && fr == 0) __hip_atomic_fetch_add(cnt, 1u, __ATOMIC_RELAXED, __HIP_MEMORY_SCOPE_AGENT);
    }
};
template <class F> struct EpiSplitOwner {
    static constexpr bool PERM = false, AFTER_DRAIN = false;
    F f; const float* slab; unsigned* cnt;
    DI void operator()(const pg8::f32x4 (&acc)[2][2][4][2], const pg8::Unit& u, int wr, int wc, int fr, int fq) const {
        const int t = (wr * 4 + wc) * 64 + fq * 16 + fr;
        {
            const unsigned long long t0 = __builtin_amdgcn_s_memrealtime();
            while (__hip_atomic_load(cnt, __ATOMIC_RELAXED, __HIP_MEMORY_SCOPE_AGENT) < 8u) {
                __builtin_amdgcn_s_sleep(2);
                if (__builtin_amdgcn_s_memrealtime() - t0 > 5000000ull) break;
            }
            asm volatile("" ::: "memory");
        }
        __amdgpu_buffer_rsrc_t rs = __builtin_amdgcn_make_buffer_rsrc(const_cast<float*>(slab), 0, 65536 * 4, 0x00020000);
#pragma unroll
        for (int ai = 0; ai < 2; ++ai)
#pragma unroll
            for (int m = 0; m < 4; ++m) {
                const int row = u.pm * 256 + ai * 128 + wr * 64 + m * 16 + fr;
#pragma unroll
                for (int bj = 0; bj < 2; ++bj) {
                    const int q0 = ((ai * 2 + bj) * 4 + m) * 2;
                    const f32x4 p0 = __builtin_bit_cast(f32x4, __builtin_amdgcn_raw_buffer_load_b128(rs, (q0 * 512 + t) * 16, 0, 16));
                    const f32x4 p1 = __builtin_bit_cast(f32x4, __builtin_amdgcn_raw_buffer_load_b128(rs, ((q0 + 1) * 512 + t) * 16, 0, 16));
                    f(row, u.pn * 256 + bj * 128 + wc * 32 + 4 * fq, acc[ai][bj][m][0] + p0, acc[ai][bj][m][1] + p1);
                }
            }
    }
};
struct OneUnit {
    int pm, pn; bool valid;
    DI bool next(int i, pg8::Unit& u) const { if (i != 0 || !valid) return false; u.pm = pm; u.pn = pn; return true; }
    DI void a_ready(const pg8::Unit&) const {}
    DI void done(const pg8::Unit&) const {}
};
struct CappedOrder {
    pg8::StaticOrder S; int cap;
    DI bool next(int i, pg8::Unit& u) const { if ((long)i * S.G + S.c >= cap) return false; return S.next(i, u); }
    DI void a_ready(const pg8::Unit&) const {}
    DI void done(const pg8::Unit&) const {}
};
template <int NF, class F>
DI void skinny_unit(const Frame& Fr, const bf16* A, int lda, int row0, const bf16* Wt, int K, int f0, int kbeg, int klen, const F& f) {
    const int lane = Fr.lane, w = Fr.wave, h = lane >> 5;
    constexpr int LDW = 144;
    LAS uchar* Bl = Fr.lds + w * ((1 + NF) * 32 * LDW); LAS uchar* Al = Bl + 32 * LDW;
    const int nch = klen >> 6, lr = lane >> 3, lc = lane & 7;
    f32x16 acc[NF];
#pragma unroll
    for (int nf = 0; nf < NF; ++nf) acc[nf] = zero16();
    const unsigned bo = (unsigned)(((row0 + lr) * lda + kbeg + 8 * lc) * 2), ao = (unsigned)(((f0 + lr) * K + kbeg + 8 * lc) * 2);
    u32x4 pb[4], pa[NF][4];
    int c = w;
    if (c < nch) {
#pragma unroll
        for (int i = 0; i < 4; ++i) { pb[i] = ldg<u32x4>(A, bo + (unsigned)((8 * i * lda + 64 * c) * 2));
#pragma unroll
            for (int nf = 0; nf < NF; ++nf) pa[nf][i] = ldg<u32x4>(Wt, ao + (unsigned)(((32 * nf + 8 * i) * K + 64 * c) * 2)); }
    }
#pragma unroll 1
    for (; c < nch; c += 8) {
#pragma unroll
        for (int i = 0; i < 4; ++i) { *(LAS u32x4*)(Bl + (lr + 8 * i) * LDW + lc * 16) = pb[i];
#pragma unroll
            for (int nf = 0; nf < NF; ++nf) *(LAS u32x4*)(Al + nf * (32 * LDW) + (lr + 8 * i) * LDW + lc * 16) = pa[nf][i]; }
        const int cn = c + 8;
        if (cn < nch) {
#pragma unroll
            for (int i = 0; i < 4; ++i) { pb[i] = ldg<u32x4>(A, bo + (unsigned)((8 * i * lda + 64 * cn) * 2));
#pragma unroll
                for (int nf = 0; nf < NF; ++nf) pa[nf][i] = ldg<u32x4>(Wt, ao + (unsigned)(((32 * nf + 8 * i) * K + 64 * cn) * 2)); }
        }
#pragma unroll
        for (int s = 0; s < 4; ++s) {
            const bf16x8 b = frag_xk(Bl, LDW, 0, 16 * s, lane);
#pragma unroll
            for (int nf = 0; nf < NF; ++nf) acc[nf] = MFMA32(frag_xk(Al + nf * (32 * LDW), LDW, 0, 16 * s, lane), b, acc[nf]);
        }
    }
    __syncthreads();
    LAS float* red = (LAS float*)Fr.lds;
#pragma unroll
    for (int nf = 0; nf < NF; ++nf)
#pragma unroll
        for (int i = 0; i < 16; ++i) red[((w * NF + nf) * 16 + i) * 64 + lane] = acc[nf][i];
    __syncthreads();
    if (w < 2 * NF) {
        const int nf = w >> 1, g = w & 1, r = lane & 31;
        f32x4 lo = {0.f, 0.f, 0.f, 0.f}, hi = {0.f, 0.f, 0.f, 0.f};
#pragma unroll
        for (int ww = 0; ww < 8; ++ww)
#pragma unroll
            for (int e = 0; e < 4; ++e) {
                lo[e] += red[((ww * NF + nf) * 16 + 4 * g + e) * 64 + lane];
                hi[e] += red[((ww * NF + nf) * 16 + 4 * g + 8 + e) * 64 + lane];
            }
        f(row0 + r, f0 + 32 * nf + 8 * g + 4 * h, lo, hi);
    }
    __syncthreads();
}
DI void tr_item(const WDesc& d, int item, LAS float* scr, int lane) {
    const int nnt = d.N >> 6, kt = item / nnt, nt = item - kt * nnt, k0 = kt << 6, n0 = nt << 6;
    const float* src = d.src + (size_t)k0 * d.N + n0 + 4 * (lane & 15);
#pragma unroll 8
    for (int i = 0; i < 16; ++i) {
        const int kk = 4 * i + (lane >> 4);
        const f32x4 v = *(const f32x4*)(src + (size_t)kk * d.N);
        LAS float* s = scr + kk * 65 + 4 * (lane & 15);
        s[0] = v[0]; s[1] = v[1]; s[2] = v[2]; s[3] = v[3];
    }
    asm volatile("s_waitcnt lgkmcnt(0)" ::: "memory");
    const int c = lane & 7;
#pragma unroll
    for (int j = 0; j < 8; ++j) {
        const int n = (lane >> 3) + 8 * j;
        LAS const float* s = scr + (8 * c) * 65 + n;
        u32x4 o; o.x = pk2(s[0], s[65]); o.y = pk2(s[2 * 65], s[3 * 65]); o.z = pk2(s[4 * 65], s[5 * 65]); o.w = pk2(s[6 * 65], s[7 * 65]);
        const int ns = n0 + n;
        int drow = ns;
        if (d.mode == 1) { const int jj = ns < DFF ? ns : ns - DFF; drow = ((jj >> 4) << 5) + (ns < DFF ? 0 : 16) + (jj & 15); }
        *(u32x4*)(d.dst + (size_t)drow * d.K + k0 + 8 * c) = o;
    }
    asm volatile("s_waitcnt lgkmcnt(0)" ::: "memory");
}
DI void convert_items(const Frame& F, const Args& a, int i0, int i1, int gw, int ngw) {
    LAS float* scr = (LAS float*)(F.lds + F.wave * 16640);
    for (int it = i0 + gw; it < i1; it += ngw) {
        int m = 0;
#pragma unroll 1
        for (int q = 1; q < NWD; ++q) if (it >= a.wd[q].item0) m = q;
        tr_item(a.wd[m], it - a.wd[m].item0, scr, F.lane);
    }
}
constexpr int CC_PER0 = 124 * 512, CC_PER1 = 508 * 512, CC_PER2 = 2044 * 512, CC_T0 = 16 * CC_PER0, CC_T1 = CC_T0 + 16 * CC_PER1, CC_TOT = CC_T1 + 16 * CC_PER2;
DI void cache_copy(const Args& a, int f0, int f1, int gt, int nt) {
    for (int i = f0 + gt; i < f1; i += nt) {
        const int g = i < CC_T0 ? 0 : i < CC_T1 ? 1 : 2;
        const int li = i - (g == 0 ? 0 : g == 1 ? CC_T0 : CC_T1), per = g == 0 ? CC_PER0 : g == 1 ? CC_PER1 : CC_PER2, wb = 128 << (2 * g);
        const int blk = li / per, o = li - blk * per;
        const float* src = g == 0 ? a.in[2] : g == 1 ? a.in[3] : a.in[4];
        float* dst = a.out + (g == 0 ? O_A128S : g == 1 ? O_A512S : O_A2048S);
        const size_t base = (size_t)blk * wb * 2048;
        *(f32x4*)(dst + base + (size_t)o * 4) = *(const f32x4*)(src + base + 8192 + (size_t)o * 4);
    }
}
DI void bg_slot(const Frame& F, const Args& a, int k, int first) {
    if (F.bid < first || F.G <= first) return;
    convert_items(F, a, a.slot[k][0], a.slot[k][1], (F.bid - first) * NWAVES + F.wave, (F.G - first) * NWAVES);
}
DI void prologue(const Frame& F, const Args& a) {
    uchar* ws = a.ws;
    convert_items(F, a, a.slot[0][0], a.slot[0][1], F.gw, F.NGW);
    const int gt = F.gw * 64 + F.lane, NT = F.NGW * 64;
    {
        float* rope = (float*)(ws + WS_ROPE);
        for (int i = gt; i < 4100 * 16; i += NT) {
            const int pidx = i >> 4, f = i & 15;
            const int pos = pidx < TP ? pidx : PASTLEN + (pidx - TP);
            const float inv = (float)exp2(-(double)f * (18.931568569324174 / 16.0));
            const float ang = (float)pos * inv;
            const double rev = (double)ang * 0.15915494309189535;
            const float fr = (float)(rev - floor(rev));
            rope[(size_t)pidx * 32 + f] = __builtin_amdgcn_cosf(fr);
            rope[(size_t)pidx * 32 + 16 + f] = __builtin_amdgcn_sinf(fr);
        }
    }
    { f32x4* z = (f32x4*)(ws + WS_ZS); const f32x4 zz = {0.f, 0.f, 0.f, 0.f}; for (int i = gt; i < (int)(12 * ZS_ONE / 16); i += NT) z[i] = zz; }
    {
        bf16* XB = (bf16*)(ws + WS_XB);
        for (int i = gt; i < MALL * DM / 4; i += NT) {
            const size_t e = (size_t)i * 4;
            const f32x4 v = e < (size_t)MP * DM ? *(const f32x4*)(a.in[0] + e) : *(const f32x4*)(a.in[1] + (e - (size_t)MP * DM));
            *(u32x2*)(XB + e) = pk4(v);
        }
    }
}

DI void ln_phase(const Frame& F, const float* Zp, const float* Zs, const float* g, const float* b, float* Xf  , bf16* XB) {
    f32x4 gv[8], bv[8];
#pragma unroll
    for (int j = 0; j < 8; ++j) { gv[j] = *(const f32x4*)(g + 4 * F.lane + 256 * j); bv[j] = *(const f32x4*)(b + 4 * F.lane + 256 * j); }
    for (int row = F.gw; row < MALL; row += F.NGW) {
        const float* z = row < MP ? Zp + (size_t)row * DM : Zs + (size_t)(row - MP) * DM;
        f32x4 v[8]; float s = 0.f;
#pragma unroll
        for (int j = 0; j < 8; ++j) { v[j] = *(const f32x4*)(z + 4 * F.lane + 256 * j); s += (v[j][0] + v[j][1]) + (v[j][2] + v[j][3]); }
        const float mean = wave_sum(s) * (1.f / DM); float s2 = 0.f;
#pragma unroll
        for (int j = 0; j < 8; ++j) { v[j] = v[j] - mean; s2 += (v[j][0] * v[j][0] + v[j][1] * v[j][1]) + (v[j][2] * v[j][2] + v[j][3] * v[j][3]); }
        const float rstd = 1.f / sqrtf(wave_sum(s2) * (1.f / DM) + LN_EPS);
        bf16* xb = XB + (size_t)row * DM + 4 * F.lane;
#pragma unroll
        for (int j = 0; j < 8; ++j) { const f32x4 y = v[j] * rstd * gv[j] + bv[j]; *(u32x2*)(xb + 256 * j) = pk4(y); if (Xf) *(f32x4*)(Xf + (size_t)row * DM + 4 * F.lane + 256 * j) = y; }
    }
}
DI void attn_prompt_unit(const Frame& F, int u, const bf16* QKV, bf16* OG, float* LSE, bf16* O) {
    const int b = u >> 7, hd = (u >> 4) & 7, ck = u & 15;
    const int lane = F.lane, w = F.wave, qi = lane & 31, h = lane >> 5;
    constexpr int LDV = 272;
    LAS uchar* Vl = F.lds + w * (64 * LDV); LAS uchar* Kl = Vl + 32 * LDV;
    const float SC = 0.08838834764831845f * 1.4426950408889634f;
    for (int it = 0; it < 4; ++it) {
        const int tl = w + 8 * it, g = tl < 8 ? 0 : tl < 16 ? 1 : 2, idx = tl < 16 ? (tl & 7) : tl - 16;
        const int dil = 1 << (2 * g);
        int r, Lb, nq = 32;
        if (g == 0) { r = 0; Lb = ck * 256 + 32 * idx; } else if (g == 1) { r = idx & 3; Lb = ck * 64 + 32 * (idx >> 2); } else { r = idx; Lb = ck * 16; nq = 16; }
        const int qv = qi < nq ? qi : nq - 1;
        const int rowb = b * TP;
        const int colQ = g * 1024 + hd * 128, colK = 3072 + colQ, colV = 6144 + colQ;
        bf16x8 qf[8];
        {
            const unsigned qo = (unsigned)(((rowb + r + dil * (Lb + qv)) * AQKV + colQ + 8 * h) * 2);
#pragma unroll
            for (int s = 0; s < 8; ++s) qf[s] = ldg<bf16x8>(QKV, qo + 32 * s);
        }
        f32x16 st[5];
#pragma unroll
        for (int kb = 0; kb < 5; ++kb) {
#pragma unroll
            for (int i = 0; i < 8; ++i) {
                const int cid = lane + 64 * i, key = cid >> 4, ch = cid & 15;
                int Lk = Lb - 128 + 32 * kb + key; if (Lk < 0) Lk = 0; if (Lk > Lb + nq - 1) Lk = Lb + nq - 1;
                const u32x4 v = ldg<u32x4>(QKV, (unsigned)(((rowb + r + dil * Lk) * AQKV + colK + 8 * ch) * 2));
                *(LAS u32x4*)(Kl + key * LDV + ch * 16) = v;
            }
            f32x16 acc = zero16();
#pragma unroll
            for (int s = 0; s < 8; ++s) { const bf16x8 kf = frag_xk(Kl, LDV, 0, 16 * s, lane); acc = MFMA32(kf, qf[s], acc); }
            st[kb] = acc;
        }
        float m = -INFINITY;
        {
            int lo = qv; if (128 - Lb > lo) lo = 128 - Lb;
            const int a0 = 4 * h - lo, b0 = 128 + qv - 4 * h;
#pragma unroll
            for (int kb = 0; kb < 5; ++kb)
#pragma unroll
                for (int i = 0; i < 16; ++i) {
                    const int cst = 32 * kb + (i & 3) + 8 * (i >> 2);
                    const unsigned msk = (unsigned)(((a0 + cst) | (b0 - cst)) >> 31);
                    const unsigned xb = __float_as_uint(st[kb][i] * SC);
                    const float sv = __uint_as_float((xb & ~msk) | (0xff800000u & msk));
                    st[kb][i] = sv; m = fmaxf(m, sv);
                }
        }
        m = fmaxf(m, __shfl_xor(m, 32));
        float l = 0.f;
#pragma unroll
        for (int kb = 0; kb < 5; ++kb)
#pragma unroll
            for (int i = 0; i < 16; ++i) { const float p = exp2f(st[kb][i] - m); st[kb][i] = p; l += p; }
        l += __shfl_xor(l, 32);
        f32x16 ot[4];
#pragma unroll
        for (int c = 0; c < 4; ++c) ot[c] = zero16();
#pragma unroll
        for (int kb = 0; kb < 5; ++kb) {
#pragma unroll
            for (int i = 0; i < 8; ++i) {
                const int cid = lane + 64 * i, key = cid >> 4, ch = cid & 15;
                int Lk = Lb - 128 + 32 * kb + key; if (Lk < 0) Lk = 0; if (Lk > Lb + nq - 1) Lk = Lb + nq - 1;
                const u32x4 v = ldg<u32x4>(QKV, (unsigned)(((rowb + r + dil * Lk) * AQKV + colV + 8 * ch) * 2));
                *(LAS u32x4*)(Vl + key * LDV + ch * 16) = v;
            }
#pragma unroll
            for (int s = 0; s < 2; ++s) {
                const bf16x8 pb = pack_step(st[kb], s);
#pragma unroll
                for (int c = 0; c < 4; ++c) { const bf16x8 af = frag_kx_perm(Vl, LDV, 32 * c, 16 * s, lane); ot[c] = MFMA32(af, pb, ot[c]); }
            }
        }
        const float rl = 1.f / l;
        const int orow = rowb + r + dil * (Lb + qv);
        if (qi < nq) {
        const unsigned oo = (unsigned)((((g * MP + orow) * 1024) + hd * 128 + 4 * h) * 2);
#pragma unroll
        for (int c = 0; c < 4; ++c)
#pragma unroll
            for (int gq = 0; gq < 4; ++gq) {
                f32x4 v = {ot[c][4 * gq] * rl, ot[c][4 * gq + 1] * rl, ot[c][4 * gq + 2] * rl, ot[c][4 * gq + 3] * rl};
                stg<u32x2>(OG, oo + (32 * c + 8 * gq) * 2, pk4(v));
            }
        if (h == 0) stg<float>(LSE, (unsigned)(((g * MP + orow) * 8 + hd) * 4), (m + log2f(l)) * 0.6931471805599453f);
        }
    }
    asm volatile("s_waitcnt vmcnt(0)" ::: "memory");
    __syncthreads();
    __builtin_amdgcn_fence(__ATOMIC_ACQUIRE, "agent");
    const int l16 = F.tid & 15;
#pragma unroll 2
    for (int it = 0; it < 8; ++it) {
        const int tok = ck * 256 + (F.tid >> 4) + 32 * it;
        const int row = b * TP + tok;
        const float l0 = ldg<float>(LSE, (unsigned)((row * 8 + hd) * 4)), l1 = ldg<float>(LSE, (unsigned)(((MP + row) * 8 + hd) * 4)), l2 = ldg<float>(LSE, (unsigned)(((2 * MP + row) * 8 + hd) * 4));
        const float mx = fmaxf(l0, fmaxf(l1, l2));
        float w0 = __expf(l0 - mx), w1 = __expf(l1 - mx), w2 = __expf(l2 - mx);
        const float ws = 1.f / (w0 + w1 + w2); w0 *= ws; w1 *= ws; w2 *= ws;
        const unsigned off = (unsigned)((row * 1024 + hd * 128 + 8 * l16) * 2);
        const u32x4 a0 = ldg<u32x4>(OG, off), a1 = ldg<u32x4>(OG, off + MP * 1024 * 2), a2 = ldg<u32x4>(OG, off + 2 * MP * 1024 * 2);
        u32x4 o;
#pragma unroll
        for (int e = 0; e < 4; ++e)
            o[e] = pk2(w0 * bflo(a0[e]) + w1 * bflo(a1[e]) + w2 * bflo(a2[e]), w0 * bfhi(a0[e]) + w1 * bfhi(a1[e]) + w2 * bfhi(a2[e]));
        stg<u32x4>(O, off, o);
    }
    __syncthreads();
}

DI void attn_sample_unit(const Frame& F, int su, const float* QKVS, const float* cache0, const float* cache1, const float* cache2, int j, bf16* O) {
    const int b = su >> 5, hd = (su >> 2) & 7, t = su & 3;
    const int lane = F.lane, w = F.wave, l32 = lane & 31, hw = lane >> 5;
    LAS float* sc = (LAS float*)F.lds;
    LAS float* part = (LAS float*)(F.lds + 4096);
    if (w < 6) {
        const int g = w >> 1, half = w & 1, dil = 1 << (2 * g), wb = 128 << (2 * g);
        const int j0 = half * 65, cnt = half ? 64 : 65;
        const float* cg = (g == 0 ? cache0 : g == 1 ? cache1 : cache2) + ((size_t)(j * 8 + b) * wb) * 2048 + hd * 128 + 4 * l32;
        const float* qn = QKVS + (size_t)(b * 4) * AQKV + g * 1024 + hd * 128 + 4 * l32;
        const f32x4 q4 = *(const f32x4*)(qn + (size_t)t * AQKV);
#pragma unroll 11
        for (int it = 0; it < 33; ++it) {
            const int jl = 2 * it + hw;
            float s = 0.f;
            if (jl < cnt) {
                const int idx = wb + t - dil * (j0 + jl);
                const float* kp = idx >= wb ? qn + (size_t)(idx - wb) * AQKV + 3072 : cg + (size_t)idx * 2048;
                const f32x4 k4 = *(const f32x4*)kp;
                s = q4[0] * k4[0] + q4[1] * k4[1] + q4[2] * k4[2] + q4[3] * k4[3];
            }
#pragma unroll
            for (int o = 1; o < 32; o <<= 1) s += __shfl_xor(s, o);
            if (l32 == 0 && jl < cnt) sc[w * 80 + jl] = s * 0.08838834764831845f;
        }
        asm volatile("s_waitcnt lgkmcnt(0)" ::: "memory");
        float m = lane < cnt ? sc[w * 80 + lane] : -INFINITY;
        if (lane == 0 && cnt == 65) m = fmaxf(m, sc[w * 80 + 64]);
        m = wave_max(m);
        float lsum = 0.f; f32x4 acc = {0.f, 0.f, 0.f, 0.f};
#pragma unroll 11
        for (int it = 0; it < 33; ++it) {
            const int jl = 2 * it + hw;
            if (jl < cnt) {
                const int idx = wb + t - dil * (j0 + jl);
                const float* vp = idx >= wb ? qn + (size_t)(idx - wb) * AQKV + 6144 : cg + (size_t)idx * 2048 + 1024;
                const f32x4 v4 = *(const f32x4*)vp;
                const float p = __expf(sc[w * 80 + jl] - m);
                lsum += p; acc += v4 * p;
            }
        }
        lsum += __shfl_xor(lsum, 32);
#pragma unroll
        for (int e = 0; e < 4; ++e) acc[e] += __shfl_xor(acc[e], 32);
        if (lane == 0) { part[w * 136] = m; part[w * 136 + 1] = lsum; }
        if (lane < 32) *(LAS f32x4*)(part + w * 136 + 8 + 4 * l32) = acc;
    }
    __syncthreads();
    if (w == 0 && lane < 32) {
        float M = -INFINITY;
#pragma unroll
        for (int ww = 0; ww < 6; ++ww) M = fmaxf(M, part[ww * 136]);
        float L = 0.f; f32x4 o = {0.f, 0.f, 0.f, 0.f};
#pragma unroll
        for (int ww = 0; ww < 6; ++ww) { const float e = __expf(part[ww * 136] - M); L += part[ww * 136 + 1] * e; o += *(LAS const f32x4*)(part + ww * 136 + 8 + 4 * l32) * e; }
        o = o * (1.f / L);
        *(u32x2*)(O + (size_t)(MP + b * 4 + t) * 1024 + hd * 128 + 4 * l32) = pk4(o);
    }
    __syncthreads();
}
struct BPtrs {
    const bf16* PB; const float* EB; const float* PBS; bf16 *WG, *UG, *QG, *KG, *QKG; float* GCG; bf16* YB; bf16 *SG, *VNG;
    const float *conv_w, *a_log, *dt_bias, *norm_w, *ssm0, *conv0;
    float *ssm_p, *ssm_s, *conv_p, *conv_s;
};
DI void bprep_unit(const Frame& F, int pu, const BPtrs& P) {
    const int b = pu >> 10, n = (pu >> 4) & 63, hq = pu & 15;
    int lane = F.lane, tid = F.tid; asm volatile("" : "+v"(lane), "+v"(tid));
    const int w = F.wave, t0 = n * 64;
    constexpr int LD = 272, LDT = 144;
    LAS uchar* Kl = F.lds; LAS uchar* V0l = F.lds + 17408; LAS uchar* V1l = F.lds + 34816; LAS uchar* Ql = F.lds + 52224;
    LAS float* Gkk = (LAS float*)(F.lds + 69632); LAS float* Gqk = (LAS float*)(F.lds + 86016);
    LAS float* LT = (LAS float*)(F.lds + 102400);
    LAS uchar* Tb = F.lds + 52224;
    LAS float* betaL = (LAS float*)(F.lds + 135168); LAS float* gcL = betaL + 128; LAS float* egL = gcL + 128;
    for (int it = 0; it < 8; ++it) {
        const int task = w + 8 * it, mt = task >> 4, rg = task & 15;
        const int i = 4 * rg + (lane >> 4), ch = lane & 15, t = t0 + i;
        const int cb = mt == 0 ? hq * 128 : mt == 1 ? 2048 + hq * 128 : 4096 + (2 * hq + (mt - 2)) * 128;
        const int col = cb + 8 * ch;
        float y[8];
#pragma unroll
        for (int e = 0; e < 8; ++e) y[e] = 0.f;
#pragma unroll
        for (int jj = 0; jj < 4; ++jj) {
            const int tt = t - 3 + jj;
            u32x4 x = {0u, 0u, 0u, 0u};
            if (tt >= 0) x = ldg<u32x4>(P.PB, (unsigned)(((b * TP + tt) * BINM + col) * 2));
            const f32x4 w0 = ldg<f32x4>(P.conv_w, (unsigned)((jj * 8192 + col) * 4)), w1 = ldg<f32x4>(P.conv_w, (unsigned)((jj * 8192 + col + 4) * 4));
            y[0] += bflo(x[0]) * w0[0]; y[1] += bfhi(x[0]) * w0[1]; y[2] += bflo(x[1]) * w0[2]; y[3] += bfhi(x[1]) * w0[3];
            y[4] += bflo(x[2]) * w1[0]; y[5] += bfhi(x[2]) * w1[1]; y[6] += bflo(x[3]) * w1[2]; y[7] += bfhi(x[3]) * w1[3];
        }
        float ss = 0.f;
#pragma unroll
        for (int e = 0; e < 8; ++e) { y[e] = silu_f(y[e]); ss += y[e] * y[e]; }
        if (mt < 2) {
#pragma unroll
            for (int o = 1; o < 16; o <<= 1) ss += __shfl_xor(ss, o);
            const float rn = rsqrtf(ss + 1e-6f) * (mt == 0 ? 0.08838834764831845f : 1.f);
#pragma unroll
            for (int e = 0; e < 8; ++e) y[e] *= rn;
        }
        u32x4 o; o.x = pk2(y[0], y[1]); o.y = pk2(y[2], y[3]); o.z = pk2(y[4], y[5]); o.w = pk2(y[6], y[7]);
        LAS uchar* dst = mt == 0 ? Ql : mt == 1 ? Kl : mt == 2 ? V0l : V1l;
        *(LAS u32x4*)(dst + i * LD + ch * 16) = o;
        if (mt == 0) stg<u32x4>(P.QG, (unsigned)((((b * 16 + hq) * TP + t) * 128 + 8 * ch) * 2), o);
        if (mt == 1) stg<u32x4>(P.KG, (unsigned)((((b * 16 + hq) * TP + t) * 128 + 8 * ch) * 2), o);
    }
    __syncthreads();
    {
        const int which = w >> 2, ti = (w >> 1) & 1, tj = w & 1;
        f32x16 acc = mm_tile<false, false>(zero16(), which ? Ql : Kl, LD, 32 * ti, Kl, LD, 32 * tj, 8, lane);
        LAS float* G = which ? Gqk : Gkk;
#pragma unroll
        for (int i = 0; i < 16; ++i) G[(32 * ti + crow(i, lane >> 5)) * 64 + 32 * tj + (lane & 31)] = acc[i];
    }
    if (w < 2) {
        const int hv = 2 * hq + w, t = t0 + lane;
        const float braw = ldg<float>(P.EB, (unsigned)(((b * TP + t) * 64 + hv) * 4)), araw = ldg<float>(P.EB, (unsigned)(((b * TP + t) * 64 + 32 + hv) * 4));
        const float beta = sigmoid_f(braw);
        float gc = -__expf(P.a_log[hv]) * softplus_f(araw + P.dt_bias[hv]);
#pragma unroll
        for (int o = 1; o < 64; o <<= 1) { const float v = __shfl_up(gc, o); if (lane >= o) gc += v; }
        betaL[w * 64 + lane] = beta; gcL[w * 64 + lane] = gc; egL[w * 64 + lane] = __expf(gc);
        stg<float>(P.GCG, (unsigned)(((b * 32 + hv) * TP + t) * 4), gc);
    }
    __syncthreads();
#pragma unroll 1
    for (int hvl = 0; hvl < 2; ++hvl) {
        const int hv = 2 * hq + hvl;
        for (int idx = tid; idx < 4096; idx += 512) {
            const int r = idx >> 6, c = idx & 63;
            const float gj = gcL[hvl * 64 + c], gr = gcL[hvl * 64 + r];
            LT[(hvl * 64 + r) * 64 + c] = (c > r) ? betaL[hvl * 64 + c] * Gkk[c * 64 + r] * __expf(gj - gr) : 0.f;
            const float qv = (r >= c) ? Gqk[r * 64 + c] * __expf(gr - gj) : 0.f;
            stg<bf16>(P.QKG, (unsigned)((((((b * 32 + hv) * 64 + n) * 64 + r) * 64) + c) * 2), (bf16)(pk2(qv, 0.f) & 0xffffu));
        }
    }
    __syncthreads();
    asm volatile("" : "+v"(lane), "+v"(tid));
    if (w < 2) {
        float t[64];
#pragma unroll
        for (int c = 0; c < 64; ++c) t[c] = 0.f;
        unsigned lt_a = (unsigned)(size_t)(LT + w * 4096), be_a = (unsigned)(size_t)(betaL + w * 64), eg_a = (unsigned)(size_t)(egL + w * 64);
        asm volatile("" : "+v"(lt_a), "+v"(be_a), "+v"(eg_a));
        LAS const float* lt = (LAS const float*)(size_t)lt_a; LAS const float* bel = (LAS const float*)(size_t)be_a; LAS const float* egl = (LAS const float*)(size_t)eg_a;
#pragma unroll
        for (int c = 63; c >= 0; --c) {
            asm volatile("" ::: "memory");
            float a0 = (lane == c) ? 1.f : 0.f, a1 = 0.f, a2 = 0.f, a3 = 0.f;
#pragma unroll
            for (int jb = (c + 1) >> 2; jb < 16; ++jb) {
                const f32x4 l4 = *(LAS const f32x4*)(lt + c * 64 + 4 * jb);
                a0 -= t[4 * jb] * l4[0]; a1 -= t[4 * jb + 1] * l4[1]; a2 -= t[4 * jb + 2] * l4[2]; a3 -= t[4 * jb + 3] * l4[3];
            }
            float acc = (a0 + a1) + (a2 + a3);
            asm volatile("" : "+v"(acc) :: "memory");
            t[c] = acc;
        }
        LAS uchar* tb0 = Tb + (w * 2 + 0) * (64 * LDT) + lane * LDT; LAS uchar* tb1 = Tb + (w * 2 + 1) * (64 * LDT) + lane * LDT;
#pragma unroll
        for (int q = 0; q < 8; ++q) {
            float a[8], c2[8];
            const f32x4 b0 = *(LAS const f32x4*)(bel + 8 * q), b1 = *(LAS const f32x4*)(bel + 8 * q + 4), e0 = *(LAS const f32x4*)(egl + 8 * q), e1 = *(LAS const f32x4*)(egl + 8 * q + 4);
#pragma unroll
            for (int e = 0; e < 4; ++e) { a[e] = t[8 * q + e] * b0[e]; c2[e] = a[e] * e0[e]; a[4 + e] = t[8 * q + 4 + e] * b1[e]; c2[4 + e] = a[4 + e] * e1[e]; }
            u32x4 o0, o1; o0.x = pk2(a[0], a[1]); o0.y = pk2(a[2], a[3]); o0.z = pk2(a[4], a[5]); o0.w = pk2(a[6], a[7]);
            o1.x = pk2(c2[0], c2[1]); o1.y = pk2(c2[2], c2[3]); o1.z = pk2(c2[4], c2[5]); o1.w = pk2(c2[6], c2[7]);
            *(LAS u32x4*)(tb0 + 16 * q) = o0; *(LAS u32x4*)(tb1 + 16 * q) = o1;
        }
    }
    __syncthreads();
    asm volatile("" : "+v"(lane), "+v"(tid));
    {
        const int hvl = w >> 2, hv = 2 * hq + hvl;
#pragma unroll 1
        for (int tt = 0; tt < 4; ++tt) {
            const int id = (w & 3) * 4 + tt, which = id >> 3, ti = (id >> 2) & 1, c = id & 3;
            f32x16 acc = mm_tile<false, true>(zero16(), Tb + (hvl * 2 + which) * (64 * LDT), LDT, 32 * ti, which ? Kl : (hvl ? V1l : V0l), LD, 32 * c, 4, lane);
            bf16* dstb = which ? P.WG : P.UG;
            const unsigned dof = (unsigned)(((((b * 32 + hv) * TP + t0 + 32 * ti + 4 * (lane >> 5)) * 128) + 32 * c + (lane & 31)) * 2);
#pragma unroll
            for (int i = 0; i < 16; ++i) stg<bf16>(dstb, dof + ((i & 3) + 8 * (i >> 2)) * 256, (bf16)(pk2(acc[i], 0.f) & 0xffffu));
        }
    }
    __syncthreads();
}
DI void bchain_unit(const Frame& F, int cu, const BPtrs& P) {
    const int b = cu >> 5, hv = cu & 31, hq = hv >> 1;
    const int lane = F.lane, w = F.wave, tid_ = F.tid, tid = tid_, h = lane >> 5, l32 = lane & 31;
    constexpr int LD = 272, LDS_ = 320;
    LAS uchar* Wl = F.lds; LAS uchar* Kl = F.lds + 17408;
    LAS uchar* Sb = F.lds + 37888; LAS uchar* VNl = F.lds + 78848; LAS uchar* VNd = F.lds + 99328;
    LAS float* gcL = (LAS float*)(F.lds + 119808);
    const bf16* wg = P.WG + ((size_t)b * 32 + hv) * TP * 128; const bf16* ug = P.UG + ((size_t)b * 32 + hv) * TP * 128;
    const bf16* kg = P.KG + ((size_t)b * 16 + hq) * TP * 128; const float* gcg = P.GCG + ((size_t)b * 32 + hv) * TP;
    bf16* sg = P.SG + ((size_t)b * 32 + hv) * 64 * 16384; bf16* vng = P.VNG + ((size_t)b * 32 + hv) * TP * 128;
    const int kb = w & 3, c0 = 2 * (w >> 2);
    f32x16 S0 = zero16(), S1 = zero16();
    for (int i = tid; i < 128 * LDS_ / 4; i += 512) ((LAS unsigned*)Sb)[i] = 0u;
    const int ti = w >> 2, tc = w & 3;
    u32x4 pw[2], pk[2]; float pg = 0.f;
    {
#pragma unroll
        for (int k = 0; k < 2; ++k) { const unsigned go = (unsigned)((tid + 512 * k) * 16); pw[k] = ldg<u32x4>(wg, go); pk[k] = ldg<u32x4>(kg, go); }
        if (tid < 64) pg = ldg<float>(gcg, (unsigned)(tid * 4));
    }
#pragma unroll 1
    for (int n = 0; n < 64; ++n) {
        const int t0 = n * 64;
        int tid = tid_; asm volatile("" : "+v"(tid));
        const int lane = tid & 63, h = lane >> 5, l32 = lane & 31;
#pragma unroll
        for (int k = 0; k < 2; ++k) {
            const int cid = tid + 512 * k, r = cid >> 4, ch = cid & 15;
            *(LAS u32x4*)(Wl + r * LD + ch * 16) = pw[k]; *(LAS u32x4*)(Kl + r * LDS_ + ch * 16) = pk[k];
        }
        if (tid < 64) gcL[tid] = pg;
        LDS_BARRIER();
        if (n < 63) {
            const unsigned nx = (unsigned)((t0 + 64) * 256);
#pragma unroll
            for (int k = 0; k < 2; ++k) { const unsigned go = nx + (unsigned)((tid + 512 * k) * 16); pw[k] = ldg<u32x4>(wg, go); pk[k] = ldg<u32x4>(kg, go); }
            if (tid < 64) pg = ldg<float>(gcg, (unsigned)((t0 + 64 + tid) * 4));
        }
        const float glast = gcL[63];
        float uu[16];
        {
            const char* upb = (const char*)(ug + (size_t)(t0 + 32 * ti) * 128 + 32 * tc);
            const unsigned uo = (unsigned)((4 * h * 128 + l32) * 2);
#pragma unroll
            for (int i = 0; i < 16; ++i) uu[i] = bf2f(*(const bf16*)(upb + uo + (unsigned)(((i & 3) + 8 * (i >> 2)) * 256)));
        }
#pragma unroll
        for (int k = 0; k < 4; ++k) { const int cid = tid + 512 * k, r = cid >> 4, ch = cid & 15; stg<u32x4>(sg, (unsigned)(n * 32768 + cid * 16), *(LAS const u32x4*)(Sb + r * LDS_ + ch * 16)); }
        f32x16 vn = mm_tile<false, true>(zero16(), Wl, LD, 32 * ti, Sb, LDS_, 32 * tc, 8, lane);
        {
#pragma unroll
            for (int i = 0; i < 16; ++i) {
                const int r = crow(i, h);
                const float v = uu[i] - vn[i];
                const float vd = v * __expf(glast - gcL[32 * ti + r]);
                *(LAS bf16*)(VNl + (32 * ti + r) * LDS_ + (32 * tc + l32) * 2) = (bf16)(pk2(v, 0.f) & 0xffffu);
                *(LAS bf16*)(VNd + (32 * ti + r) * LDS_ + (32 * tc + l32) * 2) = (bf16)(pk2(vd, 0.f) & 0xffffu);
            }
        }
        LDS_BARRIER();
#pragma unroll
        for (int k = 0; k < 2; ++k) { const int cid = tid + 512 * k, r = cid >> 4, ch = cid & 15; stg<u32x4>(vng, (unsigned)(t0 * 256 + cid * 16), *(LAS const u32x4*)(VNl + r * LDS_ + ch * 16)); }
        {
            const float el = __expf(glast);
#pragma unroll
            for (int i = 0; i < 16; ++i) { S0[i] *= el; S1[i] *= el; }
            S0 = mm_tile<true, true>(S0, Kl, LDS_, 32 * kb, VNd, LDS_, 32 * c0, 4, lane);
            S1 = mm_tile<true, true>(S1, Kl, LDS_, 32 * kb, VNd, LDS_, 32 * (c0 + 1), 4, lane);
        }
        LDS_BARRIER();
#pragma unroll
        for (int i = 0; i < 16; ++i) {
            const int r = 32 * kb + crow(i, h);
            *(LAS bf16*)(Sb + r * LDS_ + (32 * c0 + l32) * 2) = (bf16)(pk2(S0[i], 0.f) & 0xffffu);
            *(LAS bf16*)(Sb + r * LDS_ + (32 * (c0 + 1) + l32) * 2) = (bf16)(pk2(S1[i], 0.f) & 0xffffu);
        }
    }
    {
        float* sp = P.ssm_p + ((size_t)b * 32 + hv) * 16384;
#pragma unroll
        for (int i = 0; i < 16; ++i) {
            const int r = 32 * kb + crow(i, h);
            sp[r * 128 + 32 * c0 + l32] = S0[i]; sp[r * 128 + 32 * (c0 + 1) + l32] = S1[i];
        }
    }
    __syncthreads();
}
DI void bout_unit(const Frame& F, int item, const BPtrs& P) {
    const int b = item >> 11, hv = (item >> 6) & 31, n = item & 63, hq = hv >> 1, t0 = n * 64;
    int tid = F.tid; asm volatile("" : "+v"(tid));
    const int lane = tid & 63, w = F.wave, h = lane >> 5, l32 = lane & 31;
    constexpr int LD = 272, LDS_ = 320, LDQ = 144, LDO = 528;
    LAS uchar* Ql = F.lds; LAS uchar* QKl = F.lds + 17408; LAS uchar* Sl = F.lds + 26624; LAS uchar* VNl = F.lds + 67584;
    LAS uchar* Ol = F.lds + 88064;
    LAS float* egL = (LAS float*)(F.lds + 121856);
    {
        const bf16* qg = P.QG + (((size_t)b * 16 + hq) * TP + t0) * 128; const bf16* vng = P.VNG + (((size_t)b * 32 + hv) * TP + t0) * 128;
        const bf16* sg = P.SG + (((size_t)b * 32 + hv) * 64 + n) * 16384; const bf16* qkg = P.QKG + (((size_t)b * 32 + hv) * 64 + n) * 4096;
#pragma unroll
        for (int k = 0; k < 2; ++k) {
            const int cid = tid + 512 * k, r = cid >> 4, ch = cid & 15;
            *(LAS u32x4*)(Ql + r * LD + ch * 16) = ldg<u32x4>(qg, (unsigned)(cid * 16)); *(LAS u32x4*)(VNl + r * LDS_ + ch * 16) = ldg<u32x4>(vng, (unsigned)(cid * 16));
        }
#pragma unroll
        for (int k = 0; k < 4; ++k) { const int cid = tid + 512 * k, r = cid >> 4, ch = cid & 15; *(LAS u32x4*)(Sl + r * LDS_ + ch * 16) = ldg<u32x4>(sg, (unsigned)(cid * 16)); }
        { const int r = tid >> 3, ch = tid & 7; *(LAS u32x4*)(QKl + r * LDQ + ch * 16) = ldg<u32x4>(qkg, (unsigned)(tid * 16)); }
        if (tid < 64) egL[tid] = __expf(ldg<float>(P.GCG, (unsigned)((((b * 32 + hv) * TP) + t0 + tid) * 4)));
    }
    u32x4 z0, z1;
    {
        const int r = tid >> 3, part = tid & 7;
        z0 = ldg<u32x4>(P.PB, (unsigned)((((b * TP + t0 + r) * BINM) + 8192 + hv * 128 + 16 * part) * 2)); z1 = ldg<u32x4>(P.PB, (unsigned)((((b * TP + t0 + r) * BINM) + 8192 + hv * 128 + 16 * part + 8) * 2));
    }
    __syncthreads();
    {
        const int ti = w >> 2, tc = w & 3;
        f32x16 o = mm_tile<false, true>(zero16(), Ql, LD, 32 * ti, Sl, LDS_, 32 * tc, 8, lane);
#pragma unroll
        for (int i = 0; i < 16; ++i) o[i] *= egL[32 * ti + crow(i, h)];
        o = mm_tile<false, true>(o, QKl, LDQ, 32 * ti, VNl, LDS_, 32 * tc, 4, lane);
#pragma unroll
        for (int i = 0; i < 16; ++i) *(LAS float*)(Ol + (32 * ti + crow(i, h)) * LDO + (32 * tc + l32) * 4) = o[i];
    }
    __syncthreads();
    {
        const int r = tid >> 3, part = tid & 7;
        float ov[16]; float ss = 0.f;
#pragma unroll
        for (int q = 0; q < 4; ++q) { const f32x4 v = *(LAS const f32x4*)(Ol + r * LDO + (16 * part + 4 * q) * 4); ov[4 * q] = v[0]; ov[4 * q + 1] = v[1]; ov[4 * q + 2] = v[2]; ov[4 * q + 3] = v[3]; }
#pragma unroll
        for (int e = 0; e < 16; ++e) ss += ov[e] * ov[e];
        ss += __shfl_xor(ss, 1); ss += __shfl_xor(ss, 2); ss += __shfl_xor(ss, 4);
        const float rstd = rsqrtf(ss * (1.f / 128.f) + RMS_EPS);
        float nw[16];
#pragma unroll
        for (int q = 0; q < 4; ++q) { const f32x4 nv = ldg<f32x4>(P.norm_w, (unsigned)((16 * part + 4 * q) * 4)); nw[4 * q] = nv[0]; nw[4 * q + 1] = nv[1]; nw[4 * q + 2] = nv[2]; nw[4 * q + 3] = nv[3]; }
        u32x4 y0, y1;
#pragma unroll
        for (int e = 0; e < 4; ++e) {
            y0[e] = pk2(ov[2 * e] * rstd * nw[2 * e] * silu_f(bflo(z0[e])), ov[2 * e + 1] * rstd * nw[2 * e + 1] * silu_f(bfhi(z0[e])));
            y1[e] = pk2(ov[8 + 2 * e] * rstd * nw[8 + 2 * e] * silu_f(bflo(z1[e])), ov[8 + 2 * e + 1] * rstd * nw[8 + 2 * e + 1] * silu_f(bfhi(z1[e])));
        }
        const unsigned yo = (unsigned)((((b * TP + t0 + r) * 4096) + hv * 128 + 16 * part) * 2);
        stg<u32x4>(P.YB, yo, y0); stg<u32x4>(P.YB, yo + 16, y1);
    }
    __syncthreads();
}
DI void bsample_unit(const Frame& F, int su, const BPtrs& P) {
    const int b = su >> 5, hv = su & 31, hq = hv >> 1;
    const int tid = F.tid, lane = F.lane, w = F.wave, dv = tid & 127, qd = tid >> 7;
    LAS float* raw = (LAS float*)F.lds;
    LAS float* qv = raw + 1536; LAS float* kv = qv + 512; LAS float* vv = kv + 512;
    LAS float* part = vv + 512;
    LAS float* ov = part + 512;
    LAS float* scal = ov + 512;
    float s[32];
    {
        const float* s0 = P.ssm0 + ((size_t)b * 32 + hv) * 16384 + (32 * qd) * 128 + dv;
#pragma unroll
        for (int i = 0; i < 32; ++i) s[i] = s0[i * 128];
    }
    if (tid < 384) {
        const int which = tid >> 7, d = tid & 127;
        const int col = which == 0 ? hq * 128 + d : which == 1 ? 2048 + hq * 128 + d : 4096 + hv * 128 + d;
        float full[7];
#pragma unroll
        for (int r = 0; r < 3; ++r) full[r] = P.conv0[((size_t)b * 3 + r) * 8192 + col];
#pragma unroll
        for (int t = 0; t < 4; ++t) full[3 + t] = P.PBS[(size_t)(b * 4 + t) * BIN + col];
        const float w0 = P.conv_w[col], w1 = P.conv_w[8192 + col], w2 = P.conv_w[2 * 8192 + col], w3 = P.conv_w[3 * 8192 + col];
#pragma unroll
        for (int t = 0; t < 4; ++t) raw[(which * 4 + t) * 128 + d] = silu_f(full[t] * w0 + full[t + 1] * w1 + full[t + 2] * w2 + full[t + 3] * w3);
#pragma unroll
        for (int r = 0; r < 3; ++r) P.conv_s[((size_t)b * 3 + r) * 8192 + col] = full[4 + r];
    }
    if (tid < 4) {
        const float braw = P.PBS[(size_t)(b * 4 + tid) * BIN + 12288 + hv], araw = P.PBS[(size_t)(b * 4 + tid) * BIN + 12320 + hv];
        scal[tid] = sigmoid_f(braw); scal[4 + tid] = __expf(-__expf(P.a_log[hv]) * softplus_f(araw + P.dt_bias[hv]));
    }
    __syncthreads();
    {
        const int which = w >> 2, t = w & 3;
        const float a0 = raw[(which * 4 + t) * 128 + lane], a1 = raw[(which * 4 + t) * 128 + 64 + lane];
        const float rn = rsqrtf(wave_sum(a0 * a0 + a1 * a1) + 1e-6f) * (which == 0 ? 0.08838834764831845f : 1.f);
        LAS float* dst = which == 0 ? qv : kv;
        dst[t * 128 + lane] = a0 * rn; dst[t * 128 + 64 + lane] = a1 * rn;
        vv[tid] = raw[1024 + tid];
    }
    __syncthreads();
    for (int t = 0; t < 4; ++t) {
        const float beta = scal[t], eg = scal[4 + t];
        float p = 0.f;
#pragma unroll
        for (int i = 0; i < 32; ++i) p += kv[t * 128 + 32 * qd + i] * s[i];
        part[qd * 128 + dv] = p;
        __syncthreads();
        const float kS = (part[dv] + part[128 + dv]) + (part[256 + dv] + part[384 + dv]);
        const float vt = vv[t * 128 + dv];
        float po = 0.f;
#pragma unroll
        for (int i = 0; i < 32; ++i) {
            const float kk = kv[t * 128 + 32 * qd + i];
            s[i] = eg * (s[i] - beta * kk * kS) + beta * kk * vt;
            po += s[i] * qv[t * 128 + 32 * qd + i];
        }
        __syncthreads();
        part[qd * 128 + dv] = po;
        __syncthreads();
        if (qd == 0) ov[t * 128 + dv] = (part[dv] + part[128 + dv]) + (part[256 + dv] + part[384 + dv]);
        __syncthreads();
    }
    if (w < 4) {
        const int t = w;
        const float o0 = ov[t * 128 + lane], o1 = ov[t * 128 + 64 + lane];
        const float rstd = rsqrtf(wave_sum(o0 * o0 + o1 * o1) * (1.f / 128.f) + RMS_EPS);
        const float* zp = P.PBS + (size_t)(b * 4 + t) * BIN + 8192 + hv * 128;
        bf16* yp = P.YB + (size_t)(MP + b * 4 + t) * 4096 + hv * 128;
        yp[lane] = (bf16)(pk2(o0 * rstd * P.norm_w[lane] * silu_f(zp[lane]), 0.f) & 0xffffu);
        yp[64 + lane] = (bf16)(pk2(o1 * rstd * P.norm_w[64 + lane] * silu_f(zp[64 + lane]), 0.f) & 0xffffu);
    }
    {
        float* so = P.ssm_s + ((size_t)b * 32 + hv) * 16384 + (32 * qd) * 128 + dv;
#pragma unroll
        for (int i = 0; i < 32; ++i) so[i * 128] = s[i];
    }
    __syncthreads();
}
struct CPtrs {
    const bf16* PC; const float* EC; const float* PCS; float* DT; float* ACS; bf16* XBC; bf16* YC;
    const float *conv_w, *conv_b, *dt_bias, *a_log, *dskip, *norm_w, *ssm0, *conv0;
    float *ssm_p, *ssm_s, *conv_p, *conv_s;
};
DI void cpre_phase(const Frame& F, const CPtrs& P) {
    const int lane = F.lane;
    for (int it = F.gw; it < 1536 + 128; it += F.NGW) {
        if (it < 1536) {
            const int b = it / 768, cg = (it / 64) % 12, rb = it & 63, cc = cg * 512 + 8 * lane, t0 = rb * 64;
            float wt[4][8], bs[8];
#pragma unroll
            for (int jj = 0; jj < 4; ++jj) { const f32x4 w0 = ldg<f32x4>(P.conv_w, (unsigned)((jj * 6144 + cc) * 4)), w1 = ldg<f32x4>(P.conv_w, (unsigned)((jj * 6144 + cc + 4) * 4));
                wt[jj][0] = w0[0]; wt[jj][1] = w0[1]; wt[jj][2] = w0[2]; wt[jj][3] = w0[3]; wt[jj][4] = w1[0]; wt[jj][5] = w1[1]; wt[jj][6] = w1[2]; wt[jj][7] = w1[3]; }
            { const f32x4 b0 = ldg<f32x4>(P.conv_b, (unsigned)(cc * 4)), b1 = ldg<f32x4>(P.conv_b, (unsigned)((cc + 4) * 4)); bs[0] = b0[0]; bs[1] = b0[1]; bs[2] = b0[2]; bs[3] = b0[3]; bs[4] = b1[0]; bs[5] = b1[1]; bs[6] = b1[2]; bs[7] = b1[3]; }
            const unsigned src0 = (unsigned)(((b * TP + t0) * CINM + 4096 + cc) * 2), dst0 = (unsigned)(((b * TP + t0) * 6144 + cc) * 2);
            u32x4 r[19];
#pragma unroll
            for (int q = 0; q < 3; ++q) { r[q] = (u32x4){0u, 0u, 0u, 0u}; if (t0 > 0) r[q] = ldg<u32x4>(P.PC, src0 - (unsigned)((3 - q) * CINM * 2)); }
#pragma unroll 1
            for (int blk = 0; blk < 4; ++blk) {
#pragma unroll
                for (int q = 0; q < 16; ++q) r[3 + q] = ldg<u32x4>(P.PC, src0 + (unsigned)((blk * 16 + q) * CINM * 2));
#pragma unroll
                for (int q = 0; q < 16; ++q) {
                    float y[8];
#pragma unroll
                    for (int e = 0; e < 8; ++e) y[e] = bs[e];
#pragma unroll
                    for (int jj = 0; jj < 4; ++jj) {
                        const u32x4 x = r[q + jj];
                        y[0] += bflo(x[0]) * wt[jj][0]; y[1] += bfhi(x[0]) * wt[jj][1]; y[2] += bflo(x[1]) * wt[jj][2]; y[3] += bfhi(x[1]) * wt[jj][3];
                        y[4] += bflo(x[2]) * wt[jj][4]; y[5] += bfhi(x[2]) * wt[jj][5]; y[6] += bflo(x[3]) * wt[jj][6]; y[7] += bfhi(x[3]) * wt[jj][7];
                    }
#pragma unroll
                    for (int e = 0; e < 8; ++e) y[e] = silu_f(y[e]);
                    u32x4 o; o.x = pk2(y[0], y[1]); o.y = pk2(y[2], y[3]); o.z = pk2(y[4], y[5]); o.w = pk2(y[6], y[7]);
                    stg<u32x4>(P.XBC, dst0 + (unsigned)((blk * 16 + q) * 6144 * 2), o);
                }
                r[0] = r[16]; r[1] = r[17]; r[2] = r[18];
            }
        } else {
            const int id = it - 1536, b = id >> 6, n = id & 63;
            const float a = -__expf(P.a_log[lane]), db = P.dt_bias[lane];
            float acc = 0.f;
            const unsigned o0 = (unsigned)(((b * TP + n * 64) * 64 + lane) * 4);
#pragma unroll 8
            for (int t = 0; t < 64; ++t) {
                const float dt = softplus_f(ldg<float>(P.EC, o0 + t * 256) + db);
                acc += dt * a;
                stg<float>(P.DT, o0 + t * 256, dt); stg<float>(P.ACS, o0 + t * 256, acc);
            }
        }
    }
}
DI void cchain_unit(const Frame& F, int cu, const CPtrs& P) {
    const int b = cu >> 6, hd = cu & 63, g = hd >> 3;
    const int lane = F.lane, w = F.wave, tid = F.tid, h = lane >> 5, l32 = lane & 31;
    constexpr int LDX = 144, LDB = 272, LDY = 272;
    LAS uchar* Xl = F.lds; LAS uchar* XDl = F.lds + 9216; LAS uchar* XWl = F.lds + 18432;
    LAS uchar* Bl = F.lds + 27648; LAS uchar* Cl = F.lds + 45056;
    LAS uchar* Gl = F.lds + 62464;
    LAS uchar* Hl = F.lds + 71680;
    LAS uchar* Yl = F.lds + 89088;
    LAS float* dtL = (LAS float*)(F.lds + 106496);
    LAS float* acsL = dtL + 128;
    const int nb = w & 3, pb = w >> 2;
    f32x16 hst = zero16();
    for (int i = tid; i < 64 * LDB / 4; i += 512) ((LAS unsigned*)Hl)[i] = 0u;
    unsigned soff[5]; int srow[5], sch[5];
#pragma unroll
    for (int it = 0; it < 5; ++it) {
        const int id = tid + 512 * it, i = id / 40, ch = id - i * 40;
        const int c8 = ch < 8 ? hd * 64 + 8 * ch : ch < 24 ? 4096 + g * 128 + 8 * (ch - 8) : 5120 + g * 128 + 8 * (ch - 24);
        srow[it] = i; sch[it] = ch; soff[it] = (unsigned)(((b * TP + i) * 6144 + c8) * 2);
    }
    u32x4 pre[5];
#pragma unroll
    for (int it = 0; it < 5; ++it) pre[it] = ldg<u32x4>(P.XBC, soff[it]);
    const unsigned sc0 = (unsigned)(((b * TP) * 64 + hd) * 4);
    if (w == 7) { dtL[lane] = ldg<float>(P.DT, sc0 + lane * 256); acsL[lane] = ldg<float>(P.ACS, sc0 + lane * 256); }
    const float dsk = P.dskip[hd];
    __syncthreads();
#pragma unroll 1
    for (int n = 0; n < 64; ++n) {
        const int t0 = n * 64, cur = n & 1;
        LAS const float* dtc = dtL + cur * 64; LAS const float* acs = acsL + cur * 64;
        const float alast = acs[63];
#pragma unroll
        for (int it = 0; it < 5; ++it) {
            const int i = srow[it], ch = sch[it]; const u32x4 o = pre[it];
            if (ch < 8) {
                const float d1 = dtc[i], d2 = d1 * __expf(alast - acs[i]);
                u32x4 o1, o2;
#pragma unroll
                for (int e = 0; e < 4; ++e) { const float lo = bflo(o[e]), hi = bfhi(o[e]); o1[e] = pk2(lo * d1, hi * d1); o2[e] = pk2(lo * d2, hi * d2); }
                *(LAS u32x4*)(Xl + i * LDX + ch * 16) = o; *(LAS u32x4*)(XDl + i * LDX + ch * 16) = o1; *(LAS u32x4*)(XWl + i * LDX + ch * 16) = o2;
            } else if (ch < 24) *(LAS u32x4*)(Bl + i * LDB + (ch - 8) * 16) = o;
            else *(LAS u32x4*)(Cl + i * LDB + (ch - 24) * 16) = o;
        }
        LDS_BARRIER();
        if (n < 63) {
#pragma unroll
            for (int it = 0; it < 5; ++it) pre[it] = ldg<u32x4>(P.XBC, soff[it] + (unsigned)((t0 + 64) * 6144 * 2));
        }
        f32x16 yacc = zero16();
        const int ti = (w >> 1) & 1, tq = w & 1;
        if (w >= 4) {
            if (!(ti == 0 && tq == 1)) {
                f32x16 cbt = mm_tile<false, false>(zero16(), Cl, LDB, 32 * ti, Bl, LDB, 32 * tq, 8, lane);
                const int j = 32 * tq + l32; const float aj = acs[j];
#pragma unroll
                for (int r = 0; r < 16; ++r) {
                    const int i = 32 * ti + crow(r, h);
                    const float v = (i >= j) ? cbt[r] * __expf(acs[i] - aj) : 0.f;
                    *(LAS bf16*)(Gl + i * LDX + j * 2) = (bf16)(pk2(v, 0.f) & 0xffffu);
                }
            } else {
#pragma unroll
                for (int r = 0; r < 16; ++r) *(LAS bf16*)(Gl + crow(r, h) * LDX + (32 + l32) * 2) = (bf16)0;
            }
        } else {
            yacc = mm_tile<false, false>(yacc, Cl, LDB, 32 * ti, Hl, LDB, 32 * tq, 8, lane);
#pragma unroll
            for (int r = 0; r < 16; ++r) yacc[r] *= __expf(acs[32 * ti + crow(r, h)]);
        }
        LDS_BARRIER();
        if (w < 4) {
            yacc = mm_tile<false, true>(yacc, Gl, LDX, 32 * ti, XDl, LDX, 32 * tq, 4, lane);
#pragma unroll
            for (int r = 0; r < 16; ++r) *(LAS float*)(Yl + (32 * ti + crow(r, h)) * LDY + (32 * tq + l32) * 4) = yacc[r];
        }
        {
            const float el = __expf(alast);
#pragma unroll
            for (int r = 0; r < 16; ++r) hst[r] *= el;
            hst = mm_tile<true, true>(hst, Bl, LDB, 32 * nb, XWl, LDX, 32 * pb, 4, lane);
        }
        LDS_BARRIER();
#pragma unroll
        for (int q = 0; q < 4; ++q) {
            f32x4 v = {hst[4 * q], hst[4 * q + 1], hst[4 * q + 2], hst[4 * q + 3]};
            *(LAS u32x2*)(Hl + (32 * pb + l32) * LDB + (32 * nb + 8 * q + 4 * h) * 2) = pk4(v);
        }
        if (w == 7 && n < 63) { dtL[(cur ^ 1) * 64 + lane] = ldg<float>(P.DT, sc0 + (unsigned)((t0 + 64 + lane) * 256)); acsL[(cur ^ 1) * 64 + lane] = ldg<float>(P.ACS, sc0 + (unsigned)((t0 + 64 + lane) * 256)); }
        {
            const int i = tid >> 3, part = tid & 7;
            const f32x4 ya = *(LAS const f32x4*)(Yl + i * LDY + (8 * part) * 4), yb = *(LAS const f32x4*)(Yl + i * LDY + (8 * part + 4) * 4);
            const u32x4 xv = *(LAS const u32x4*)(Xl + i * LDX + part * 16);
            u32x4 o;
            o.x = pk2(ya[0] + dsk * bflo(xv[0]), ya[1] + dsk * bfhi(xv[0])); o.y = pk2(ya[2] + dsk * bflo(xv[1]), ya[3] + dsk * bfhi(xv[1]));
            o.z = pk2(yb[0] + dsk * bflo(xv[2]), yb[1] + dsk * bfhi(xv[2])); o.w = pk2(yb[2] + dsk * bflo(xv[3]), yb[3] + dsk * bfhi(xv[3]));
            stg<u32x4>(P.YC, (unsigned)((((b * TP + t0 + i) * 4096) + hd * 64 + 8 * part) * 2), o);
        }
        LDS_BARRIER();
    }
    {
        float* sp = P.ssm_p + (((size_t)b * 64 + hd) * 64 + 32 * pb + l32) * 128 + 32 * nb + 4 * h;
#pragma unroll
        for (int q = 0; q < 4; ++q) { f32x4 v = {hst[4 * q], hst[4 * q + 1], hst[4 * q + 2], hst[4 * q + 3]}; *(f32x4*)(sp + 8 * q) = v; }
    }
    __syncthreads();
}

DI void csample_unit(const Frame& F, int su, const CPtrs& P) {
    const int b = su >> 3, g = su & 7;
    const int tid = F.tid, lane = F.lane, w = F.wave, hd = g * 8 + w;
    LAS float* xs = (LAS float*)F.lds;
    LAS float* Bs = xs + 2048; LAS float* Cs = Bs + 512;
    LAS float* ys = Cs + 512;
    for (int c = tid; c < 768; c += 512) {
        const int cc = c < 512 ? g * 512 + c : c < 640 ? 4096 + g * 128 + (c - 512) : 5120 + g * 128 + (c - 640);
        float full[7];
#pragma unroll
        for (int r = 0; r < 3; ++r) full[r] = P.conv0[((size_t)b * 3 + r) * 6144 + cc];
#pragma unroll
        for (int t = 0; t < 4; ++t) full[3 + t] = P.PCS[(size_t)(b * 4 + t) * CIN + 4096 + cc];
        const float w0 = P.conv_w[cc], w1 = P.conv_w[6144 + cc], w2 = P.conv_w[2 * 6144 + cc], w3 = P.conv_w[3 * 6144 + cc], cb = P.conv_b[cc];
#pragma unroll
        for (int t = 0; t < 4; ++t) {
            const float v = silu_f(full[t] * w0 + full[t + 1] * w1 + full[t + 2] * w2 + full[t + 3] * w3 + cb);
            if (c < 512) xs[t * 512 + c]= v; else if (c < 640) Bs[t * 128 + (c - 512)] = v; else Cs[t * 128 + (c - 640)] = v;
        }
#pragma unroll
        for (int r = 0; r < 3; ++r) P.conv_s[((size_t)b * 3 + r) * 6144 + cc] = full[4 + r];
    }
    __syncthreads();
    float dt[4], dA[4];
    {
        const float a = -__expf(P.a_log[hd]), db = P.dt_bias[hd];
#pragma unroll
        for (int t = 0; t < 4; ++t) { dt[t] = softplus_f(P.PCS[(size_t)(b * 4 + t) * CIN + 10240 + hd] + db); dA[t] = __expf(dt[t] * a); }
    }
    const float dsk = P.dskip[hd];
#pragma unroll 1
    for (int ph = 0; ph < 2; ++ph) {
        float hs[32][2];
        const float* h0 = P.ssm0 + (((size_t)b * 64 + hd) * 64 + 32 * ph) * 128 + lane;
#pragma unroll
        for (int pi = 0; pi < 32; ++pi) { hs[pi][0] = h0[pi * 128]; hs[pi][1] = h0[pi * 128 + 64]; }
#pragma unroll 1
        for (int t = 0; t < 4; ++t) {
            const float b0 = Bs[t * 128 + lane], b1 = Bs[t * 128 + 64 + lane], c0 = Cs[t * 128 + lane], c1 = Cs[t * 128 + 64 + lane];
#pragma unroll
            for (int pi = 0; pi < 32; ++pi) {
                const float x = xs[t * 512 + w * 64 + 32 * ph + pi], dx = dt[t] * x;
                hs[pi][0] = hs[pi][0] * dA[t] + dx * b0; hs[pi][1] = hs[pi][1] * dA[t] + dx * b1;
                const float yv = wave_sum(hs[pi][0] * c0 + hs[pi][1] * c1);
                if (lane == 0) ys[t * 512 + w * 64 + 32 * ph + pi] = yv + dsk * x;
            }
        }
        float* ho = P.ssm_s + (((size_t)b * 64 + hd) * 64 + 32 * ph) * 128 + lane;
#pragma unroll
        for (int pi = 0; pi < 32; ++pi) { ho[pi * 128] = hs[pi][0]; ho[pi * 128 + 64] = hs[pi][1]; }
    }
    __syncthreads();
    if (w < 4) {
        const int t = w;
        const float* zp = P.PCS + (size_t)(b * 4 + t) * CIN + g * 512 + 8 * lane;
        float y[8]; float ss = 0.f;
#pragma unroll
        for (int e = 0; e < 8; ++e) { y[e] = ys[t * 512 + 8 * lane + e] * silu_f(zp[e]); ss += y[e] * y[e]; }
        const float rstd = rsqrtf(wave_sum(ss) * (1.f / 512.f) + RMS_EPS);
        const float* nw = P.norm_w + g * 512 + 8 * lane;
        u32x4 o; o.x = pk2(y[0] * rstd * nw[0], y[1] * rstd * nw[1]); o.y = pk2(y[2] * rstd * nw[2], y[3] * rstd * nw[3]);
        o.z = pk2(y[4] * rstd * nw[4], y[5] * rstd * nw[5]); o.w = pk2(y[6] * rstd * nw[6], y[7] * rstd * nw[7]);
        *(u32x4*)(P.YC + (size_t)(MP + b * 4 + t) * 4096 + g * 512 + 8 * lane) = o;
    }
    __syncthreads();
}
DI void cnorm_phase(const Frame& F, const CPtrs& P) {
    for (int row = F.gw; row < MP; row += F.NGW) {
#pragma unroll
        for (int k = 0; k < 8; ++k) {
            const int ch = 8 * (F.lane + 64 * k);
            const u32x4 v = ldg<u32x4>(P.YC, (unsigned)((row * 4096 + ch) * 2)), z = ldg<u32x4>(P.PC, (unsigned)((row * CINM + ch) * 2));
            const f32x4 n0 = ldg<f32x4>(P.norm_w, (unsigned)(ch * 4)), n1 = ldg<f32x4>(P.norm_w, (unsigned)((ch + 4) * 4));
            float y[8]; float ss = 0.f;
#pragma unroll
            for (int e = 0; e < 4; ++e) { y[2 * e] = bflo(v[e]) * silu_f(bflo(z[e])); y[2 * e + 1] = bfhi(v[e]) * silu_f(bfhi(z[e])); ss += y[2 * e] * y[2 * e] + y[2 * e + 1] * y[2 * e + 1]; }
            const float rstd = rsqrtf(wave_sum(ss) * (1.f / 512.f) + RMS_EPS);
            u32x4 o; o.x = pk2(y[0] * rstd * n0[0], y[1] * rstd * n0[1]); o.y = pk2(y[2] * rstd * n0[2], y[3] * rstd * n0[3]);
            o.z = pk2(y[4] * rstd * n1[0], y[5] * rstd * n1[1]); o.w = pk2(y[6] * rstd * n1[2], y[7] * rstd * n1[3]);
            stg<u32x4>(P.YC, (unsigned)((row * 4096 + ch) * 2), o);
        }
    }
}
template <class Fn>
DI void run_gemm(const Frame& F, const bf16* A, const bf16* Bt, int N, int K, const Fn& f) {
    pg8::Gemm g{A, Bt, MP, N, K, K}; pg8::StaticOrder S; S.init(MP, N, F.G, F.bid);
    EpiWrap<Fn> E{f};
    pg8::gemm_phase<EpiWrap<Fn>, pg8::StaticOrder, true, true>(F.lds, g, S, E, F.tid);
}
template <class Fn>
DI void run_gemm_split(const Frame& F, const Args& args, const bf16* A, const bf16* Bt, int N, int K, const Fn& f, int inst) {
    const int nwg = (MP / 256) * (N / 256), full = (nwg / F.G) * F.G, rem = nwg - full;
    if (F.G != 256 || rem * 2 != F.G) { run_gemm(F, A, Bt, N, K, f); return; }
    {
        pg8::Gemm g{A, Bt, MP, N, K, K}; CappedOrder S; S.S.init(MP, N, F.G, F.bid); S.cap = full;
        EpiWrap<Fn> E{f};
        pg8::gemm_phase<EpiWrap<Fn>, CappedOrder, true, true>(F.lds, g, S, E, F.tid);
    }
    {
        const int half = F.bid >= rem ? 1 : 0, c = F.bid - half * rem;
        pg8::StaticOrder S0; S0.init(MP, N, F.G, c); pg8::Unit u; S0.next(full / F.G, u);
        OneUnit S; S.pm = u.pm; S.pn = u.pn; S.valid = true;
        pg8::Gemm g{A + half * (K / 2), Bt + half * (K / 2), MP, N, K / 2, K};
        float* slab = (float*)(args.ws + WS_SLAB) + (size_t)c * 65536;
        unsigned* cnt = (unsigned*)(args.ws + CTL_SPLIT) + ((size_t)inst * 128 + c) * 64;
        if (half) { EpiSplitPartner E{slab, cnt}; pg8::gemm_phase<EpiSplitPartner, OneUnit, true, true>(F.lds, g, S, E, F.tid); }
        else { EpiSplitOwner<Fn> E{f, slab, cnt}; pg8::gemm_phase<EpiSplitOwner<Fn>, OneUnit, true, true>(F.lds, g, S, E, F.tid); }
    }
}
#define SKINNY_LOOP(u, count) for (int u = (F.G - 1 - F.bid); u < (count); u += F.G)
#define SIDE_LOOP(u, count, nres) for (int _ns = (F.G > (nres) ? F.G - (nres) : F.G), u = ((F.G - 1 - F.bid) < _ns ? (F.G - 1 - F.bid) : (count)); u < (count); u += _ns)

enum { PH_PRO = 0, PH_GU, PH_DN, PH_LN, PH_AQKV, PH_ATT, PH_AO, PH_BIN, PH_BPREP, PH_BCHAIN, PH_BOUT, PH_CIN, PH_CCHAIN, PH_CNORM, PH_COUT, PH_CPRE, PH_BO, PH_N };

DI void fill_b(BPtrs& P, const Args& args) {
    uchar* ws = args.ws;
    P.PB = (const bf16*)(ws + MB_PB); P.EB = (const float*)(ws + MB_EB); P.PBS = (const float*)(ws + MB_PBS);
    P.WG = (bf16*)(ws + MB_WG); P.UG = (bf16*)(ws + MB_UG); P.QG = (bf16*)(ws + MB_QG); P.KG = (bf16*)(ws + MB_KG); P.QKG = (bf16*)(ws + MB_QKG);
    P.GCG = (float*)(ws + MB_GCG); P.YB = (bf16*)(ws + MB_YB); P.SG = (bf16*)(ws + MB_SG); P.VNG = (bf16*)(ws + MB_VNG);
    P.conv_w = args.in[18]; P.a_log = args.in[19]; P.dt_bias = args.in[20]; P.norm_w = args.in[21]; P.ssm0 = args.in[5]; P.conv0 = args.in[6];
    P.ssm_p = args.out + O_BSSMP; P.ssm_s = args.out + O_BSSMS; P.conv_p = args.out + O_BCONVP; P.conv_s = args.out + O_BCONVS;
}
DI void fill_c(CPtrs& P, const Args& args) {
    uchar* ws = args.ws;
    P.PC = (const bf16*)(ws + MC_PC); P.EC = (const float*)(ws + MC_EC); P.PCS = (const float*)(ws + MC_PCS); P.DT = (float*)(ws + MC_SS); P.ACS = (float*)(ws + MC_ACS); P.XBC = (bf16*)(ws + MC_XBC); P.YC = (bf16*)(ws + MC_YC);
    P.conv_w = args.in[24]; P.conv_b = args.in[25]; P.dt_bias = args.in[26]; P.a_log = args.in[27]; P.dskip = args.in[28]; P.norm_w = args.in[29];
    P.ssm0 = args.in[7]; P.conv0 = args.in[8];
    P.ssm_p = args.out + O_CSSMP; P.ssm_s = args.out + O_CSSMS; P.conv_p = args.out + O_CCONVP; P.conv_s = args.out + O_CCONVS;
}
template <int PH>
DI void phase_body(const Frame& F, const Args& args, int hl, int zsi, int j, bool isdup = false) {
    uchar* ws = args.ws;
    float* X = args.out; bf16* XB = (bf16*)(ws + WS_XB); float* ZP = (float*)(ws + WS_ZP); bf16* HB = (bf16*)(ws + WS_H);
    float* ZS = (float*)(ws + WS_ZS + (size_t)zsi * ZS_ONE);
    if constexpr (PH == PH_PRO) prologue(F, args);
    if constexpr (PH == PH_GU) {
        const bf16* Wgu = (const bf16*)(ws + WS_W + (size_t)hl * FFN_BYTES);
        FSwiglu f{HB}; run_gemm(F, XB, Wgu, NGU, DM, f);
        SIDE_LOOP(u, NGU / 64, 128) skinny_unit<2>(F, XB, DM, MP, Wgu, DM, 64 * u, 0, DM, f);
    }
    if constexpr (PH == PH_DN) {
        const bf16* Wdn = (const bf16*)(ws + WS_W + (size_t)hl * FFN_BYTES + GU_BYTES);
        FResid f{XB, ZP, 0, 0.5f, 0, 1}; run_gemm(F, HB, Wdn, DM, DFF, f);
        if (!isdup) SKINNY_LOOP(u, 256) { const int ft = u >> 2, ks = u & 3; FResid fs{XB, ZS, MP, 0.5f, 1, ks == 0}; skinny_unit<1>(F, HB, DFF, MP, Wdn, DFF, 32 * ft, ks * (DFF / 4), DFF / 4, fs); }
    }
    if constexpr (PH == PH_LN) ln_phase(F, ZP, ZS, args.in[9] + (size_t)zsi * DM, args.in[10] + (size_t)zsi * DM, zsi == 11 ? X : (float*)nullptr, XB);
    if constexpr (PH == PH_AQKV || PH == PH_ATT || PH == PH_AO) {
        const bf16* Wq = (const bf16*)(ws + WS_WA + (size_t)j * A_BYTES); const bf16* Wo = (const bf16*)(ws + WS_WA + (size_t)j * A_BYTES + AQ_BYTES);
        bf16* QKV = (bf16*)(ws + MA_QKV); float* QKVS = (float*)(ws + MA_QKVS); bf16* OG = (bf16*)(ws + MA_OG); float* LSE = (float*)(ws + MA_LSE); bf16* OA = (bf16*)(ws + MA_O);
        if constexpr (PH == PH_AQKV) {
            FQkv f; f.QKV = QKV; f.QKVS = QKVS; f.rope = (const float*)(ws + WS_ROPE); f.j = j;
            f.out = args.out;
            run_gemm(F, XB, Wq, AQKV, DM, f);
            SIDE_LOOP(u, AQKV / 64, 128) skinny_unit<2>(F, XB, DM, MP, Wq, DM, 64 * u, 0, DM, f);
        }
        if constexpr (PH == PH_ATT) {
#ifndef DUP_SUB
#define DUP_SUB 0
#endif
            if (!isdup || DUP_SUB == 0 || DUP_SUB == 1) for (int u = F.bid; u < 256; u += F.G) attn_prompt_unit(F, u, QKV, OG, LSE, OA);
            if (!isdup || DUP_SUB == 0 || DUP_SUB == 2) for (int u = F.bid; u < 256; u += F.G) attn_sample_unit(F, u, QKVS, args.in[2], args.in[3], args.in[4], j, OA);
            if (!isdup || DUP_SUB == 0 || DUP_SUB == 3) { if (j == 0) bg_slot(F, args, 1, 0);
            if (j == 1) cache_copy(args, args.cc[0], args.cc[1], F.bid * 512 + F.tid, F.G * 512); }
        }
        if constexpr (PH == PH_AO) {
            FResid f{XB, ZP, 0, 1.f, 0, 1}; run_gemm(F, OA, Wo, DM, 1024, f);
            if (!isdup) SKINNY_LOOP(u, 256) { const int ft = u >> 2, ks = u & 3; FResid fs{XB, ZS, MP, 1.f, 1, ks == 0}; skinny_unit<1>(F, OA, 1024, MP, Wo, 1024, 32 * ft, ks * 256, 256, fs); }
        }
    }
    if constexpr (PH == PH_BIN || PH == PH_BPREP || PH == PH_BCHAIN || PH == PH_BOUT || PH == PH_BO) {
        const bf16* Wi = (const bf16*)(ws + WS_WB); const bf16* Wo = (const bf16*)(ws + WS_WB + BI_BYTES);
        BPtrs P; fill_b(P, args);
        if constexpr (PH == PH_BIN) {
            FBf16 f{(bf16*)(ws + MB_PB), BINM}; run_gemm(F, XB, Wi, BINM, DM, f);
            FF32 fe{(float*)(ws + MB_EB), 64, 0, BINM};
            SKINNY_LOOP(u, 256) skinny_unit<2>(F, XB, DM, 32 * u, Wi, DM, BINM, 0, DM, fe);
            FF32 fs{(float*)(ws + MB_PBS), BIN, MP, 0};
            SKINNY_LOOP(u, BIN / 64) skinny_unit<2>(F, XB, DM, MP, Wi, DM, 64 * u, 0, DM, fs);
        }
        if constexpr (PH == PH_BPREP) {
            for (int u = F.bid; u < 2048; u += F.G) bprep_unit(F, u, P);
            for (int i = F.gw * 64 + F.lane; i < 2 * 3 * 8192; i += F.NGW * 64) { const int b = i / 24576, r = (i / 8192) % 3, c = i & 8191; P.conv_p[i] = bf2f(P.PB[((size_t)b * TP + TP - 3 + r) * BINM + c]); }
        }
        if constexpr (PH == PH_BCHAIN) {
            for (int u = F.bid; u < 64; u += F.G) bchain_unit(F, u, P);
            SIDE_LOOP(u, 256, 64) bsample_unit(F, u, P);
            bg_slot(F, args, 4, 64);
            if (F.bid >= 64 && F.G > 64) cache_copy(args, args.cc[1], args.cc[2], (F.bid - 64) * 512 + F.tid, (F.G - 64) * 512);
        }
        if constexpr (PH == PH_BO) { for (int u = F.bid; u < 4096; u += F.G) bout_unit(F, u, P); }
        if constexpr (PH == PH_BOUT) {
            FResid f{XB, ZP, 0, 1.f, 0, 1}; run_gemm(F, P.YB, Wo, DM, 4096, f);
            if (!isdup) SKINNY_LOOP(u, 256) { const int ft = u >> 2, ks = u & 3; FResid fs{XB, ZS, MP, 1.f, 1, ks == 0}; skinny_unit<1>(F, P.YB, 4096, MP, Wo, 4096, 32 * ft, ks * 1024, 1024, fs); }
        }
    }
    if constexpr (PH == PH_CIN || PH == PH_CCHAIN || PH == PH_CNORM || PH == PH_COUT || PH == PH_CPRE) {
        const bf16* Wi = (const bf16*)(ws + WS_WC); const bf16* Wo = (const bf16*)(ws + WS_WC + CI_BYTES);
        CPtrs P; fill_c(P, args);
        if constexpr (PH == PH_CIN) {
            FBf16 f{(bf16*)(ws + MC_PC), CINM}; run_gemm(F, XB, Wi, CINM, DM, f);
            FF32 fe{(float*)(ws + MC_EC), 64, 0, CINM};
            SKINNY_LOOP(u, 256) skinny_unit<2>(F, XB, DM, 32 * u, Wi, DM, CINM, 0, DM, fe);
            FF32 fs{(float*)(ws + MC_PCS), CIN, MP, 0};
            SKINNY_LOOP(u, CIN / 64) skinny_unit<2>(F, XB, DM, MP, Wi, DM, 64 * u, 0, DM, fs);
        }
        if constexpr (PH == PH_CCHAIN) {
            for (int u = F.bid; u < 128; u += F.G) cchain_unit(F, u, P);
            SIDE_LOOP(u, 64, 128) csample_unit(F, u, P);
            bg_slot(F, args, 5, 128);
            if (F.bid >= 128 && F.G > 128) cache_copy(args, args.cc[2], args.cc[3], (F.bid - 128) * 512 + F.tid, (F.G - 128) * 512);
            for (int i = F.gw * 64 + F.lane; i < 2 * 3 * 6144; i += F.NGW * 64) { const int b = i / 18432, r = (i / 6144) % 3, c = i % 6144; P.conv_p[i] = bf2f(P.PC[((size_t)b * TP + TP - 3 + r) * CINM + 4096 + c]); }
        }
        if constexpr (PH == PH_CPRE) cpre_phase(F, P);
        if constexpr (PH == PH_CNORM) cnorm_phase(F, P);
        if constexpr (PH == PH_COUT) {
            FResid f{XB, ZP, 0, 1.f, 0, 1}; run_gemm(F, P.YC, Wo, DM, 4096, f);
            if (!isdup) SKINNY_LOOP(u, 256) { const int ft = u >> 2, ks = u & 3; FResid fs{XB, ZS, MP, 1.f, 1, ks == 0}; skinny_unit<1>(F, P.YC, 4096, MP, Wo, 4096, 32 * ft, ks * 1024, 1024, fs); }
        }
    }
}
DI void make_frame(Frame& F, unsigned char* lds_raw) {
    F.lds = (LAS uchar*)lds_raw;
    F.tid = threadIdx.x; F.lane = F.tid & 63; F.wave = __builtin_amdgcn_readfirstlane(F.tid >> 6);
    F.G = gridDim.x; F.bid = blockIdx.x; F.gw = F.bid * NWAVES + F.wave; F.NGW = F.G * NWAVES;
}
#if MK_MULTI
template <int PH>
__global__ void __launch_bounds__(NWAVES * 64, 2) mk_phase(Args args, int hl, int zsi, int j) {
    extern __shared__ __attribute__((aligned(16))) unsigned char lds_raw[];
    Frame F; make_frame(F, lds_raw);
    phase_body<PH>(F, args, hl, zsi, j);
}
#endif

static void fill_args(Args& a, void* const* d_in, void* d_out, void* d_ws) {
    for (int i = 0; i < 31; ++i) a.in[i] = (const float*)d_in[i];
    a.out = (float*)d_out; a.ws = (unsigned char*)d_ws;
    unsigned char* ws = (unsigned char*)d_ws;
    int nd = 0, items = 0;
    auto add = [&](const float* src, size_t dst_off, int K, int N, int mode) { a.wd[nd].src = src; a.wd[nd].dst = (bf16*)(ws + dst_off); a.wd[nd].K = K; a.wd[nd].N = N; a.wd[nd].mode = mode; a.wd[nd].item0 = items; items += (K / 64) * (N / 64); ++nd; };
    auto ffn = [&](int hl) { const int L = hl >> 1, wh = hl & 1;
        add(a.in[wh ? 13 : 11] + (size_t)L * DM * NGU, WS_W + (size_t)hl * FFN_BYTES, DM, NGU, 1);
        add(a.in[wh ? 14 : 12] + (size_t)L * DFF * DM, WS_W + (size_t)hl * FFN_BYTES + GU_BYTES, DFF, DM, 0); };
    auto mixa = [&](int j) { add(a.in[15] + (size_t)j * DM * AQKV, WS_WA + (size_t)j * A_BYTES, DM, AQKV, 0); add(a.in[16] + (size_t)j * 1024 * DM, WS_WA + (size_t)j * A_BYTES + AQ_BYTES, 1024, DM, 0); };
    a.slot[0][0] = items; ffn(0); mixa(0); ffn(2); a.slot[0][1] = items;
    a.slot[1][0] = items; ffn(1); add(a.in[17], WS_WB, DM, BIN, 0); add(a.in[22], WS_WB + BI_BYTES, 4096, DM, 0); a.slot[1][1] = items;
    a.slot[2][0] = items; a.slot[2][1] = items; a.slot[3][0] = items; a.slot[3][1] = items;
    a.slot[4][0] = items; ffn(3); ffn(4); add(a.in[23], WS_WC, DM, CIN, 0); add(a.in[30], WS_WC + CI_BYTES, 4096, DM, 0); ffn(5); a.slot[4][1] = items;
    a.slot[5][0] = items; ffn(6); mixa(1); ffn(7); a.slot[5][1] = items;
    { const double fr[4] = {0.0, 0.35, 0.75, 1.0}; for (int i = 0; i < 12; ++i) a.cc[i] = CC_TOT; for (int i = 0; i < 3; ++i) a.cc[i] = (int)(fr[i] * CC_TOT); }
    a.nitems = items; a.pad = 0;
}
#if MK_MULTI
template <int PH> static void launch_phase(const Args& a, int grid, hipStream_t stream, int hl, int zsi, int j) {
    static bool attr = false;
    if (!attr) { (void)hipFuncSetAttribute((const void*)mk_phase<PH>, hipFuncAttributeMaxDynamicSharedMemorySize, LDS_BYTES); attr = true; }
    hipLaunchKernelGGL(mk_phase<PH>, dim3(grid), dim3(NWAVES * 64), LDS_BYTES, stream, a, hl, zsi, j);
}
extern "C" void kernel_launch(void* const* d_in, const int* in_sizes, int n_in, void* d_out, int out_size, void* d_ws, size_t ws_size, hipStream_t stream) {
    static int grid = 0;
    if (grid == 0) {
        if (n_in != 31 || (size_t)out_size != O_END || ws_size < WS_END) {
            fprintf(stderr, "kernel_launch: expected 31 inputs, out %zu floats, ws >= %zu bytes; got n_in %d out %d ws %zu; nothing launched\n", (size_t)O_END, (size_t)WS_END, n_in, out_size, ws_size);
            grid = -1; return;
        }
        int dev = 0, cus = 0;
        if (hipGetDevice(&dev) != hipSuccess || hipDeviceGetAttribute(&cus, hipDeviceAttributeMultiprocessorCount, dev) != hipSuccess) { grid = -1; return; }
        grid = cus;
    }
    if (grid < 0) return;
    Args a{}; fill_args(a, d_in, d_out, d_ws);
    launch_phase<PH_PRO>(a, grid, stream, 0, 0, 0);
    for (int hl = 0; hl < 8; ++hl) {
        const int layer = hl >> 1, which = hl & 1, zf = 3 * layer + 2 * which, zm = 3 * layer + 1;
        launch_phase<PH_GU>(a, grid, stream, hl, zf, 0);
        launch_phase<PH_DN>(a, grid, stream, hl, zf, 0);
        launch_phase<PH_LN>(a, grid, stream, hl, zf, 0);
        if (which == 1) continue;
        if (layer == 0 || layer == 3) {
            const int j = layer == 0 ? 0 : 1;
            launch_phase<PH_AQKV>(a, grid, stream, hl, zm, j); launch_phase<PH_ATT>(a, grid, stream, hl, zm, j); launch_phase<PH_AO>(a, grid, stream, hl, zm, j);
        } else if (layer == 1) {
            launch_phase<PH_BIN>(a, grid, stream, hl, zm, 0); launch_phase<PH_BPREP>(a, grid, stream, hl, zm, 0); launch_phase<PH_BCHAIN>(a, grid, stream, hl, zm, 0); launch_phase<PH_BO>(a, grid, stream, hl, zm, 0); launch_phase<PH_BOUT>(a, grid, stream, hl, zm, 0);
        } else {
            launch_phase<PH_CIN>(a, grid, stream, hl, zm, 0); launch_phase<PH_CPRE>(a, grid, stream, hl, zm, 0); launch_phase<PH_CCHAIN>(a, grid, stream, hl, zm, 0); launch_phase<PH_CNORM>(a, grid, stream, hl, zm, 0); launch_phase<PH_COUT>(a, grid, stream, hl, zm, 0);
        }
        launch_phase<PH_LN>(a, grid, stream, hl, zm, 0);
    }
    const hipError_t le = hipPeekAtLastError();
    if (le != hipSuccess) fprintf(stderr, "kernel_launch: launch failed: %s\n", hipGetErrorName(le));
}
#endif
#if !MK_MULTI
DI void launder_frame(Frame& F) {
    int t_ = F.tid, l_ = F.lane, w_ = F.wave, g_ = F.G, b_ = F.bid; unsigned la_ = (unsigned)(size_t)F.lds;
    asm volatile("" : "+v"(t_), "+v"(l_)); asm volatile("" : "+s"(w_), "+s"(g_), "+s"(b_), "+s"(la_));
    F.tid = t_; F.lane = l_; F.wave = w_; F.G = g_; F.bid = b_; F.gw = b_ * NWAVES + w_; F.NGW = g_ * NWAVES; F.lds = (LAS uchar*)(size_t)la_;
}
__global__ void __launch_bounds__(NWAVES * 64, 2) mk_fwd(Args args) {
    extern __shared__ __attribute__((aligned(16))) unsigned char lds_raw[];
    Frame F; make_frame(F, lds_raw);
    volatile LAS unsigned* MISC = (volatile LAS unsigned*)(F.lds + MISC_OFF);
    for (int u = F.tid; u < (LDS_BYTES - MISC_OFF) / 4; u += NWAVES * 64) ((LAS unsigned*)(F.lds + MISC_OFF))[u] = 0u;
    __syncthreads();
    XcdBarrier bar = xcd_barrier_post((unsigned*)(args.ws + WS_CTL) + CW_BAR, MISC + 8);
#ifndef DUP_PH
#define DUP_PH -1
#endif
#define RUN1(PH, hl, zsi, j) do { asm volatile("; MARK_PHASE %0 %1" :: "i"(PH), "i"(zsi)); launder_frame(F); phase_body<PH>(F, args, hl, zsi, j); xcd_barrier(bar); } while (0)
#define RUN(PH, hl, zsi, j) do { RUN1(PH, hl, zsi, j); if (PH == DUP_PH) { launder_frame(F); phase_body<PH>(F, args, hl, zsi, j, true); xcd_barrier(bar); } } while (0)
#define FFN(hl, zsi) RUN(PH_GU, hl, zsi, 0); RUN(PH_DN, hl, zsi, 0); RUN(PH_LN, hl, zsi, 0)
#define MIXA(zsi, j) RUN(PH_AQKV, 0, zsi, j); RUN(PH_ATT, 0, zsi, j); RUN(PH_AO, 0, zsi, j); RUN(PH_LN, 0, zsi, 0)
#define MIXB(zsi) RUN(PH_BIN, 0, zsi, 0); RUN(PH_BPREP, 0, zsi, 0); RUN(PH_BCHAIN, 0, zsi, 0); RUN(PH_BO, 0, zsi, 0); RUN(PH_BOUT, 0, zsi, 0); RUN(PH_LN, 0, zsi, 0)
#define MIXC(zsi) RUN(PH_CIN, 0, zsi, 0); RUN(PH_CPRE, 0, zsi, 0); RUN(PH_CCHAIN, 0, zsi, 0); RUN(PH_CNORM, 0, zsi, 0); RUN(PH_COUT, 0, zsi, 0); RUN(PH_LN, 0, zsi, 0)
    RUN(PH_PRO, 0, 0, 0);
    FFN(0, 0); MIXA(1, 0); FFN(1, 2);
    FFN(2, 3); MIXB(4);    FFN(3, 5);
    FFN(4, 6); MIXC(7);    FFN(5, 8);
    FFN(6, 9); MIXA(10, 1); FFN(7, 11);
}
extern "C" void kernel_launch(void* const* d_in, const int* in_sizes, int n_in, void* d_out, int out_size, void* d_ws, size_t ws_size, hipStream_t stream) {
    static int grid = 0;
    if (grid == 0) {
        if (n_in != 31 || (size_t)out_size != O_END || ws_size < WS_END) {
            fprintf(stderr, "kernel_launch: expected 31 inputs, out %zu floats, ws >= %zu bytes; got n_in %d out %d ws %zu; nothing launched\n", (size_t)O_END, (size_t)WS_END, n_in, out_size, ws_size);
            grid = -1; return;
        }
        int dev = 0, cus = 0, per_cu = 0;
        if (hipGetDevice(&dev) != hipSuccess || hipDeviceGetAttribute(&cus, hipDeviceAttributeMultiprocessorCount, dev) != hipSuccess) { grid = -1; return; }
        if (hipFuncSetAttribute((const void*)mk_fwd, hipFuncAttributeMaxDynamicSharedMemorySize, LDS_BYTES) != hipSuccess) { fprintf(stderr, "kernel_launch: hipFuncSetAttribute failed\n"); grid = -1; return; }
        if (hipOccupancyMaxActiveBlocksPerMultiprocessor(&per_cu, (const void*)mk_fwd, NWAVES * 64, LDS_BYTES) != hipSuccess || per_cu < 1)
            fprintf(stderr, "kernel_launch: note: occupancy query reports %d workgroups per CU\n", per_cu);
        (void)hipGetLastError();
        grid = cus;
    }
    if (grid < 0) return;
    if (hipMemsetAsync((char*)d_ws + WS_CTL, 0, CTL_ZERO_BYTES, stream) != hipSuccess) { fprintf(stderr, "kernel_launch: memset failed\n"); return; }
    Args a{}; fill_args(a, d_in, d_out, d_ws);
    hipLaunchKernelGGL(mk_fwd, dim3(grid), dim3(NWAVES * 64), LDS_BYTES, stream, a);
    const hipError_t le = hipPeekAtLastError();
    if (le != hipSuccess) fprintf(stderr, "kernel_launch: launch failed: %s\n", hipGetErrorName(le));
}
#endif
```

```cpp
#include <hip/hip_runtime.h>
#include <cstdio>
#include <cstdint>
#ifndef MK_MULTI
#define MK_MULTI 0
#endif
#define DUP_PH -1
#define DUP_SUB 0
namespace pg8 {
#define PG8_LAS __attribute__((address_space(3)))
typedef unsigned short bf16_t;
typedef short bf16x8 __attribute__((ext_vector_type(8)));
typedef float f32x4 __attribute__((ext_vector_type(4)));
typedef unsigned u32x4 __attribute__((ext_vector_type(4)));
constexpr int BM = 256, BK = 64, HALF = 128, HTB = HALF * BK * 2  , STAGE_BYTES = 8 * HTB, NXCD = 8, WGM = 8;

__host__ __device__ __forceinline__ int lds_byte(int r, int c) { const int st = (r >> 4) * 2 + (c >> 5), rr = r & 15, cc = c & 31, ob = rr * 64 + cc * 2; return st * 1024 + (ob ^ (((ob >> 9) & 1) << 5)); }
__host__ __device__ __forceinline__ void stage_rc(int b, int& R, int& C) { const int st = b / 1024, sb = b % 1024, swz = sb ^ (((sb >> 9) & 1) << 5); R = (st >> 1) * 16 + swz / 64; C = (st & 1) * 32 + (swz % 64) / 2; }
__host__ __device__ __forceinline__ int perm32(int rho) { const int n = rho >> 4, i = rho & 15; return 8 * (i >> 2) + 4 * n + (i & 3); }

struct Unit { int pm, pn; };
struct Gemm { const bf16_t* A; const bf16_t* Bt; int M, N, K, ld; };

struct StaticOrder {
    int nM, nN, nwg, G, c;
    __host__ __device__ void init(int M, int N, int G_, int c_) { nM = M / BM; nN = N / BM; nwg = nM * nN; G = G_; c = c_; }
    __host__ __device__ bool next(int i, Unit& u) const {
        const long L = (long)i * G + c; if (L >= nwg) return false;
        int wgid = (int)L; { const int q = nwg / NXCD, r = nwg % NXCD, xcd = wgid % NXCD, off = wgid / NXCD; wgid = (xcd < r ? xcd * (q + 1) : r * (q + 1) + (xcd - r) * q) + off; }
        const int nig = WGM * nN, gid = wgid / nig, fm = gid * WGM, gsz = (nM - fm) < WGM ? (nM - fm) : WGM;
        u.pm = fm + ((wgid % nig) % gsz); u.pn = (wgid % nig) / gsz; return true;
    }
    __device__ __forceinline__ void a_ready(const Unit&) const {}
    __device__ __forceinline__ void done(const Unit&) const {}
};


template <class Epi, class Sched, bool ALIGN_EPI = false, bool SP2 = false>
__device__ __forceinline__ void gemm_phase(PG8_LAS unsigned char* lds, const Gemm g, const Sched& S, const Epi& E, const int tid) {
    const int wid = __builtin_amdgcn_readfirstlane(tid >> 6), lane = tid & 63, wr = wid >> 2, wc = wid & 3, fr = lane & 15, fq = lane >> 4;
    const int K = g.ld, nt = g.K / BK;
    unsigned voffA[2], voffB[2];
#pragma unroll
    for (int i = 0; i < 2; ++i) { int R, C; stage_rc(tid * 16 + i * 8192, R, C); const int Rb = Epi::PERM ? ((R & ~31) + perm32(R & 31)) : R;
        voffA[i] = (unsigned)(R * K + C) * 2u; voffB[i] = (unsigned)(Rb * K + C) * 2u; }
    const size_t kstep = (size_t)(BK * 2);
    const size_t hstep = (size_t)HALF * K * 2;
    const size_t tstep = 2 * hstep;
    const unsigned ldsw = (unsigned)wid * 1024u;
    const int aoff = lds_byte(wr * 64 + fr, fq * 8), boff = lds_byte(wc * 32 + fr, fq * 8);
#define PG8_SA(b, h) (((b) * 2 + (h)) * HTB)
#define PG8_SB(b, h) ((4 + (b) * 2 + (h)) * HTB)
#define PG8_STAGE(bufoff, gbase, voff) do { _Pragma("unroll") for (int _i = 0; _i < 2; ++_i) \
        __builtin_amdgcn_global_load_lds((const unsigned*)((const char*)(gbase) + (voff)[_i]), (PG8_LAS unsigned*)(lds + (bufoff) + ldsw + _i * 8192), 16, 0, 0); } while (0)
#define PG8_LDA(dst, b, h) do { _Pragma("unroll") for (int m = 0; m < 4; ++m) _Pragma("unroll") for (int k = 0; k < 2; ++k) dst[m][k] = *(const PG8_LAS bf16x8*)(lds + PG8_SA(b, h) + aoff + m * 2048 + k * 1024); } while (0)
#define PG8_LDB(dst, b, h) do { _Pragma("unroll") for (int n = 0; n < 2; ++n) _Pragma("unroll") for (int k = 0; k < 2; ++k) dst[n][k] = *(const PG8_LAS bf16x8*)(lds + PG8_SB(b, h) + boff + n * 2048 + k * 1024); } while (0)
#define PG8_MMA(ai, bj, At, Bt) do { __builtin_amdgcn_s_setprio(1); _Pragma("unroll") for (int m = 0; m < 4; ++m) _Pragma("unroll") for (int n = 0; n < 2; ++n) _Pragma("unroll") for (int k = 0; k < 2; ++k) \
        acc[ai][bj][m][n] = __builtin_amdgcn_mfma_f32_16x16x32_bf16(Bt[n][k], At[m][k], acc[ai][bj][m][n], 0, 0, 0); __builtin_amdgcn_s_setprio(0); } while (0)
#define PG8_WAIT_V(n) asm volatile("s_waitcnt vmcnt(" #n ")" ::: "memory")
#define PG8_WAIT_L(n) asm volatile("s_waitcnt lgkmcnt(" #n ")" ::: "memory")
#define PG8_BAR __builtin_amdgcn_s_barrier()
#define PG8_SCHED __builtin_amdgcn_sched_barrier(0)
    Unit cur, nxt; int ui = 0;
    if (!S.next(0, cur)) return;
    f32x4 acc[2][2][4][2];
#pragma unroll
    for (int a = 0; a < 2; ++a)
#pragma unroll
        for (int b = 0; b < 2; ++b)
#pragma unroll
            for (int m = 0; m < 4; ++m)
#pragma unroll
                for (int n = 0; n < 2; ++n) acc[a][b][m][n] = (f32x4){0.f, 0.f, 0.f, 0.f};
    bf16x8 At[4][2], B0[2][2], B1[2][2];
    const char* cA = (const char*)g.A + (size_t)cur.pm * tstep; const char* cB = (const char*)g.Bt + (size_t)cur.pn * tstep;
    S.a_ready(cur);
    if constexpr (SP2) {
        PG8_STAGE(PG8_SB(0, 0), cB, voffB); PG8_STAGE(PG8_SB(0, 1), cB + hstep, voffB); PG8_STAGE(PG8_SA(0, 0), cA, voffA); PG8_STAGE(PG8_SA(0, 1), cA + hstep, voffA);
        if (wr == 1) PG8_BAR;
        PG8_WAIT_V(2); PG8_BAR;
        PG8_STAGE(PG8_SB(1, 0), cB + kstep, voffB); PG8_STAGE(PG8_SA(1, 0), cA + kstep, voffA); PG8_STAGE(PG8_SB(1, 1), cB + hstep + kstep, voffB);
        PG8_WAIT_V(6); PG8_BAR;
    } else {
        PG8_STAGE(PG8_SB(0, 0), cB, voffB); PG8_STAGE(PG8_SA(0, 0), cA, voffA); PG8_STAGE(PG8_SB(0, 1), cB + hstep, voffB); PG8_STAGE(PG8_SA(0, 1), cA + hstep, voffA);
        if (wr == 1) PG8_BAR;
        PG8_WAIT_V(4); PG8_BAR;
        PG8_STAGE(PG8_SB(1, 0), cB + kstep, voffB); PG8_STAGE(PG8_SA(1, 0), cA + kstep, voffA); PG8_STAGE(PG8_SB(1, 1), cB + hstep + kstep, voffB);
        PG8_WAIT_V(6); PG8_BAR;
    }
    for (;;) {
        const bool has_next = S.next(ui + 1, nxt);
        const char* nA = has_next ? (const char*)g.A + (size_t)nxt.pm * tstep : cA; const char* nB = has_next ? (const char*)g.Bt + (size_t)nxt.pn * tstep : cB;
        for (int t = 0; t < nt; t += 2) {
            const bool last = (t == nt - 2);
            const char* a1 = cA + (size_t)(t + 1) * kstep;
            const char* a2 = last ? nA : cA + (size_t)(t + 2) * kstep; const char* b2 = last ? nB : cB + (size_t)(t + 2) * kstep;
            const char* a3 = a2 + kstep; const char* b3 = b2 + kstep;
            if (last && has_next) S.a_ready(nxt);
            if constexpr (SP2) {
            PG8_LDB(B0, 0, 0); PG8_LDB(B1, 0, 1); PG8_SCHED; PG8_LDA(At, 0, 0); PG8_STAGE(PG8_SA(1, 1), a1 + hstep, voffA);
            PG8_WAIT_V(8); PG8_WAIT_L(0); PG8_BAR; PG8_MMA(0, 0, At, B0); PG8_MMA(0, 1, At, B1); PG8_BAR; PG8_SCHED;
            PG8_LDA(At, 0, 1); PG8_STAGE(PG8_SB(0, 0), b2, voffB); PG8_STAGE(PG8_SB(0, 1), b2 + hstep, voffB); PG8_STAGE(PG8_SA(0, 0), a2, voffA);
            PG8_WAIT_V(8); PG8_WAIT_L(0); PG8_BAR; PG8_MMA(1, 0, At, B0); PG8_MMA(1, 1, At, B1); PG8_BAR; PG8_SCHED;
            PG8_LDB(B0, 1, 0); PG8_LDB(B1, 1, 1); PG8_SCHED; PG8_LDA(At, 1, 0); PG8_STAGE(PG8_SA(0, 1), a2 + hstep, voffA);
            PG8_WAIT_V(8); PG8_WAIT_L(0); PG8_BAR; PG8_MMA(0, 0, At, B0); PG8_MMA(0, 1, At, B1); PG8_BAR; PG8_SCHED;
            PG8_LDA(At, 1, 1); PG8_STAGE(PG8_SB(1, 0), b3, voffB); PG8_STAGE(PG8_SB(1, 1), b3 + hstep, voffB); PG8_STAGE(PG8_SA(1, 0), a3, voffA);
            PG8_WAIT_V(8); PG8_WAIT_L(0); PG8_BAR; PG8_MMA(1, 0, At, B0); PG8_MMA(1, 1, At, B1); PG8_BAR; PG8_SCHED;
            } else {
            PG8_LDB(B0, 0, 0); PG8_SCHED; PG8_LDA(At, 0, 0); PG8_STAGE(PG8_SA(1, 1), a1 + hstep, voffA);
            PG8_WAIT_L(8); PG8_BAR; PG8_WAIT_L(0); PG8_MMA(0, 0, At, B0); PG8_BAR; PG8_SCHED;
            PG8_LDB(B1, 0, 1); PG8_STAGE(PG8_SB(0, 0), b2, voffB);
            PG8_BAR; PG8_WAIT_L(0); PG8_MMA(0, 1, At, B1); PG8_BAR;
            PG8_LDA(At, 0, 1); PG8_STAGE(PG8_SA(0, 0), a2, voffA);
            PG8_BAR; PG8_WAIT_L(0); PG8_MMA(1, 0, At, B0); PG8_BAR; PG8_SCHED;
            PG8_STAGE(PG8_SB(0, 1), b2 + hstep, voffB);
            PG8_WAIT_V(6); PG8_BAR; PG8_MMA(1, 1, At, B1); PG8_BAR;
            PG8_LDB(B0, 1, 0); PG8_SCHED; PG8_LDA(At, 1, 0); PG8_STAGE(PG8_SA(0, 1), a2 + hstep, voffA);
            PG8_WAIT_L(8); PG8_BAR; PG8_WAIT_L(0); PG8_MMA(0, 0, At, B0); PG8_BAR; PG8_SCHED;
            PG8_LDB(B1, 1, 1); PG8_STAGE(PG8_SB(1, 0), b3, voffB);
            PG8_BAR; PG8_WAIT_L(0); PG8_MMA(0, 1, At, B1); PG8_BAR;
            PG8_LDA(At, 1, 1); PG8_STAGE(PG8_SA(1, 0), a3, voffA);
            PG8_BAR; PG8_WAIT_L(0); PG8_MMA(1, 0, At, B0); PG8_BAR; PG8_SCHED;
            PG8_STAGE(PG8_SB(1, 1), b3 + hstep, voffB);
            PG8_WAIT_V(6); PG8_BAR; PG8_MMA(1, 1, At, B1); PG8_BAR;
            }
        }
        if constexpr (ALIGN_EPI) { if (wr == 0) PG8_BAR; }
        if constexpr (!Epi::AFTER_DRAIN) { E(acc, cur, wr, wc, fr, fq); S.done(cur); }
        if (!has_next) break;
#pragma unroll
        for (int a = 0; a < 2; ++a)
#pragma unroll
            for (int b = 0; b < 2; ++b)
#pragma unroll
                for (int m = 0; m < 4; ++m)
#pragma unroll
                    for (int n = 0; n < 2; ++n) acc[a][b][m][n] = (f32x4){0.f, 0.f, 0.f, 0.f};
        cur = nxt; cA = nA; cB = nB; ++ui;
        if constexpr (ALIGN_EPI) { if (wr == 1) PG8_BAR; }
    }
    PG8_WAIT_V(0);
    if constexpr (!ALIGN_EPI) { if (wr == 0) PG8_BAR; }
    PG8_BAR;
    if constexpr (Epi::AFTER_DRAIN) { E.fused(acc, cur, wr, wc, fr, fq, lds, wid, lane); S.done(cur); }
#undef PG8_SA
#undef PG8_SB
#undef PG8_STAGE
#undef PG8_LDA
#undef PG8_LDB
#undef PG8_MMA
#undef PG8_WAIT_V
#undef PG8_WAIT_L
#undef PG8_BAR
#undef PG8_SCHED
}
}
#define GAS __attribute__((address_space(1)))
#define LAS __attribute__((address_space(3)))
typedef unsigned short bf16;
typedef unsigned char uchar;
typedef float f32x4 __attribute__((ext_vector_type(4)));
typedef float f32x2 __attribute__((ext_vector_type(2)));
typedef float f32x16 __attribute__((ext_vector_type(16)));
typedef short bf16x8 __attribute__((ext_vector_type(8)));
typedef short s16x4 __attribute__((ext_vector_type(4)));
typedef unsigned u32x4 __attribute__((ext_vector_type(4)));
typedef unsigned u32x2 __attribute__((ext_vector_type(2)));
typedef __bf16 hbf16x2 __attribute__((ext_vector_type(2)));
#define DI __device__ __forceinline__

DI unsigned pk2(float a, float b) { f32x2 v = {a, b}; hbf16x2 r = __builtin_convertvector(v, hbf16x2); return __builtin_bit_cast(unsigned, r); }
DI float bf2f(unsigned short b) { return __uint_as_float(((unsigned)b) << 16); }
DI float bflo(unsigned u) { return __uint_as_float(u << 16); }
DI float bfhi(unsigned u) { return __uint_as_float(u & 0xffff0000u); }
DI u32x2 pk4(f32x4 v) { u32x2 r; r.x = pk2(v[0], v[1]); r.y = pk2(v[2], v[3]); return r; }
DI float wave_sum(float v) {
#pragma unroll
    for (int o = 1; o < 64; o <<= 1) v += __shfl_xor(v, o);
    return v;
}
DI float wave_max(float v) {
#pragma unroll
    for (int o = 1; o < 64; o <<= 1) v = fmaxf(v, __shfl_xor(v, o));
    return v;
}
DI float silu_f(float x) { return x * __builtin_amdgcn_rcpf(1.f + __expf(-x)); }
DI float sigmoid_f(float x) { return __builtin_amdgcn_rcpf(1.f + __expf(-x)); }
DI float softplus_f(float x) { return x > 20.f ? x : log1pf(__expf(x)); }
#define LDS_BARRIER() do { asm volatile("s_waitcnt lgkmcnt(0)" ::: "memory"); __builtin_amdgcn_s_barrier(); asm volatile("" ::: "memory"); } while (0)
DI int crow(int r, int h) { return (r & 3) + 8 * (r >> 2) + 4 * h; }
template <class T> DI T ldg(const void* base, unsigned off) { return *(const T*)((const char*)base + off); }
template <class T> DI void stg(void* base, unsigned off, T v) { *(T*)((char*)base + off) = v; }

constexpr int DM = 2048, TP = 4096, NBP = 2, MP = NBP * TP, MS = 32, MALL = MP + MS, DFF = 5632, NGU = 2 * DFF;
constexpr int AQKV = 9216, BIN = 12352, BINM = 12288, CIN = 10304, CINM = 10240;
constexpr float DN_ALPHA = 1.6817928305074290f;
constexpr float LN_EPS = 1e-5f, RMS_EPS = 1e-6f;
constexpr int PASTLEN = 16384;

constexpr size_t O_YP = 0, O_YS = O_YP + (size_t)MP * DM, O_A128P = O_YS + (size_t)MS * DM,
    O_A128S = O_A128P + 1048576, O_A512P = O_A128S + 4194304, O_A512S = O_A512P + 4194304, O_A2048P = O_A512S + 16777216,
    O_A2048S = O_A2048P + 16777216, O_BSSMP = O_A2048S + 67108864, O_BSSMS = O_BSSMP + 1048576, O_BCONVP = O_BSSMS + 4194304,
    O_BCONVS = O_BCONVP + 49152, O_CSSMP = O_BCONVS + 196608, O_CSSMS = O_CSSMP + 1048576, O_CCONVP = O_CSSMS + 4194304,
    O_CCONVS = O_CCONVP + 36864, O_END = O_CCONVS + 147456;

constexpr size_t MiB = 1u << 20;
constexpr size_t WS_CTL = 0, CTL_ZERO_BYTES = 1 * MiB;
constexpr size_t WS_ROPE = 1 * MiB;
constexpr size_t CTL_SPLIT = 65536;
constexpr size_t WS_ZS = 2 * MiB, ZS_ONE = (size_t)MS * DM * 4;
constexpr size_t WS_W = 8 * MiB;
constexpr size_t GU_BYTES = (size_t)NGU * DM * 2, DN_BYTES = (size_t)DM * DFF * 2, FFN_BYTES = GU_BYTES + DN_BYTES;
constexpr size_t WS_WA = WS_W + 8 * FFN_BYTES, AQ_BYTES = (size_t)AQKV * DM * 2, AO_BYTES = (size_t)DM * 1024 * 2, A_BYTES = AQ_BYTES + AO_BYTES;
constexpr size_t WS_WB = WS_WA + 2 * A_BYTES, BI_BYTES = (size_t)BIN * DM * 2, BO_BYTES = (size_t)DM * 4096 * 2;
constexpr size_t WS_WC = WS_WB + BI_BYTES + BO_BYTES, CI_BYTES = (size_t)CIN * DM * 2, CO_BYTES = BO_BYTES;
constexpr size_t WS_XB = WS_WC + CI_BYTES + CO_BYTES;
constexpr size_t WS_ZP = WS_XB + (size_t)MALL * DM * 2;
constexpr size_t WS_H = WS_ZP + (size_t)MP * DM * 4;
constexpr size_t WS_MIX = WS_H + (size_t)MALL * DFF * 2;
constexpr size_t MA_QKV = WS_MIX, MA_QKVS = MA_QKV + (size_t)MP * AQKV * 2, MA_OG = MA_QKVS + (size_t)MS * AQKV * 4,
    MA_LSE = MA_OG + (size_t)3 * MP * 1024 * 2, MA_O = MA_LSE + (size_t)3 * MP * 8 * 4, MA_END = MA_O + (size_t)MALL * 1024 * 2;
constexpr size_t MB_PB = WS_MIX, MB_EB = MB_PB + (size_t)MP * BINM * 2, MB_PBS = MB_EB + (size_t)MP * 64 * 4, MB_WG = MB_PBS + (size_t)MS * BIN * 4,
    MB_UG = MB_WG + (size_t)MP * 32 * 128 * 2, MB_QG = MB_UG + (size_t)MP * 32 * 128 * 2, MB_KG = MB_QG + (size_t)MP * 16 * 128 * 2,
    MB_QKG = MB_KG + (size_t)MP * 16 * 128 * 2, MB_GCG = MB_QKG + (size_t)2 * 32 * 64 * 64 * 64 * 2, MB_YB = MB_GCG + (size_t)MP * 32 * 4,
    MB_SG = MB_YB + (size_t)MALL * 4096 * 2, MB_VNG = MB_SG + (size_t)4096 * 16384 * 2, MB_END = MB_VNG + (size_t)MP * 32 * 128 * 2;
constexpr size_t MC_PC = WS_MIX, MC_EC = MC_PC + (size_t)MP * CINM * 2, MC_PCS = MC_EC + (size_t)MP * 64 * 4, MC_SS = MC_PCS + (size_t)MS * CIN * 4,
    MC_YC = MC_SS + (size_t)MP * 64 * 4, MC_ACS = MC_YC + (size_t)MALL * 4096 * 2, MC_XBC = MC_ACS + (size_t)MP * 64 * 4, MC_END = MC_XBC + (size_t)MP * 6144 * 2;
constexpr size_t WS_SLAB = (MB_END > MA_END ? (MB_END > MC_END ? MB_END : MC_END) : (MA_END > MC_END ? MA_END : MC_END));
constexpr size_t WS_END_OLD = (MB_END > MA_END ? (MB_END > MC_END ? MB_END : MC_END) : (MA_END > MC_END ? MA_END : MC_END));
constexpr size_t WS_END = WS_SLAB + (size_t)128 * 65536 * 4;
static_assert(CTL_SPLIT + 10 * 128 * 256 <= CTL_ZERO_BYTES && WS_SLAB % 256 == 0, "split");
static_assert(MA_QKVS % 256 == 0 && MA_OG % 256 == 0 && MA_O % 256 == 0 && MB_EB % 256 == 0 && MB_WG % 256 == 0 && MB_YB % 256 == 0 && MC_YC % 256 == 0 && WS_MIX % 256 == 0, "alignment");

constexpr int CW_BAR = 4096;
constexpr int SCR_BYTES = 143360, MISC_OFF = SCR_BYTES, LDS_BYTES = 147456;
constexpr int NWAVES = 8;

struct WDesc { int in_idx; unsigned src_off; size_t dst_off; int K, N, mode, item0; };
constexpr int NWD = 24;
struct WTab { WDesc d[NWD]; int nitems; int slot[16][4]; int cc[16][2]; };
constexpr int CC_PER0 = 124 * 512, CC_PER1 = 508 * 512, CC_PER2 = 2044 * 512, CC_T0 = 16 * CC_PER0, CC_T1 = CC_T0 + 16 * CC_PER1, CC_TOT = CC_T1 + 16 * CC_PER2;
constexpr WTab make_wtab() {
    WTab t{}; int nd = 0, items = 0;
    auto add = [&](int in_idx, size_t src_off, size_t dst_off, int K, int N, int mode) { t.d[nd].in_idx = in_idx; t.d[nd].src_off = (unsigned)src_off; t.d[nd].dst_off = dst_off; t.d[nd].K = K; t.d[nd].N = N; t.d[nd].mode = mode; t.d[nd].item0 = items; items += (K / 64) * (N / 64); ++nd; };
    auto ffn = [&](int hl) { const int L = hl >> 1, wh = hl & 1;
        add(wh ? 13 : 11, (size_t)L * DM * NGU, WS_W + (size_t)hl * FFN_BYTES, DM, NGU, 1);
        add(wh ? 14 : 12, (size_t)L * DFF * DM, WS_W + (size_t)hl * FFN_BYTES + GU_BYTES, DFF, DM, 0); };
    auto mixa = [&](int j) { add(15, (size_t)j * DM * AQKV, WS_WA + (size_t)j * A_BYTES, DM, AQKV, 0); add(16, (size_t)j * 1024 * DM, WS_WA + (size_t)j * A_BYTES + AQ_BYTES, 1024, DM, 0); };
    ffn(0); mixa(0); ffn(1); ffn(2); const int b0 = items; add(17, 0, WS_WB, DM, BIN, 0); add(22, 0, WS_WB + BI_BYTES, 4096, DM, 0); const int b1 = items;
    ffn(3); ffn(4); add(23, 0, WS_WC, DM, CIN, 0); add(30, 0, WS_WC + CI_BYTES, 4096, DM, 0); ffn(5); ffn(6); mixa(1); ffn(7);
    t.nitems = items;
    const int HS = 2750;
    int cur = 0;
    auto take = [&](int k, int upto) { t.slot[k][0] = cur; t.slot[k][1] = upto; cur = upto; };
    const int eA0 = t.d[4].item0, eF2 = b0;
    take(0, eA0 - HS); take(1, eA0);
    take(2, eA0 + HS);
    take(3, eF2 - HS);
    t.slot[3][2] = b0 + HS; t.slot[3][3] = b1;
    take(4, eF2);
    t.slot[5][0] = b0; t.slot[5][1] = b0 + HS; cur = b1;
    const int e5 = t.d[16].item0;
    take(6, e5 + 5000); take(7, e5 + 5000 + HS); take(8, e5 + 5000 + 2 * HS); take(9, items);
    const int fr[8] = {0, 25, 55, 64, 73, 82, 91, 100};
    const int ks[7] = {6, 9, 10, 11, 12, 14, 13};
    for (int i = 0; i < 7; ++i) { t.cc[ks[i]][0] = (int)((long)CC_TOT * fr[i] / 100); t.cc[ks[i]][1] = (int)((long)CC_TOT * fr[i + 1] / 100); }
    return t;
}
static __device__ const WTab g_wtab = make_wtab();
struct Args { const float* in[31]; float* out; unsigned char* ws; };

struct Frame {
    LAS uchar* lds;
    int tid, lane, wave, G, gw, NGW, bid;
};
#define XB_TMO      128
#define XB_XCNT(j)  (256  + 64 * (j))
#define XB_XSUB(j)  (1280 + 64 * (j))
#define XB_XGEN(j)  (2304 + 64 * (j))
#define XB_TOP      3328
#define XB_TOPGEN   3392
#define XCD_BAR_WORDS 3456
#define XB_SPIN_CAP (1u << 18)

__device__ __forceinline__ unsigned xb_ld(unsigned* p)              { return __hip_atomic_load(p, __ATOMIC_RELAXED, __HIP_MEMORY_SCOPE_AGENT); }
__device__ __forceinline__ unsigned xb_add(unsigned* p, unsigned v) { return __hip_atomic_fetch_add(p, v, __ATOMIC_RELAXED, __HIP_MEMORY_SCOPE_AGENT); }
__device__ __forceinline__ unsigned xb_xcc_id() { return (unsigned)__builtin_amdgcn_s_getreg((3 << 11) | 20) & 0xFu; }
#define XB_SPIN(cond, bar) do { unsigned _sp = 0; while (cond) { __builtin_amdgcn_s_sleep(1); \
    if ((++_sp & 255u) == 0u) { if (xb_ld(&(bar)[XB_TMO])) break; if (_sp > XB_SPIN_CAP) { atomicAdd(&(bar)[XB_TMO], 1u); break; } } } } while (0)

struct XcdBarrier {
    unsigned* bar; unsigned x;
    volatile LAS unsigned* st;
};

__device__ __forceinline__ XcdBarrier xcd_barrier_post(unsigned* bar, volatile LAS unsigned* st) {
    XcdBarrier b; b.bar = bar; b.x = xb_xcc_id(); b.st = st;
    if (threadIdx.x == 0) (void)xb_add(&bar[XB_XCNT(b.x)], 1u);
    return b;
}
__device__ __forceinline__ void xcd_barrier_complete(unsigned* bar, unsigned x, unsigned& nloc, unsigned& nx) {
    const unsigned G = gridDim.x * gridDim.y * gridDim.z;
    unsigned sum, cnt, mine, sp = 0u;
    for (;;) {
        sum = 0u; cnt = 0u; mine = 0u;
#pragma unroll
        for (unsigned j = 0; j < 16; ++j) { const unsigned c = xb_ld(&bar[XB_XCNT(j)]); sum += c; cnt += (c > 0u) ? 1u : 0u; mine = (j == x) ? c : mine; }
        if (sum == G) break;
        __builtin_amdgcn_s_sleep(1);
        if ((++sp & 255u) == 0u) { if (xb_ld(&bar[XB_TMO])) break; if (sp > XB_SPIN_CAP) { atomicAdd(&bar[XB_TMO], 1u); break; } }
    }
    nloc = mine > 0u ? mine : 1u; nx = cnt > 0u ? cnt : 1u;
}

__device__ __forceinline__ void xcd_barrier(const XcdBarrier& b) {
    asm volatile("s_waitcnt vmcnt(0)" ::: "memory");
    __syncthreads();
    if (threadIdx.x == 0) {
        unsigned* bar = b.bar;
        __builtin_amdgcn_s_waitcnt(0);
        unsigned nloc = b.st[0], nx = b.st[1];
        if (nloc == 0u) { xcd_barrier_complete(bar, b.x, nloc, nx); b.st[0] = nloc; b.st[1] = nx; }
        const unsigned old = xb_add(&bar[XB_XSUB(b.x)], 1u);
        const unsigned gen = old / nloc;
        if (old + 1u == (gen + 1u) * nloc) {
            __builtin_amdgcn_fence(__ATOMIC_RELEASE, "agent");
            asm volatile("s_waitcnt vmcnt(0)" ::: "memory");
            const unsigned og = xb_add(&bar[XB_TOP], 1u);
            const unsigned tg = og / nx;
            if (og + 1u == (tg + 1u) * nx) xb_add(&bar[XB_TOPGEN], 1u);
            else XB_SPIN(xb_ld(&bar[XB_TOPGEN]) == tg, bar);
            __builtin_amdgcn_fence(__ATOMIC_ACQUIRE, "agent");
            xb_add(&bar[XB_XGEN(b.x)], 1u);
            asm volatile("s_waitcnt vmcnt(0)" ::: "memory");
        } else {
            XB_SPIN(xb_ld(&bar[XB_XGEN(b.x)]) == gen, bar);
            __builtin_amdgcn_fence(__ATOMIC_ACQUIRE, "agent");
            asm volatile("s_waitcnt vmcnt(0)" ::: "memory");
        }
    }
    __syncthreads();
}
#define MFMA32(a, b, c) __builtin_amdgcn_mfma_f32_32x32x16_bf16((a), (b), (c), 0, 0, 0)
DI s16x4 lds_tr(LAS const uchar* p) { return __builtin_amdgcn_ds_read_tr16_b64_v4i16((LAS s16x4*)p); }
DI bf16x8 frag_xk(LAS const uchar* base, int ld, int x0, int k0, int lane) {
    return *(LAS const bf16x8*)(base + (x0 + (lane & 31)) * ld + (k0 + 8 * (lane >> 5)) * 2);
}
DI bf16x8 frag_kx(LAS const uchar* base, int ld, int x0, int k0, int lane) {
    const int h = lane >> 5, blk = (lane >> 4) & 1, q = (lane & 15) >> 2, p = lane & 3;
    LAS const uchar* a = base + (k0 + 8 * h + q) * ld + (x0 + 16 * blk + 4 * p) * 2;
    const s16x4 lo = lds_tr(a), hi = lds_tr(a + 4 * ld);
    return __builtin_shufflevector(lo, hi, 0, 1, 2, 3, 4, 5, 6, 7);
}
DI bf16x8 frag_kx_perm(LAS const uchar* base, int ld, int x0, int k0, int lane) {
    const int h = lane >> 5, blk = (lane >> 4) & 1, q = (lane & 15) >> 2, p = lane & 3;
    LAS const uchar* a = base + (k0 + 4 * h + q) * ld + (x0 + 16 * blk + 4 * p) * 2;
    const s16x4 lo = lds_tr(a), hi = lds_tr(a + 8 * ld);
    return __builtin_shufflevector(lo, hi, 0, 1, 2, 3, 4, 5, 6, 7);
}
DI bf16x8 pack_step(const f32x16& x, int s) {
    u32x4 p;
    p.x = pk2(x[8 * s + 0], x[8 * s + 1]); p.y = pk2(x[8 * s + 2], x[8 * s + 3]); p.z = pk2(x[8 * s + 4], x[8 * s + 5]); p.w = pk2(x[8 * s + 6], x[8 * s + 7]);
    return __builtin_bit_cast(bf16x8, p);
}
DI f32x16 zero16() { f32x16 z;
#pragma unroll
    for (int i = 0; i < 16; ++i) z[i] = 0.f; return z; }
template <bool A_KX, bool B_KX>
DI f32x16 mm_tile(f32x16 acc, LAS const uchar* A, int lda, int am0, LAS const uchar* B, int ldb, int bn0, int ksteps, int lane) {
#pragma unroll 4
    for (int s = 0; s < ksteps; ++s) {
        const bf16x8 a = A_KX ? frag_kx(A, lda, am0, 16 * s, lane) : frag_xk(A, lda, am0, 16 * s, lane);
        const bf16x8 b = B_KX ? frag_kx(B, ldb, bn0, 16 * s, lane) : frag_xk(B, ldb, bn0, 16 * s, lane);
        acc = MFMA32(a, b, acc);
    }
    return acc;
}

struct FSwiglu {
    bf16* H;
    DI void operator()(int row, int col, f32x4 lo, f32x4 hi) const {
        f32x4 r;
#pragma unroll
        for (int e = 0; e < 4; ++e) r[e] = silu_f(lo[e]) * hi[e];
        *(u32x2*)(H + (size_t)row * DFF + ((col >> 5) << 4) + (col & 15)) = pk4(r);
    }
};
struct FResid {
    const bf16* XB; float* Z; long zrow_off; float s; int atomic, add_x;
    DI void operator()(int row, int col, f32x4 lo, f32x4 hi) const {
        float* zp = Z + ((long)row - zrow_off) * DM + col;
        f32x4 a = lo * s, b = hi * s;
        if (add_x) {
            const u32x2 x0 = *(const u32x2*)(XB + (size_t)row * DM + col), x1 = *(const u32x2*)(XB + (size_t)row * DM + col + 16);
            a[0] += bflo(x0.x) * DN_ALPHA; a[1] += bfhi(x0.x) * DN_ALPHA; a[2] += bflo(x0.y) * DN_ALPHA; a[3] += bfhi(x0.y) * DN_ALPHA;
            b[0] += bflo(x1.x) * DN_ALPHA; b[1] += bfhi(x1.x) * DN_ALPHA; b[2] += bflo(x1.y) * DN_ALPHA; b[3] += bfhi(x1.y) * DN_ALPHA;
        }
        if (atomic) {
#pragma unroll
            for (int e = 0; e < 4; ++e) { atomicAdd(zp + e, a[e]); atomicAdd(zp + 16 + e, b[e]); }
        } else { *(f32x4*)zp = a; *(f32x4*)(zp + 16) = b; }
    }
};
struct FBf16 {
    bf16* P; int ld;
    DI void operator()(int row, int col, f32x4 lo, f32x4 hi) const {
        bf16* p = P + (size_t)row * ld + col;
        *(u32x2*)p = pk4(lo); *(u32x2*)(p + 16) = pk4(hi);
    }
};
struct FF32 {
    float* P; int ld, row_off, col_off;
    DI void operator()(int row, int col, f32x4 lo, f32x4 hi) const {
        float* p = P + (size_t)(row - row_off) * ld + (col - col_off);
        *(f32x4*)p = lo; *(f32x4*)(p + 16) = hi;
    }
};
struct FQkv {
    bf16* QKV; float* QKVS; const float* rope; float* out; int j;
    DI void operator()(int row, int col, f32x4 lo, f32x4 hi) const {
        const int s = col / 3072, rem = col - s * 3072, g = rem >> 10, hh = (rem >> 7) & 7, d = rem & 127;
        const bool smp = row >= MP;
        const int pidx = smp ? TP + ((row - MP) & 3) : (row & (TP - 1));
        if (s < 2 && d < 16) {
            const f32x4 c = *(const f32x4*)(rope + (size_t)pidx * 32 + d), sn = *(const f32x4*)(rope + (size_t)pidx * 32 + 16 + d);
            const f32x4 x1 = lo, x2 = hi;
            lo = x1 * c - x2 * sn; hi = x2 * c + x1 * sn;
        }
        const int keep = 128 << (2 * g);
        if (!smp) {
            bf16* p = QKV + (size_t)row * AQKV + col;
            *(u32x2*)p = pk4(lo); *(u32x2*)(p + 16) = pk4(hi);
            if (s >= 1) {
                const int t = row & (TP - 1), b = row >> 12;
                if (t >= TP - keep) {
                    float* dst = out + (g == 0 ? O_A128P : g == 1 ? O_A512P : O_A2048P) + ((((size_t)(j * NBP + b) * keep + (t - (TP - keep))) * 2 + (s - 1)) * 8 + hh) * 128 + d;
                    *(f32x4*)dst = lo; *(f32x4*)(dst + 16) = hi;
                }
            }
        } else {
            const int r = row - MP, b = r >> 2, t = r & 3;
            float* p = QKVS + (size_t)r * AQKV + col;
            *(f32x4*)p = lo; *(f32x4*)(p + 16) = hi;
            if (s >= 1) {
                float* dst = out + (g == 0 ? O_A128S : g == 1 ? O_A512S : O_A2048S) + ((((size_t)(j * 8 + b) * keep + (keep - 4 + t)) * 2 + (s - 1)) * 8 + hh) * 128 + d;
                *(f32x4*)dst = lo; *(f32x4*)(dst + 16) = hi;
            }
        }
    }
};
template <class F> struct EpiWrap {
    static constexpr bool PERM = false, AFTER_DRAIN = false;
    F f;
    DI void operator()(const pg8::f32x4 (&acc)[2][2][4][2], const pg8::Unit& u, int wr, int wc, int fr, int fq) const {
#pragma unroll
        for (int ai = 0; ai < 2; ++ai)
#pragma unroll
            for (int m = 0; m < 4; ++m) {
                const int row = u.pm * 256 + ai * 128 + wr * 64 + m * 16 + fr;
#pragma unroll
                for (int bj = 0; bj < 2; ++bj) f(row, u.pn * 256 + bj * 128 + wc * 32 + 4 * fq, acc[ai][bj][m][0], acc[ai][bj][m][1]);
            }
    }
};


struct EpiSplitPartner {
    static constexpr bool PERM = false, AFTER_DRAIN = false;
    float* slab; unsigned* cnt;
    DI void operator()(const pg8::f32x4 (&acc)[2][2][4][2], const pg8::Unit&, int wr, int wc, int fr, int fq) const {
        const int t = (wr * 4 + wc) * 64 + fq * 16 + fr;
        __amdgpu_buffer_rsrc_t rs = __builtin_amdgcn_make_buffer_rsrc(slab, 0, 65536 * 4, 0x00020000);
#pragma unroll
        for (int ai = 0; ai < 2; ++ai)
#pragma unroll
            for (int bj = 0; bj < 2; ++bj)
#pragma unroll
                for (int m = 0; m < 4; ++m)
#pragma unroll
                    for (int n = 0; n < 2; ++n) {
                        const int q = ((ai * 2 + bj) * 4 + m) * 2 + n;
                        __builtin_amdgcn_raw_buffer_store_b128(__builtin_bit_cast(u32x4, acc[ai][bj][m][n]), rs, (q * 512 + t) * 16, 0, 16);
                    }
        asm volatile("s_waitcnt vmcnt(0)" ::: "memory");
        if (fq == 0 && fr == 0) __hip_atomic_fetch_add(cnt, 1u, __ATOMIC_RELAXED, __HIP_MEMORY_SCOPE_AGENT);
    }
};
template <class F> struct EpiSplitOwner {
    static constexpr bool PERM = false, AFTER_DRAIN = false;
    F f; const float* slab; unsigned* cnt;
    DI void operator()(const pg8::f32x4 (&acc)[2][2][4][2], const pg8::Unit& u, int wr, int wc, int fr, int fq) const {
        const int t = (wr * 4 + wc) * 64 + fq * 16 + fr;
        {
            const unsigned long long t0 = __builtin_amdgcn_s_memrealtime();
            while (__hip_atomic_load(cnt, __ATOMIC_RELAXED, __HIP_MEMORY_SCOPE_AGENT) < 8u) {
                __builtin_amdgcn_s_sleep(2);
                if (__builtin_amdgcn_s_memrealtime() - t0 > 5000000ull) break;
            }
            asm volatile("" ::: "memory");
        }
        __amdgpu_buffer_rsrc_t rs = __builtin_amdgcn_make_buffer_rsrc(const_cast<float*>(slab), 0, 65536 * 4, 0x00020000);
#pragma unroll
        for (int ai = 0; ai < 2; ++ai)
#pragma unroll
            for (int m = 0; m < 4; ++m) {
                const int row = u.pm * 256 + ai * 128 + wr * 64 + m * 16 + fr;
#pragma unroll
                for (int bj = 0; bj < 2; ++bj) {
                    const int q0 = ((ai * 2 + bj) * 4 + m) * 2;
                    const f32x4 p0 = __builtin_bit_cast(f32x4, __builtin_amdgcn_raw_buffer_load_b128(rs, (q0 * 512 + t) * 16, 0, 16));
                    const f32x4 p1 = __builtin_bit_cast(f32x4, __builtin_amdgcn_raw_buffer_load_b128(rs, ((q0 + 1) * 512 + t) * 16, 0, 16));
                    f(row, u.pn * 256 + bj * 128 + wc * 32 + 4 * fq, acc[ai][bj][m][0] + p0, acc[ai][bj][m][1] + p1);
                }
            }
    }
};
struct OneUnit {
    int pm, pn; bool valid;
    DI bool next(int i, pg8::Unit& u) const { if (i != 0 || !valid) return false; u.pm = pm; u.pn = pn; return true; }
    DI void a_ready(const pg8::Unit&) const {}
    DI void done(const pg8::Unit&) const {}
};
struct CappedOrder {
    pg8::StaticOrder S; int cap;
    DI bool next(int i, pg8::Unit& u) const { if ((long)i * S.G + S.c >= cap) return false; return S.next(i, u); }
    DI void a_ready(const pg8::Unit&) const {}
    DI void done(const pg8::Unit&) const {}
};
template <int NF, class F>
DI void skinny_unit(const Frame& Fr, const bf16* A, int lda, int row0, const bf16* Wt, int K, int f0, int kbeg, int klen, const F& f) {
    const int lane = Fr.lane, w = Fr.wave, h = lane >> 5;
    constexpr int LDW = 144;
    LAS uchar* Bl = Fr.lds + w * ((1 + NF) * 32 * LDW); LAS uchar* Al = Bl + 32 * LDW;
    const int nch = klen >> 6, lr = lane >> 3, lc = lane & 7;
    f32x16 acc[NF];
#pragma unroll
    for (int nf = 0; nf < NF; ++nf) acc[nf] = zero16();
    const unsigned bo = (unsigned)(((row0 + lr) * lda + kbeg + 8 * lc) * 2), ao = (unsigned)(((f0 + lr) * K + kbeg + 8 * lc) * 2);
    u32x4 pb[4], pa[NF][4];
    int c = w;
    if (c < nch) {
#pragma unroll
        for (int i = 0; i < 4; ++i) { pb[i] = ldg<u32x4>(A, bo + (unsigned)((8 * i * lda + 64 * c) * 2));
#pragma unroll
            for (int nf = 0; nf < NF; ++nf) pa[nf][i] = ldg<u32x4>(Wt, ao + (unsigned)(((32 * nf + 8 * i) * K + 64 * c) * 2)); }
    }
#pragma unroll 1
    for (; c < nch; c += 8) {
#pragma unroll
        for (int i = 0; i < 4; ++i) { *(LAS u32x4*)(Bl + (lr + 8 * i) * LDW + lc * 16) = pb[i];
#pragma unroll
            for (int nf = 0; nf < NF; ++nf) *(LAS u32x4*)(Al + nf * (32 * LDW) + (lr + 8 * i) * LDW + lc * 16) = pa[nf][i]; }
        const int cn = c + 8;
        if (cn < nch) {
#pragma unroll
            for (int i = 0; i < 4; ++i) { pb[i] = ldg<u32x4>(A, bo + (unsigned)((8 * i * lda + 64 * cn) * 2));
#pragma unroll
                for (int nf = 0; nf < NF; ++nf) pa[nf][i] = ldg<u32x4>(Wt, ao + (unsigned)(((32 * nf + 8 * i) * K + 64 * cn) * 2)); }
        }
#pragma unroll
        for (int s = 0; s < 4; ++s) {
            const bf16x8 b = frag_xk(Bl, LDW, 0, 16 * s, lane);
#pragma unroll
            for (int nf = 0; nf < NF; ++nf) acc[nf] = MFMA32(frag_xk(Al + nf * (32 * LDW), LDW, 0, 16 * s, lane), b, acc[nf]);
        }
    }
    __syncthreads();
    LAS float* red = (LAS float*)Fr.lds;
#pragma unroll
    for (int nf = 0; nf < NF; ++nf)
#pragma unroll
        for (int i = 0; i < 16; ++i) red[((w * NF + nf) * 16 + i) * 64 + lane] = acc[nf][i];
    __syncthreads();
    if (w < 2 * NF) {
        const int nf = w >> 1, g = w & 1, r = lane & 31;
        f32x4 lo = {0.f, 0.f, 0.f, 0.f}, hi = {0.f, 0.f, 0.f, 0.f};
#pragma unroll
        for (int ww = 0; ww < 8; ++ww)
#pragma unroll
            for (int e = 0; e < 4; ++e) {
                lo[e] += red[((ww * NF + nf) * 16 + 4 * g + e) * 64 + lane];
                hi[e] += red[((ww * NF + nf) * 16 + 4 * g + 8 + e) * 64 + lane];
            }
        f(row0 + r, f0 + 32 * nf + 8 * g + 4 * h, lo, hi);
    }
    __syncthreads();
}
DI void tr_item(const WDesc& d, const float* dsrc, bf16* ddst, int item, LAS float* scr, int lane) {
    const int nnt = d.N >> 6, kt = item / nnt, nt = item - kt * nnt, k0 = kt << 6, n0 = nt << 6;
    const float* src = dsrc + (size_t)k0 * d.N + n0 + 4 * (lane & 15);
#pragma unroll 8
    for (int i = 0; i < 16; ++i) {
        const int kk = 4 * i + (lane >> 4);
        const f32x4 v = *(const f32x4*)(src + (size_t)kk * d.N);
        LAS float* s = scr + kk * 65 + 4 * (lane & 15);
        s[0] = v[0]; s[1] = v[1]; s[2] = v[2]; s[3] = v[3];
    }
    asm volatile("s_waitcnt lgkmcnt(0)" ::: "memory");
    const int c = lane & 7;
#pragma unroll
    for (int j = 0; j < 8; ++j) {
        const int n = (lane >> 3) + 8 * j;
        LAS const float* s = scr + (8 * c) * 65 + n;
        u32x4 o; o.x = pk2(s[0], s[65]); o.y = pk2(s[2 * 65], s[3 * 65]); o.z = pk2(s[4 * 65], s[5 * 65]); o.w = pk2(s[6 * 65], s[7 * 65]);
        const int ns = n0 + n;
        int drow = ns;
        if (d.mode == 1) { const int jj = ns < DFF ? ns : ns - DFF; drow = ((jj >> 4) << 5) + (ns < DFF ? 0 : 16) + (jj & 15); }
        *(u32x4*)(ddst + (size_t)drow * d.K + k0 + 8 * c) = o;
    }
    asm volatile("s_waitcnt lgkmcnt(0)" ::: "memory");
}
DI void convert_items(const Frame& F, const Args& a, int i0, int i1, int gw, int ngw) {
    LAS float* scr = (LAS float*)(F.lds + F.wave * 16640);
    for (int it = i0 + gw; it < i1; it += ngw) {
        int m = 0;
#pragma unroll 1
        for (int q = 1; q < NWD; ++q) if (it >= g_wtab.d[q].item0) m = q;
        const WDesc d = g_wtab.d[m];
        tr_item(d, a.in[d.in_idx] + d.src_off, (bf16*)(a.ws + d.dst_off), it - d.item0, scr, F.lane);
    }
}
DI void cache_copy(const Args& a, int f0, int f1, int gt, int nt) {
    for (int i = f0 + gt; i < f1; i += nt) {
        const int g = i < CC_T0 ? 0 : i < CC_T1 ? 1 : 2;
        const int li = i - (g == 0 ? 0 : g == 1 ? CC_T0 : CC_T1), per = g == 0 ? CC_PER0 : g == 1 ? CC_PER1 : CC_PER2, wb = 128 << (2 * g);
        const int blk = li / per, o = li - blk * per;
        const float* src = g == 0 ? a.in[2] : g == 1 ? a.in[3] : a.in[4];
        float* dst = a.out + (g == 0 ? O_A128S : g == 1 ? O_A512S : O_A2048S);
        const size_t base = (size_t)blk * wb * 2048;
        *(f32x4*)(dst + base + (size_t)o * 4) = *(const f32x4*)(src + base + 8192 + (size_t)o * 4);
    }
}
DI void bg_slot(const Frame& F, const Args& a, int k, int first) {
    if (F.bid < first || F.G <= first) return;
    const int gw = (F.bid - first) * NWAVES + F.wave, ngw = (F.G - first) * NWAVES;
    convert_items(F, a, g_wtab.slot[k][0], g_wtab.slot[k][1], gw, ngw);
    convert_items(F, a, g_wtab.slot[k][2], g_wtab.slot[k][3], gw, ngw);
    cache_copy(a, g_wtab.cc[k][0], g_wtab.cc[k][1], gw * 64 + F.lane, ngw * 64);
}
DI void prologue(const Frame& F, const Args& a) {
    uchar* ws = a.ws;
    convert_items(F, a, g_wtab.slot[0][0], g_wtab.slot[0][1], F.gw, F.NGW);
    const int gt = F.gw * 64 + F.lane, NT = F.NGW * 64;
    {
        float* rope = (float*)(ws + WS_ROPE);
        for (int i = gt; i < 4100 * 16; i += NT) {
            const int pidx = i >> 4, f = i & 15;
            const int pos = pidx < TP ? pidx : PASTLEN + (pidx - TP);
            const float inv = (float)exp2(-(double)f * (18.931568569324174 / 16.0));
            const float ang = (float)pos * inv;
            const double rev = (double)ang * 0.15915494309189535;
            const float fr = (float)(rev - floor(rev));
            rope[(size_t)pidx * 32 + f] = __builtin_amdgcn_cosf(fr);
            rope[(size_t)pidx * 32 + 16 + f] = __builtin_amdgcn_sinf(fr);
        }
    }
    { f32x4* z = (f32x4*)(ws + WS_ZS); const f32x4 zz = {0.f, 0.f, 0.f, 0.f}; for (int i = gt; i < (int)(12 * ZS_ONE / 16); i += NT) z[i] = zz; }
    {
        bf16* XB = (bf16*)(ws + WS_XB);
        for (int i = gt; i < MALL * DM / 4; i += NT) {
            const size_t e = (size_t)i * 4;
            const f32x4 v = e < (size_t)MP * DM ? *(const f32x4*)(a.in[0] + e) : *(const f32x4*)(a.in[1] + (e - (size_t)MP * DM));
            *(u32x2*)(XB + e) = pk4(v);
        }
    }
}

DI void ln_phase(const Frame& F, const float* Zp, const float* Zs, const float* g, const float* b, float* Xf  , bf16* XB) {
    f32x4 gv[8], bv[8];
#pragma unroll
    for (int j = 0; j < 8; ++j) { gv[j] = *(const f32x4*)(g + 4 * F.lane + 256 * j); bv[j] = *(const f32x4*)(b + 4 * F.lane + 256 * j); }
    for (int row = F.gw; row < MALL; row += F.NGW) {
        const float* z = row < MP ? Zp + (size_t)row * DM : Zs + (size_t)(row - MP) * DM;
        f32x4 v[8]; float s = 0.f;
#pragma unroll
        for (int j = 0; j < 8; ++j) { v[j] = *(const f32x4*)(z + 4 * F.lane + 256 * j); s += (v[j][0] + v[j][1]) + (v[j][2] + v[j][3]); }
        const float mean = wave_sum(s) * (1.f / DM); float s2 = 0.f;
#pragma unroll
        for (int j = 0; j < 8; ++j) { v[j] = v[j] - mean; s2 += (v[j][0] * v[j][0] + v[j][1] * v[j][1]) + (v[j][2] * v[j][2] + v[j][3] * v[j][3]); }
        const float rstd = 1.f / sqrtf(wave_sum(s2) * (1.f / DM) + LN_EPS);
        bf16* xb = XB + (size_t)row * DM + 4 * F.lane;
#pragma unroll
        for (int j = 0; j < 8; ++j) { const f32x4 y = v[j] * rstd * gv[j] + bv[j]; *(u32x2*)(xb + 256 * j) = pk4(y); if (Xf) *(f32x4*)(Xf + (size_t)row * DM + 4 * F.lane + 256 * j) = y; }
    }
}
DI void attn_prompt_unit(const Frame& F, int u, const bf16* QKV, bf16* OG, float* LSE, bf16* O) {
    const int b = u >> 7, hd = (u >> 4) & 7, ck = u & 15;
    const int lane = F.lane, w = F.wave, qi = lane & 31, h = lane >> 5;
    constexpr int LDV = 272;
    LAS uchar* Vl = F.lds + w * (64 * LDV); LAS uchar* Kl = Vl + 32 * LDV;
    const float SC = 0.08838834764831845f * 1.4426950408889634f;
    for (int it = 0; it < 4; ++it) {
        const int tl = w + 8 * it, g = tl < 8 ? 0 : tl < 16 ? 1 : 2, idx = tl < 16 ? (tl & 7) : tl - 16;
        const int dil = 1 << (2 * g);
        int r, Lb, nq = 32;
        if (g == 0) { r = 0; Lb = ck * 256 + 32 * idx; } else if (g == 1) { r = idx & 3; Lb = ck * 64 + 32 * (idx >> 2); } else { r = idx; Lb = ck * 16; nq = 16; }
        const int qv = qi < nq ? qi : nq - 1;
        const int rowb = b * TP;
        const int colQ = g * 1024 + hd * 128, colK = 3072 + colQ, colV = 6144 + colQ;
        bf16x8 qf[8];
        {
            const unsigned qo = (unsigned)(((rowb + r + dil * (Lb + qv)) * AQKV + colQ + 8 * h) * 2);
#pragma unroll
            for (int s = 0; s < 8; ++s) qf[s] = ldg<bf16x8>(QKV, qo + 32 * s);
        }
        f32x16 st[5];
#pragma unroll
        for (int kb = 0; kb < 5; ++kb) {
#pragma unroll
            for (int i = 0; i < 8; ++i) {
                const int cid = lane + 64 * i, key = cid >> 4, ch = cid & 15;
                int Lk = Lb - 128 + 32 * kb + key; if (Lk < 0) Lk = 0; if (Lk > Lb + nq - 1) Lk = Lb + nq - 1;
                const u32x4 v = ldg<u32x4>(QKV, (unsigned)(((rowb + r + dil * Lk) * AQKV + colK + 8 * ch) * 2));
                *(LAS u32x4*)(Kl + key * LDV + ch * 16) = v;
            }
            f32x16 acc = zero16();
#pragma unroll
            for (int s = 0; s < 8; ++s) { const bf16x8 kf = frag_xk(Kl, LDV, 0, 16 * s, lane); acc = MFMA32(kf, qf[s], acc); }
            st[kb] = acc;
        }
        float m = -INFINITY;
        {
            int lo = qv; if (128 - Lb > lo) lo = 128 - Lb;
            const int a0 = 4 * h - lo, b0 = 128 + qv - 4 * h;
#pragma unroll
            for (int kb = 0; kb < 5; ++kb)
#pragma unroll
                for (int i = 0; i < 16; ++i) {
                    const int cst = 32 * kb + (i & 3) + 8 * (i >> 2);
                    const unsigned msk = (unsigned)(((a0 + cst) | (b0 - cst)) >> 31);
                    const unsigned xb = __float_as_uint(st[kb][i] * SC);
                    const float sv = __uint_as_float((xb & ~msk) | (0xff800000u & msk));
                    st[kb][i] = sv; m = fmaxf(m, sv);
                }
        }
        m = fmaxf(m, __shfl_xor(m, 32));
        float l = 0.f;
#pragma unroll
        for (int kb = 0; kb < 5; ++kb)
#pragma unroll
            for (int i = 0; i < 16; ++i) { const float p = exp2f(st[kb][i] - m); st[kb][i] = p; l += p; }
        l += __shfl_xor(l, 32);
        f32x16 ot[4];
#pragma unroll
        for (int c = 0; c < 4; ++c) ot[c] = zero16();
#pragma unroll
        for (int kb = 0; kb < 5; ++kb) {
#pragma unroll
            for (int i = 0; i < 8; ++i) {
                const int cid = lane + 64 * i, key = cid >> 4, ch = cid & 15;
                int Lk = Lb - 128 + 32 * kb + key; if (Lk < 0) Lk = 0; if (Lk > Lb + nq - 1) Lk = Lb + nq - 1;
                const u32x4 v = ldg<u32x4>(QKV, (unsigned)(((rowb + r + dil * Lk) * AQKV + colV + 8 * ch) * 2));
                *(LAS u32x4*)(Vl + key * LDV + ch * 16) = v;
            }
#pragma unroll
            for (int s = 0; s < 2; ++s) {
                const bf16x8 pb = pack_step(st[kb], s);
#pragma unroll
                for (int c = 0; c < 4; ++c) { const bf16x8 af = frag_kx_perm(Vl, LDV, 32 * c, 16 * s, lane); ot[c] = MFMA32(af, pb, ot[c]); }
            }
        }
        const float rl = 1.f / l;
        const int orow = rowb + r + dil * (Lb + qv);
        if (qi < nq) {
        const unsigned oo = (unsigned)((((g * MP + orow) * 1024) + hd * 128 + 4 * h) * 2);
#pragma unroll
        for (int c = 0; c < 4; ++c)
#pragma unroll
            for (int gq = 0; gq < 4; ++gq) {
                f32x4 v = {ot[c][4 * gq] * rl, ot[c][4 * gq + 1] * rl, ot[c][4 * gq + 2] * rl, ot[c][4 * gq + 3] * rl};
                stg<u32x2>(OG, oo + (32 * c + 8 * gq) * 2, pk4(v));
            }
        if (h == 0) stg<float>(LSE, (unsigned)(((g * MP + orow) * 8 + hd) * 4), (m + log2f(l)) * 0.6931471805599453f);
        }
    }
    asm volatile("s_waitcnt vmcnt(0)" ::: "memory");
    __syncthreads();
    __builtin_amdgcn_fence(__ATOMIC_ACQUIRE, "agent");
    const int l16 = F.tid & 15;
#pragma unroll 2
    for (int it = 0; it < 8; ++it) {
        const int tok = ck * 256 + (F.tid >> 4) + 32 * it;
        const int row = b * TP + tok;
        const float l0 = ldg<float>(LSE, (unsigned)((row * 8 + hd) * 4)), l1 = ldg<float>(LSE, (unsigned)(((MP + row) * 8 + hd) * 4)), l2 = ldg<float>(LSE, (unsigned)(((2 * MP + row) * 8 + hd) * 4));
        const float mx = fmaxf(l0, fmaxf(l1, l2));
        float w0 = __expf(l0 - mx), w1 = __expf(l1 - mx), w2 = __expf(l2 - mx);
        const float ws = 1.f / (w0 + w1 + w2); w0 *= ws; w1 *= ws; w2 *= ws;
        const unsigned off = (unsigned)((row * 1024 + hd * 128 + 8 * l16) * 2);
        const u32x4 a0 = ldg<u32x4>(OG, off), a1 = ldg<u32x4>(OG, off + MP * 1024 * 2), a2 = ldg<u32x4>(OG, off + 2 * MP * 1024 * 2);
        u32x4 o;
#pragma unroll
        for (int e = 0; e < 4; ++e)
            o[e] = pk2(w0 * bflo(a0[e]) + w1 * bflo(a1[e]) + w2 * bflo(a2[e]), w0 * bfhi(a0[e]) + w1 * bfhi(a1[e]) + w2 * bfhi(a2[e]));
        stg<u32x4>(O, off, o);
    }
    __syncthreads();
}

#define MFMA16(a, b, c) __builtin_amdgcn_mfma_f32_16x16x32_bf16((a), (b), (c), 0, 0, 0)
DI void attn_decode_unit(int u, int& b, int& hd, int& g, int& r, int& nb) {
    const int bh = u / 96, v = u - bh * 96; b = bh >> 3; hd = bh & 7;
    if (v < 32) { g = 0; r = 0; nb = v; } else if (v < 64) { g = 1; r = (v - 32) >> 3; nb = (v - 32) & 7; } else { g = 2; r = (v - 64) >> 1; nb = (v - 64) & 1; }
}
DI void attn_load_unit(int u, const bf16* QKV, int tid, u32x4 (&pre)[16]) {
    int b, hd, g, r, nb; attn_decode_unit(u, b, hd, g, r, nb);
    const int dil = 1 << (2 * g);
#pragma unroll
    for (int i = 0; i < 16; ++i) {
        const int cid = tid + 512 * i, c = cid & 4095, row = c >> 4, ch = c & 15;
        int Lk = 128 * nb - 128 + row; if (Lk < 0) Lk = 0;
        const int col = (i < 8 ? 3072 : 6144) + g * 1024 + hd * 128 + 8 * ch;
        pre[i] = ldg<u32x4>(QKV, (unsigned)(((b * TP + r + dil * Lk) * AQKV + col) * 2));
    }
}
DI void attn_coop_phase(const Frame& F, const bf16* QKV, bf16* OG, float* LSE) {
    const int tid = F.tid, lane = F.lane, w = F.wave, q16 = lane & 15, qd = lane >> 4;
    constexpr int LD = 272;
    LAS uchar* Kl = F.lds; LAS uchar* Vl = F.lds + 256 * LD;
    const float SC = 0.08838834764831845f * 1.4426950408889634f;
    u32x4 pre[16];
    int u = F.bid;
    if (u < 1536) attn_load_unit(u, QKV, tid, pre);
#pragma unroll 1
    for (; u < 1536; u += F.G) {
        int b, hd, g, r, nb; attn_decode_unit(u, b, hd, g, r, nb);
        const int dil = 1 << (2 * g), rowb = b * TP;
#pragma unroll
        for (int i = 0; i < 16; ++i) {
            const int cid = tid + 512 * i, c = cid & 4095, row = c >> 4, ch = c & 15;
            *(LAS u32x4*)((i < 8 ? Kl : Vl) + row * LD + ch * 16) = pre[i];
        }
        LDS_BARRIER();
        if (u + F.G < 1536) attn_load_unit(u + F.G, QKV, tid, pre);
        const int L = 128 * nb + 16 * w + q16, orow = rowb + r + dil * L;
        bf16x8 qf[4];
        {
            const unsigned qo = (unsigned)((orow * AQKV + g * 1024 + hd * 128 + 8 * qd) * 2);
#pragma unroll
            for (int s = 0; s < 4; ++s) qf[s] = ldg<bf16x8>(QKV, qo + 64 * s);
        }
        f32x4 st[10];
#pragma unroll
        for (int kb = 0; kb < 9; ++kb) {
            f32x4 acc = {0.f, 0.f, 0.f, 0.f};
            LAS const uchar* kp = Kl + (16 * w + 16 * kb + q16) * LD + 16 * qd;
#pragma unroll
            for (int s = 0; s < 4; ++s) acc = MFMA16(*(LAS const bf16x8*)(kp + 64 * s), qf[s], acc);
            st[kb] = acc;
        }
        st[9] = (f32x4){0.f, 0.f, 0.f, 0.f};
        float m = -INFINITY;
        {
            int lo = q16; const int kmin = (nb == 0 ? 128 : 0) - 16 * w; if (kmin > lo) lo = kmin;
            const int a0 = 4 * qd - lo, b0 = q16 + 128 - 4 * qd;
#pragma unroll
            for (int kb = 0; kb < 9; ++kb)
#pragma unroll
                for (int e = 0; e < 4; ++e) {
                    const int cst = 16 * kb + e;
                    const unsigned msk = (unsigned)(((a0 + cst) | (b0 - cst)) >> 31);
                    const unsigned xb = __float_as_uint(st[kb][e] * SC);
                    const float sv = __uint_as_float((xb & ~msk) | (0xff800000u & msk));
                    st[kb][e] = sv; m = fmaxf(m, sv);
                }
        }
        m = fmaxf(m, __shfl_xor(m, 16)); m = fmaxf(m, __shfl_xor(m, 32));
        float l = 0.f;
#pragma unroll
        for (int kb = 0; kb < 9; ++kb)
#pragma unroll
            for (int e = 0; e < 4; ++e) { const float p = exp2f(st[kb][e] - m); st[kb][e] = p; l += p; }
        l += __shfl_xor(l, 16); l += __shfl_xor(l, 32);
        f32x4 ot[8];
#pragma unroll
        for (int db = 0; db < 8; ++db) ot[db] = (f32x4){0.f, 0.f, 0.f, 0.f};
#pragma unroll
        for (int k2 = 0; k2 < 5; ++k2) {
            u32x4 pp; pp.x = pk2(st[2 * k2][0], st[2 * k2][1]); pp.y = pk2(st[2 * k2][2], st[2 * k2][3]); pp.z = pk2(st[2 * k2 + 1][0], st[2 * k2 + 1][1]); pp.w = pk2(st[2 * k2 + 1][2], st[2 * k2 + 1][3]);
            const bf16x8 pb = __builtin_bit_cast(bf16x8, pp);
            const int r0 = 16 * w + 32 * k2 + 4 * qd + (q16 >> 2); int r1 = r0 + 16; if (r1 > 255) r1 = 255;
            LAS const uchar* v0 = Vl + r0 * LD + 8 * (q16 & 3); LAS const uchar* v1 = Vl + r1 * LD + 8 * (q16 & 3);
#pragma unroll
            for (int db = 0; db < 8; ++db) {
                const s16x4 alo = lds_tr(v0 + 32 * db), ahi = lds_tr(v1 + 32 * db);
                ot[db] = MFMA16(__builtin_shufflevector(alo, ahi, 0, 1, 2, 3, 4, 5, 6, 7), pb, ot[db]);
            }
        }
        const float rl = 1.f / l;
        const unsigned oo = (unsigned)((((g * MP + orow) * 1024) + hd * 128 + 4 * qd) * 2);
#pragma unroll
        for (int db = 0; db < 8; ++db) stg<u32x2>(OG, oo + 32 * db, pk4(ot[db] * rl));
        if (qd == 0) stg<float>(LSE, (unsigned)(((g * MP + orow) * 8 + hd) * 4), (m + log2f(l)) * 0.6931471805599453f);
        LDS_BARRIER();
    }
}
DI void attn_merge_phase(const Frame& F, const bf16* OG, const float* LSE, bf16* O) {
    const int l16 = F.lane & 15;
    for (int it = F.gw * 4 + (F.lane >> 4); it < MP * 8; it += F.NGW * 4) {
        const int row = it >> 3, hd = it & 7;
        const float l0 = ldg<float>(LSE, (unsigned)((row * 8 + hd) * 4)), l1 = ldg<float>(LSE, (unsigned)(((MP + row) * 8 + hd) * 4)), l2 = ldg<float>(LSE, (unsigned)(((2 * MP + row) * 8 + hd) * 4));
        const float mx = fmaxf(l0, fmaxf(l1, l2));
        float w0 = __expf(l0 - mx), w1 = __expf(l1 - mx), w2 = __expf(l2 - mx);
        const float ws = 1.f / (w0 + w1 + w2); w0 *= ws; w1 *= ws; w2 *= ws;
        const unsigned off = (unsigned)((row * 1024 + hd * 128 + 8 * l16) * 2);
        const u32x4 a0 = ldg<u32x4>(OG, off), a1 = ldg<u32x4>(OG, off + MP * 1024 * 2), a2 = ldg<u32x4>(OG, off + 2 * MP * 1024 * 2);
        u32x4 o;
#pragma unroll
        for (int e = 0; e < 4; ++e)
            o[e] = pk2(w0 * bflo(a0[e]) + w1 * bflo(a1[e]) + w2 * bflo(a2[e]), w0 * bfhi(a0[e]) + w1 * bfhi(a1[e]) + w2 * bfhi(a2[e]));
        stg<u32x4>(O, off, o);
    }
}

DI void attn_sample_unit(const Frame& F, int su, const float* QKVS, const float* cache0, const float* cache1, const float* cache2, int j, bf16* O) {
    const int b = su >> 5, hd = (su >> 2) & 7, t = su & 3;
    const int lane = F.lane, w = F.wave, l32 = lane & 31, hw = lane >> 5;
    LAS float* sc = (LAS float*)F.lds;
    LAS float* part = (LAS float*)(F.lds + 4096);
    if (w < 6) {
        const int g = w >> 1, half = w & 1, dil = 1 << (2 * g), wb = 128 << (2 * g);
        const int j0 = half * 65, cnt = half ? 64 : 65;
        const float* cg = (g == 0 ? cache0 : g == 1 ? cache1 : cache2) + ((size_t)(j * 8 + b) * wb) * 2048 + hd * 128 + 4 * l32;
        const float* qn = QKVS + (size_t)(b * 4) * AQKV + g * 1024 + hd * 128 + 4 * l32;
        const f32x4 q4 = *(const f32x4*)(qn + (size_t)t * AQKV);
#pragma unroll 11
        for (int it = 0; it < 33; ++it) {
            const int jl = 2 * it + hw;
            float s = 0.f;
            if (jl < cnt) {
                const int idx = wb + t - dil * (j0 + jl);
                const float* kp = idx >= wb ? qn + (size_t)(idx - wb) * AQKV + 3072 : cg + (size_t)idx * 2048;
                const f32x4 k4 = *(const f32x4*)kp;
                s = q4[0] * k4[0] + q4[1] * k4[1] + q4[2] * k4[2] + q4[3] * k4[3];
            }
#pragma unroll
            for (int o = 1; o < 32; o <<= 1) s += __shfl_xor(s, o);
            if (l32 == 0 && jl < cnt) sc[w * 80 + jl] = s * 0.08838834764831845f;
        }
        asm volatile("s_waitcnt lgkmcnt(0)" ::: "memory");
        float m = lane < cnt ? sc[w * 80 + lane] : -INFINITY;
        if (lane == 0 && cnt == 65) m = fmaxf(m, sc[w * 80 + 64]);
        m = wave_max(m);
        float lsum = 0.f; f32x4 acc = {0.f, 0.f, 0.f, 0.f};
#pragma unroll 11
        for (int it = 0; it < 33; ++it) {
            const int jl = 2 * it + hw;
            if (jl < cnt) {
                const int idx = wb + t - dil * (j0 + jl);
                const float* vp = idx >= wb ? qn + (size_t)(idx - wb) * AQKV + 6144 : cg + (size_t)idx * 2048 + 1024;
                const f32x4 v4 = *(const f32x4*)vp;
                const float p = __expf(sc[w * 80 + jl] - m);
                lsum += p; acc += v4 * p;
            }
        }
        lsum += __shfl_xor(lsum, 32);
#pragma unroll
        for (int e = 0; e < 4; ++e) acc[e] += __shfl_xor(acc[e], 32);
        if (lane == 0) { part[w * 136] = m; part[w * 136 + 1] = lsum; }
        if (lane < 32) *(LAS f32x4*)(part + w * 136 + 8 + 4 * l32) = acc;
    }
    __syncthreads();
    if (w == 0 && lane < 32) {
        float M = -INFINITY;
#pragma unroll
        for (int ww = 0; ww < 6; ++ww) M = fmaxf(M, part[ww * 136]);
        float L = 0.f; f32x4 o = {0.f, 0.f, 0.f, 0.f};
#pragma unroll
        for (int ww = 0; ww < 6; ++ww) { const float e = __expf(part[ww * 136] - M); L += part[ww * 136 + 1] * e; o += *(LAS const f32x4*)(part + ww * 136 + 8 + 4 * l32) * e; }
        o = o * (1.f / L);
        *(u32x2*)(O + (size_t)(MP + b * 4 + t) * 1024 + hd * 128 + 4 * l32) = pk4(o);
    }
    __syncthreads();
}
struct BPtrs {
    const bf16* PB; const float* EB; const float* PBS; bf16 *WG, *UG, *QG, *KG, *QKG; float* GCG; bf16* YB; bf16 *SG, *VNG;
    const float *conv_w, *a_log, *dt_bias, *norm_w, *ssm0, *conv0;
    float *ssm_p, *ssm_s, *conv_p, *conv_s;
};
DI void bprep_unit(const Frame& F, int pu, const BPtrs& P) {
    const int b = pu >> 10, n = (pu >> 4) & 63, hq = pu & 15;
    int lane = F.lane, tid = F.tid; asm volatile("" : "+v"(lane), "+v"(tid));
    const int w = F.wave, t0 = n * 64;
    constexpr int LD = 272, LDT = 144;
    LAS uchar* Kl = F.lds; LAS uchar* V0l = F.lds + 17408; LAS uchar* V1l = F.lds + 34816; LAS uchar* Ql = F.lds + 52224;
    LAS float* Gkk = (LAS float*)(F.lds + 69632); LAS float* Gqk = (LAS float*)(F.lds + 86016);
    LAS float* LT = (LAS float*)(F.lds + 102400);
    LAS uchar* Tb = F.lds + 52224;
    LAS float* betaL = (LAS float*)(F.lds + 135168); LAS float* gcL = betaL + 128; LAS float* egL = gcL + 128;
    for (int it = 0; it < 8; ++it) {
        const int task = w + 8 * it, mt = task >> 4, rg = task & 15;
        const int i = 4 * rg + (lane >> 4), ch = lane & 15, t = t0 + i;
        const int cb = mt == 0 ? hq * 128 : mt == 1 ? 2048 + hq * 128 : 4096 + (2 * hq + (mt - 2)) * 128;
        const int col = cb + 8 * ch;
        float y[8];
#pragma unroll
        for (int e = 0; e < 8; ++e) y[e] = 0.f;
#pragma unroll
        for (int jj = 0; jj < 4; ++jj) {
            const int tt = t - 3 + jj;
            u32x4 x = {0u, 0u, 0u, 0u};
            if (tt >= 0) x = ldg<u32x4>(P.PB, (unsigned)(((b * TP + tt) * BINM + col) * 2));
            const f32x4 w0 = ldg<f32x4>(P.conv_w, (unsigned)((jj * 8192 + col) * 4)), w1 = ldg<f32x4>(P.conv_w, (unsigned)((jj * 8192 + col + 4) * 4));
            y[0] += bflo(x[0]) * w0[0]; y[1] += bfhi(x[0]) * w0[1]; y[2] += bflo(x[1]) * w0[2]; y[3] += bfhi(x[1]) * w0[3];
            y[4] += bflo(x[2]) * w1[0]; y[5] += bfhi(x[2]) * w1[1]; y[6] += bflo(x[3]) * w1[2]; y[7] += bfhi(x[3]) * w1[3];
        }
        float ss = 0.f;
#pragma unroll
        for (int e = 0; e < 8; ++e) { y[e] = silu_f(y[e]); ss += y[e] * y[e]; }
        if (mt < 2) {
#pragma unroll
            for (int o = 1; o < 16; o <<= 1) ss += __shfl_xor(ss, o);
            const float rn = rsqrtf(ss + 1e-6f) * (mt == 0 ? 0.08838834764831845f : 1.f);
#pragma unroll
            for (int e = 0; e < 8; ++e) y[e] *= rn;
        }
        u32x4 o; o.x = pk2(y[0], y[1]); o.y = pk2(y[2], y[3]); o.z = pk2(y[4], y[5]); o.w = pk2(y[6], y[7]);
        LAS uchar* dst = mt == 0 ? Ql : mt == 1 ? Kl : mt == 2 ? V0l : V1l;
        *(LAS u32x4*)(dst + i * LD + ch * 16) = o;
        if (mt == 0) stg<u32x4>(P.QG, (unsigned)((((b * 16 + hq) * TP + t) * 128 + 8 * ch) * 2), o);
        if (mt == 1) stg<u32x4>(P.KG, (unsigned)((((b * 16 + hq) * TP + t) * 128 + 8 * ch) * 2), o);
    }
    __syncthreads();
    {
        const int which = w >> 2, ti = (w >> 1) & 1, tj = w & 1;
        f32x16 acc = mm_tile<false, false>(zero16(), which ? Ql : Kl, LD, 32 * ti, Kl, LD, 32 * tj, 8, lane);
        LAS float* G = which ? Gqk : Gkk;
#pragma unroll
        for (int i = 0; i < 16; ++i) G[(32 * ti + crow(i, lane >> 5)) * 64 + 32 * tj + (lane & 31)] = acc[i];
    }
    if (w < 2) {
        const int hv = 2 * hq + w, t = t0 + lane;
        const float braw = ldg<float>(P.EB, (unsigned)(((b * TP + t) * 64 + hv) * 4)), araw = ldg<float>(P.EB, (unsigned)(((b * TP + t) * 64 + 32 + hv) * 4));
        const float beta = sigmoid_f(braw);
        float gc = -__expf(P.a_log[hv]) * softplus_f(araw + P.dt_bias[hv]);
#pragma unroll
        for (int o = 1; o < 64; o <<= 1) { const float v = __shfl_up(gc, o); if (lane >= o) gc += v; }
        betaL[w * 64 + lane] = beta; gcL[w * 64 + lane] = gc; egL[w * 64 + lane] = __expf(gc);
        stg<float>(P.GCG, (unsigned)(((b * 32 + hv) * TP + t) * 4), gc);
    }
    __syncthreads();
#pragma unroll 1
    for (int hvl = 0; hvl < 2; ++hvl) {
        const int hv = 2 * hq + hvl;
        for (int idx = tid; idx < 4096; idx += 512) {
            const int r = idx >> 6, c = idx & 63;
            const float gj = gcL[hvl * 64 + c], gr = gcL[hvl * 64 + r];
            LT[(hvl * 64 + r) * 64 + c] = (c > r) ? betaL[hvl * 64 + c] * Gkk[c * 64 + r] * __expf(gj - gr) : 0.f;
            const float qv = (r >= c) ? Gqk[r * 64 + c] * __expf(gr - gj) : 0.f;
            stg<bf16>(P.QKG, (unsigned)((((((b * 32 + hv) * 64 + n) * 64 + r) * 64) + c) * 2), (bf16)(pk2(qv, 0.f) & 0xffffu));
        }
    }
    __syncthreads();
    asm volatile("" : "+v"(lane), "+v"(tid));
    if (w < 2) {
        float t[64];
#pragma unroll
        for (int c = 0; c < 64; ++c) t[c] = 0.f;
        unsigned lt_a = (unsigned)(size_t)(LT + w * 4096), be_a = (unsigned)(size_t)(betaL + w * 64), eg_a = (unsigned)(size_t)(egL + w * 64);
        asm volatile("" : "+v"(lt_a), "+v"(be_a), "+v"(eg_a));
        LAS const float* lt = (LAS const float*)(size_t)lt_a; LAS const float* bel = (LAS const float*)(size_t)be_a; LAS const float* egl = (LAS const float*)(size_t)eg_a;
#pragma unroll
        for (int c = 63; c >= 0; --c) {
            asm volatile("" ::: "memory");
            float a0 = (lane == c) ? 1.f : 0.f, a1 = 0.f, a2 = 0.f, a3 = 0.f;
#pragma unroll
            for (int jb = (c + 1) >> 2; jb < 16; ++jb) {
                const f32x4 l4 = *(LAS const f32x4*)(lt + c * 64 + 4 * jb);
                a0 -= t[4 * jb] * l4[0]; a1 -= t[4 * jb + 1] * l4[1]; a2 -= t[4 * jb + 2] * l4[2]; a3 -= t[4 * jb + 3] * l4[3];
            }
            float acc = (a0 + a1) + (a2 + a3);
            asm volatile("" : "+v"(acc) :: "memory");
            t[c] = acc;
        }
        LAS uchar* tb0 = Tb + (w * 2 + 0) * (64 * LDT) + lane * LDT; LAS uchar* tb1 = Tb + (w * 2 + 1) * (64 * LDT) + lane * LDT;
#pragma unroll
        for (int q = 0; q < 8; ++q) {
            float a[8], c2[8];
            const f32x4 b0 = *(LAS const f32x4*)(bel + 8 * q), b1 = *(LAS const f32x4*)(bel + 8 * q + 4), e0 = *(LAS const f32x4*)(egl + 8 * q), e1 = *(LAS const f32x4*)(egl + 8 * q + 4);
#pragma unroll
            for (int e = 0; e < 4; ++e) { a[e] = t[8 * q + e] * b0[e]; c2[e] = a[e] * e0[e]; a[4 + e] = t[8 * q + 4 + e] * b1[e]; c2[4 + e] = a[4 + e] * e1[e]; }
            u32x4 o0, o1; o0.x = pk2(a[0], a[1]); o0.y = pk2(a[2], a[3]); o0.z = pk2(a[4], a[5]); o0.w = pk2(a[6], a[7]);
            o1.x = pk2(c2[0], c2[1]); o1.y = pk2(c2[2], c2[3]); o1.z = pk2(c2[4], c2[5]); o1.w = pk2(c2[6], c2[7]);
            *(LAS u32x4*)(tb0 + 16 * q) = o0; *(LAS u32x4*)(tb1 + 16 * q) = o1;
        }
    }
    __syncthreads();
    asm volatile("" : "+v"(lane), "+v"(tid));
    {
        const int hvl = w >> 2, hv = 2 * hq + hvl;
#pragma unroll 1
        for (int tt = 0; tt < 4; ++tt) {
            const int id = (w & 3) * 4 + tt, which = id >> 3, ti = (id >> 2) & 1, c = id & 3;
            f32x16 acc = mm_tile<false, true>(zero16(), Tb + (hvl * 2 + which) * (64 * LDT), LDT, 32 * ti, which ? Kl : (hvl ? V1l : V0l), LD, 32 * c, 4, lane);
            bf16* dstb = which ? P.WG : P.UG;
            const unsigned dof = (unsigned)(((((b * 32 + hv) * TP + t0 + 32 * ti + 4 * (lane >> 5)) * 128) + 32 * c + (lane & 31)) * 2);
#pragma unroll
            for (int i = 0; i < 16; ++i) stg<bf16>(dstb, dof + ((i & 3) + 8 * (i >> 2)) * 256, (bf16)(pk2(acc[i], 0.f) & 0xffffu));
        }
    }
    __syncthreads();
}
DI void bchain_unit(const Frame& F, int cu, const BPtrs& P) {
    const int b = cu >> 5, hv = cu & 31, hq = hv >> 1;
    const int lane = F.lane, w = F.wave, tid_ = F.tid, tid = tid_, h = lane >> 5, l32 = lane & 31;
    constexpr int LD = 272, LDS_ = 320;
    LAS uchar* Wl = F.lds; LAS uchar* Kl = F.lds + 17408;
    LAS uchar* Sb = F.lds + 37888; LAS uchar* VNl = F.lds + 78848; LAS uchar* VNd = F.lds + 99328;
    LAS float* gcL = (LAS float*)(F.lds + 119808);
    const bf16* wg = P.WG + ((size_t)b * 32 + hv) * TP * 128; const bf16* ug = P.UG + ((size_t)b * 32 + hv) * TP * 128;
    const bf16* kg = P.KG + ((size_t)b * 16 + hq) * TP * 128; const float* gcg = P.GCG + ((size_t)b * 32 + hv) * TP;
    bf16* sg = P.SG + ((size_t)b * 32 + hv) * 64 * 16384; bf16* vng = P.VNG + ((size_t)b * 32 + hv) * TP * 128;
    const int kb = w & 3, c0 = 2 * (w >> 2);
    f32x16 S0 = zero16(), S1 = zero16();
    for (int i = tid; i < 128 * LDS_ / 4; i += 512) ((LAS unsigned*)Sb)[i] = 0u;
    const int ti = w >> 2, tc = w & 3;
    u32x4 pw[2], pk[2]; float pg = 0.f;
    {
#pragma unroll
        for (int k = 0; k < 2; ++k) { const unsigned go = (unsigned)((tid + 512 * k) * 16); pw[k] = ldg<u32x4>(wg, go); pk[k] = ldg<u32x4>(kg, go); }
        if (tid < 64) pg = ldg<float>(gcg, (unsigned)(tid * 4));
    }
#pragma unroll 1
    for (int n = 0; n < 64; ++n) {
        const int t0 = n * 64;
        int tid = tid_; asm volatile("" : "+v"(tid));
        const int lane = tid & 63, h = lane >> 5, l32 = lane & 31;
#pragma unroll
        for (int k = 0; k < 2; ++k) {
            const int cid = tid + 512 * k, r = cid >> 4, ch = cid & 15;
            *(LAS u32x4*)(Wl + r * LD + ch * 16) = pw[k]; *(LAS u32x4*)(Kl + r * LDS_ + ch * 16) = pk[k];
        }
        if (tid < 64) gcL[tid] = pg;
        LDS_BARRIER();
        if (n < 63) {
            const unsigned nx = (unsigned)((t0 + 64) * 256);
#pragma unroll
            for (int k = 0; k < 2; ++k) { const unsigned go = nx + (unsigned)((tid + 512 * k) * 16); pw[k] = ldg<u32x4>(wg, go); pk[k] = ldg<u32x4>(kg, go); }
            if (tid < 64) pg = ldg<float>(gcg, (unsigned)((t0 + 64 + tid) * 4));
        }
        const float glast = gcL[63];
        float uu[16];
        {
            const char* upb = (const char*)(ug + (size_t)(t0 + 32 * ti) * 128 + 32 * tc);
            const unsigned uo = (unsigned)((4 * h * 128 + l32) * 2);
#pragma unroll
            for (int i = 0; i < 16; ++i) uu[i] = bf2f(*(const bf16*)(upb + uo + (unsigned)(((i & 3) + 8 * (i >> 2)) * 256)));
        }
#pragma unroll
        for (int k = 0; k < 4; ++k) { const int cid = tid + 512 * k, r = cid >> 4, ch = cid & 15; stg<u32x4>(sg, (unsigned)(n * 32768 + cid * 16), *(LAS const u32x4*)(Sb + r * LDS_ + ch * 16)); }
        f32x16 vn = mm_tile<false, true>(zero16(), Wl, LD, 32 * ti, Sb, LDS_, 32 * tc, 8, lane);
        {
#pragma unroll
            for (int i = 0; i < 16; ++i) {
                const int r = crow(i, h);
                const float v = uu[i] - vn[i];
                const float vd = v * __expf(glast - gcL[32 * ti + r]);
                *(LAS bf16*)(VNl + (32 * ti + r) * LDS_ + (32 * tc + l32) * 2) = (bf16)(pk2(v, 0.f) & 0xffffu);
                *(LAS bf16*)(VNd + (32 * ti + r) * LDS_ + (32 * tc + l32) * 2) = (bf16)(pk2(vd, 0.f) & 0xffffu);
            }
        }
        LDS_BARRIER();
#pragma unroll
        for (int k = 0; k < 2; ++k) { const int cid = tid + 512 * k, r = cid >> 4, ch = cid & 15; stg<u32x4>(vng, (unsigned)(t0 * 256 + cid * 16), *(LAS const u32x4*)(VNl + r * LDS_ + ch * 16)); }
        {
            const float el = __expf(glast);
#pragma unroll
            for (int i = 0; i < 16; ++i) { S0[i] *= el; S1[i] *= el; }
            S0 = mm_tile<true, true>(S0, Kl, LDS_, 32 * kb, VNd, LDS_, 32 * c0, 4, lane);
            S1 = mm_tile<true, true>(S1, Kl, LDS_, 32 * kb, VNd, LDS_, 32 * (c0 + 1), 4, lane);
        }
        LDS_BARRIER();
#pragma unroll
        for (int i = 0; i < 16; ++i) {
            const int r = 32 * kb + crow(i, h);
            *(LAS bf16*)(Sb + r * LDS_ + (32 * c0 + l32) * 2) = (bf16)(pk2(S0[i], 0.f) & 0xffffu);
            *(LAS bf16*)(Sb + r * LDS_ + (32 * (c0 + 1) + l32) * 2) = (bf16)(pk2(S1[i], 0.f) & 0xffffu);
        }
    }
    {
        float* sp = P.ssm_p + ((size_t)b * 32 + hv) * 16384;
#pragma unroll
        for (int i = 0; i < 16; ++i) {
            const int r = 32 * kb + crow(i, h);
            sp[r * 128 + 32 * c0 + l32] = S0[i]; sp[r * 128 + 32 * (c0 + 1) + l32] = S1[i];
        }
    }
    __syncthreads();
}
DI void bout_unit(const Frame& F, int item, const BPtrs& P) {
    const int b = item >> 11, hv = (item >> 6) & 31, n = item & 63, hq = hv >> 1, t0 = n * 64;
    int tid = F.tid; asm volatile("" : "+v"(tid));
    const int lane = tid & 63, w = F.wave, h = lane >> 5, l32 = lane & 31;
    constexpr int LD = 272, LDS_ = 320, LDQ = 144, LDO = 528;
    LAS uchar* Ql = F.lds; LAS uchar* QKl = F.lds + 17408; LAS uchar* Sl = F.lds + 26624; LAS uchar* VNl = F.lds + 67584;
    LAS uchar* Ol = F.lds + 88064;
    LAS float* egL = (LAS float*)(F.lds + 121856);
    {
        const bf16* qg = P.QG + (((size_t)b * 16 + hq) * TP + t0) * 128; const bf16* vng = P.VNG + (((size_t)b * 32 + hv) * TP + t0) * 128;
        const bf16* sg = P.SG + (((size_t)b * 32 + hv) * 64 + n) * 16384; const bf16* qkg = P.QKG + (((size_t)b * 32 + hv) * 64 + n) * 4096;
#pragma unroll
        for (int k = 0; k < 2; ++k) {
            const int cid = tid + 512 * k, r = cid >> 4, ch = cid & 15;
            *(LAS u32x4*)(Ql + r * LD + ch * 16) = ldg<u32x4>(qg, (unsigned)(cid * 16)); *(LAS u32x4*)(VNl + r * LDS_ + ch * 16) = ldg<u32x4>(vng, (unsigned)(cid * 16));
        }
#pragma unroll
        for (int k = 0; k < 4; ++k) { const int cid = tid + 512 * k, r = cid >> 4, ch = cid & 15; *(LAS u32x4*)(Sl + r * LDS_ + ch * 16) = ldg<u32x4>(sg, (unsigned)(cid * 16)); }
        { const int r = tid >> 3, ch = tid & 7; *(LAS u32x4*)(QKl + r * LDQ + ch * 16) = ldg<u32x4>(qkg, (unsigned)(tid * 16)); }
        if (tid < 64) egL[tid] = __expf(ldg<float>(P.GCG, (unsigned)((((b * 32 + hv) * TP) + t0 + tid) * 4)));
    }
    u32x4 z0, z1;
    {
        const int r = tid >> 3, part = tid & 7;
        z0 = ldg<u32x4>(P.PB, (unsigned)((((b * TP + t0 + r) * BINM) + 8192 + hv * 128 + 16 * part) * 2)); z1 = ldg<u32x4>(P.PB, (unsigned)((((b * TP + t0 + r) * BINM) + 8192 + hv * 128 + 16 * part + 8) * 2));
    }
    __syncthreads();
    {
        const int ti = w >> 2, tc = w & 3;
        f32x16 o = mm_tile<false, true>(zero16(), Ql, LD, 32 * ti, Sl, LDS_, 32 * tc, 8, lane);
#pragma unroll
        for (int i = 0; i < 16; ++i) o[i] *= egL[32 * ti + crow(i, h)];
        o = mm_tile<false, true>(o, QKl, LDQ, 32 * ti, VNl, LDS_, 32 * tc, 4, lane);
#pragma unroll
        for (int i = 0; i < 16; ++i) *(LAS float*)(Ol + (32 * ti + crow(i, h)) * LDO + (32 * tc + l32) * 4) = o[i];
    }
    __syncthreads();
    {
        const int r = tid >> 3, part = tid & 7;
        float ov[16]; float ss = 0.f;
#pragma unroll
        for (int q = 0; q < 4; ++q) { const f32x4 v = *(LAS const f32x4*)(Ol + r * LDO + (16 * part + 4 * q) * 4); ov[4 * q] = v[0]; ov[4 * q + 1] = v[1]; ov[4 * q + 2] = v[2]; ov[4 * q + 3] = v[3]; }
#pragma unroll
        for (int e = 0; e < 16; ++e) ss += ov[e] * ov[e];
        ss += __shfl_xor(ss, 1); ss += __shfl_xor(ss, 2); ss += __shfl_xor(ss, 4);
        const float rstd = rsqrtf(ss * (1.f / 128.f) + RMS_EPS);
        float nw[16];
#pragma unroll
        for (int q = 0; q < 4; ++q) { const f32x4 nv = ldg<f32x4>(P.norm_w, (unsigned)((16 * part + 4 * q) * 4)); nw[4 * q] = nv[0]; nw[4 * q + 1] = nv[1]; nw[4 * q + 2] = nv[2]; nw[4 * q + 3] = nv[3]; }
        u32x4 y0, y1;
#pragma unroll
        for (int e = 0; e < 4; ++e) {
            y0[e] = pk2(ov[2 * e] * rstd * nw[2 * e] * silu_f(bflo(z0[e])), ov[2 * e + 1] * rstd * nw[2 * e + 1] * silu_f(bfhi(z0[e])));
            y1[e] = pk2(ov[8 + 2 * e] * rstd * nw[8 + 2 * e] * silu_f(bflo(z1[e])), ov[8 + 2 * e + 1] * rstd * nw[8 + 2 * e + 1] * silu_f(bfhi(z1[e])));
        }
        const unsigned yo = (unsigned)((((b * TP + t0 + r) * 4096) + hv * 128 + 16 * part) * 2);
        stg<u32x4>(P.YB, yo, y0); stg<u32x4>(P.YB, yo + 16, y1);
    }
    __syncthreads();
}
DI void bsample_unit(const Frame& F, int su, const BPtrs& P) {
    const int b = su >> 5, hv = su & 31, hq = hv >> 1;
    const int tid = F.tid, lane = F.lane, w = F.wave, dv = tid & 127, qd = tid >> 7;
    LAS float* raw = (LAS float*)F.lds;
    LAS float* qv = raw + 1536; LAS float* kv = qv + 512; LAS float* vv = kv + 512;
    LAS float* part = vv + 512;
    LAS float* ov = part + 512;
    LAS float* scal = ov + 512;
    float s[32];
    {
        const float* s0 = P.ssm0 + ((size_t)b * 32 + hv) * 16384 + (32 * qd) * 128 + dv;
#pragma unroll
        for (int i = 0; i < 32; ++i) s[i] = s0[i * 128];
    }
    if (tid < 384) {
        const int which = tid >> 7, d = tid & 127;
        const int col = which == 0 ? hq * 128 + d : which == 1 ? 2048 + hq * 128 + d : 4096 + hv * 128 + d;
        float full[7];
#pragma unroll
        for (int r = 0; r < 3; ++r) full[r] = P.conv0[((size_t)b * 3 + r) * 8192 + col];
#pragma unroll
        for (int t = 0; t < 4; ++t) full[3 + t] = P.PBS[(size_t)(b * 4 + t) * BIN + col];
        const float w0 = P.conv_w[col], w1 = P.conv_w[8192 + col], w2 = P.conv_w[2 * 8192 + col], w3 = P.conv_w[3 * 8192 + col];
#pragma unroll
        for (int t = 0; t < 4; ++t) raw[(which * 4 + t) * 128 + d] = silu_f(full[t] * w0 + full[t + 1] * w1 + full[t + 2] * w2 + full[t + 3] * w3);
#pragma unroll
        for (int r = 0; r < 3; ++r) P.conv_s[((size_t)b * 3 + r) * 8192 + col] = full[4 + r];
    }
    if (tid < 4) {
        const float braw = P.PBS[(size_t)(b * 4 + tid) * BIN + 12288 + hv], araw = P.PBS[(size_t)(b * 4 + tid) * BIN + 12320 + hv];
        scal[tid] = sigmoid_f(braw); scal[4 + tid] = __expf(-__expf(P.a_log[hv]) * softplus_f(araw + P.dt_bias[hv]));
    }
    __syncthreads();
    {
        const int which = w >> 2, t = w & 3;
        const float a0 = raw[(which * 4 + t) * 128 + lane], a1 = raw[(which * 4 + t) * 128 + 64 + lane];
        const float rn = rsqrtf(wave_sum(a0 * a0 + a1 * a1) + 1e-6f) * (which == 0 ? 0.08838834764831845f : 1.f);
        LAS float* dst = which == 0 ? qv : kv;
        dst[t * 128 + lane] = a0 * rn; dst[t * 128 + 64 + lane] = a1 * rn;
        vv[tid] = raw[1024 + tid];
    }
    __syncthreads();
    for (int t = 0; t < 4; ++t) {
        const float beta = scal[t], eg = scal[4 + t];
        float p = 0.f;
#pragma unroll
        for (int i = 0; i < 32; ++i) p += kv[t * 128 + 32 * qd + i] * s[i];
        part[qd * 128 + dv] = p;
        __syncthreads();
        const float kS = (part[dv] + part[128 + dv]) + (part[256 + dv] + part[384 + dv]);
        const float vt = vv[t * 128 + dv];
        float po = 0.f;
#pragma unroll
        for (int i = 0; i < 32; ++i) {
            const float kk = kv[t * 128 + 32 * qd + i];
            s[i] = eg * (s[i] - beta * kk * kS) + beta * kk * vt;
            po += s[i] * qv[t * 128 + 32 * qd + i];
        }
        __syncthreads();
        part[qd * 128 + dv] = po;
        __syncthreads();
        if (qd == 0) ov[t * 128 + dv] = (part[dv] + part[128 + dv]) + (part[256 + dv] + part[384 + dv]);
        __syncthreads();
    }
    if (w < 4) {
        const int t = w;
        const float o0 = ov[t * 128 + lane], o1 = ov[t * 128 + 64 + lane];
        const float rstd = rsqrtf(wave_sum(o0 * o0 + o1 * o1) * (1.f / 128.f) + RMS_EPS);
        const float* zp = P.PBS + (size_t)(b * 4 + t) * BIN + 8192 + hv * 128;
        bf16* yp = P.YB + (size_t)(MP + b * 4 + t) * 4096 + hv * 128;
        yp[lane] = (bf16)(pk2(o0 * rstd * P.norm_w[lane] * silu_f(zp[lane]), 0.f) & 0xffffu);
        yp[64 + lane] = (bf16)(pk2(o1 * rstd * P.norm_w[64 + lane] * silu_f(zp[64 + lane]), 0.f) & 0xffffu);
    }
    {
        float* so = P.ssm_s + ((size_t)b * 32 + hv) * 16384 + (32 * qd) * 128 + dv;
#pragma unroll
        for (int i = 0; i < 32; ++i) so[i * 128] = s[i];
    }
    __syncthreads();
}
struct CPtrs {
    const bf16* PC; const float* EC; const float* PCS; float* DT; float* ACS; bf16* XBC; bf16* YC;
    const float *conv_w, *conv_b, *dt_bias, *a_log, *dskip, *norm_w, *ssm0, *conv0;
    float *ssm_p, *ssm_s, *conv_p, *conv_s;
};
DI void cpre_phase(const Frame& F, const CPtrs& P) {
    const int lane = F.lane;
    for (int it = F.gw; it < 1536 + 128; it += F.NGW) {
        if (it < 1536) {
            const int b = it / 768, cg = (it / 64) % 12, rb = it & 63, cc = cg * 512 + 8 * lane, t0 = rb * 64;
            float wt[4][8], bs[8];
#pragma unroll
            for (int jj = 0; jj < 4; ++jj) { const f32x4 w0 = ldg<f32x4>(P.conv_w, (unsigned)((jj * 6144 + cc) * 4)), w1 = ldg<f32x4>(P.conv_w, (unsigned)((jj * 6144 + cc + 4) * 4));
                wt[jj][0] = w0[0]; wt[jj][1] = w0[1]; wt[jj][2] = w0[2]; wt[jj][3] = w0[3]; wt[jj][4] = w1[0]; wt[jj][5] = w1[1]; wt[jj][6] = w1[2]; wt[jj][7] = w1[3]; }
            { const f32x4 b0 = ldg<f32x4>(P.conv_b, (unsigned)(cc * 4)), b1 = ldg<f32x4>(P.conv_b, (unsigned)((cc + 4) * 4)); bs[0] = b0[0]; bs[1] = b0[1]; bs[2] = b0[2]; bs[3] = b0[3]; bs[4] = b1[0]; bs[5] = b1[1]; bs[6] = b1[2]; bs[7] = b1[3]; }
            const unsigned src0 = (unsigned)(((b * TP + t0) * CINM + 4096 + cc) * 2), dst0 = (unsigned)(((b * TP + t0) * 6144 + cc) * 2);
            u32x4 r[19];
#pragma unroll
            for (int q = 0; q < 3; ++q) { r[q] = (u32x4){0u, 0u, 0u, 0u}; if (t0 > 0) r[q] = ldg<u32x4>(P.PC, src0 - (unsigned)((3 - q) * CINM * 2)); }
#pragma unroll 1
            for (int blk = 0; blk < 4; ++blk) {
#pragma unroll
                for (int q = 0; q < 16; ++q) r[3 + q] = ldg<u32x4>(P.PC, src0 + (unsigned)((blk * 16 + q) * CINM * 2));
#pragma unroll
                for (int q = 0; q < 16; ++q) {
                    float y[8];
#pragma unroll
                    for (int e = 0; e < 8; ++e) y[e] = bs[e];
#pragma unroll
                    for (int jj = 0; jj < 4; ++jj) {
                        const u32x4 x = r[q + jj];
                        y[0] += bflo(x[0]) * wt[jj][0]; y[1] += bfhi(x[0]) * wt[jj][1]; y[2] += bflo(x[1]) * wt[jj][2]; y[3] += bfhi(x[1]) * wt[jj][3];
                        y[4] += bflo(x[2]) * wt[jj][4]; y[5] += bfhi(x[2]) * wt[jj][5]; y[6] += bflo(x[3]) * wt[jj][6]; y[7] += bfhi(x[3]) * wt[jj][7];
                    }
#pragma unroll
                    for (int e = 0; e < 8; ++e) y[e] = silu_f(y[e]);
                    u32x4 o; o.x = pk2(y[0], y[1]); o.y = pk2(y[2], y[3]); o.z = pk2(y[4], y[5]); o.w = pk2(y[6], y[7]);
                    stg<u32x4>(P.XBC, dst0 + (unsigned)((blk * 16 + q) * 6144 * 2), o);
                }
                r[0] = r[16]; r[1] = r[17]; r[2] = r[18];
            }
        } else {
            const int id = it - 1536, b = id >> 6, n = id & 63;
            const float a = -__expf(P.a_log[lane]), db = P.dt_bias[lane];
            float acc = 0.f;
            const unsigned o0 = (unsigned)(((b * TP + n * 64) * 64 + lane) * 4);
#pragma unroll 8
            for (int t = 0; t < 64; ++t) {
                const float dt = softplus_f(ldg<float>(P.EC, o0 + t * 256) + db);
                acc += dt * a;
                stg<float>(P.DT, o0 + t * 256, dt); stg<float>(P.ACS, o0 + t * 256, acc);
            }
        }
    }
}
DI void cchain_unit(const Frame& F, int cu, const CPtrs& P) {
    const int b = cu >> 6, hd = cu & 63, g = hd >> 3;
    const int lane = F.lane, w = F.wave, tid = F.tid, h = lane >> 5, l32 = lane & 31;
    constexpr int LDX = 144, LDB = 272, LDY = 272;
    LAS uchar* Xl = F.lds; LAS uchar* XDl = F.lds + 9216; LAS uchar* XWl = F.lds + 18432;
    LAS uchar* Bl = F.lds + 27648; LAS uchar* Cl = F.lds + 45056;
    LAS uchar* Gl = F.lds + 62464;
    LAS uchar* Hl = F.lds + 71680;
    LAS uchar* Yl = F.lds + 89088;
    LAS float* dtL = (LAS float*)(F.lds + 106496);
    LAS float* acsL = dtL + 128;
    const int nb = w & 3, pb = w >> 2;
    f32x16 hst = zero16();
    for (int i = tid; i < 64 * LDB / 4; i += 512) ((LAS unsigned*)Hl)[i] = 0u;
    unsigned soff[5]; int srow[5], sch[5];
#pragma unroll
    for (int it = 0; it < 5; ++it) {
        const int id = tid + 512 * it, i = id / 40, ch = id - i * 40;
        const int c8 = ch < 8 ? hd * 64 + 8 * ch : ch < 24 ? 4096 + g * 128 + 8 * (ch - 8) : 5120 + g * 128 + 8 * (ch - 24);
        srow[it] = i; sch[it] = ch; soff[it] = (unsigned)(((b * TP + i) * 6144 + c8) * 2);
    }
    u32x4 pre[5];
#pragma unroll
    for (int it = 0; it < 5; ++it) pre[it] = ldg<u32x4>(P.XBC, soff[it]);
    const unsigned sc0 = (unsigned)(((b * TP) * 64 + hd) * 4);
    if (w == 7) { dtL[lane] = ldg<float>(P.DT, sc0 + lane * 256); acsL[lane] = ldg<float>(P.ACS, sc0 + lane * 256); }
    const float dsk = P.dskip[hd];
    __syncthreads();
#pragma unroll 1
    for (int n = 0; n < 64; ++n) {
        const int t0 = n * 64, cur = n & 1;
        LAS const float* dtc = dtL + cur * 64; LAS const float* acs = acsL + cur * 64;
        const float alast = acs[63];
#pragma unroll
        for (int it = 0; it < 5; ++it) {
            const int i = srow[it], ch = sch[it]; const u32x4 o = pre[it];
            if (ch < 8) {
                const float d1 = dtc[i], d2 = d1 * __expf(alast - acs[i]);
                u32x4 o1, o2;
#pragma unroll
                for (int e = 0; e < 4; ++e) { const float lo = bflo(o[e]), hi = bfhi(o[e]); o1[e] = pk2(lo * d1, hi * d1); o2[e] = pk2(lo * d2, hi * d2); }
                *(LAS u32x4*)(Xl + i * LDX + ch * 16) = o; *(LAS u32x4*)(XDl + i * LDX + ch * 16) = o1; *(LAS u32x4*)(XWl + i * LDX + ch * 16) = o2;
            } else if (ch < 24) *(LAS u32x4*)(Bl + i * LDB + (ch - 8) * 16) = o;
            else *(LAS u32x4*)(Cl + i * LDB + (ch - 24) * 16) = o;
        }
        LDS_BARRIER();
        if (n < 63) {
#pragma unroll
            for (int it = 0; it < 5; ++it) pre[it] = ldg<u32x4>(P.XBC, soff[it] + (unsigned)((t0 + 64) * 6144 * 2));
        }
        f32x16 yacc = zero16();
        const int ti = (w >> 1) & 1, tq = w & 1;
        if (w >= 4) {
            if (!(ti == 0 && tq == 1)) {
                f32x16 cbt = mm_tile<false, false>(zero16(), Cl, LDB, 32 * ti, Bl, LDB, 32 * tq, 8, lane);
                const int j = 32 * tq + l32; const float aj = acs[j];
#pragma unroll
                for (int r = 0; r < 16; ++r) {
                    const int i = 32 * ti + crow(r, h);
                    const float v = (i >= j) ? cbt[r] * __expf(acs[i] - aj) : 0.f;
                    *(LAS bf16*)(Gl + i * LDX + j * 2) = (bf16)(pk2(v, 0.f) & 0xffffu);
                }
            } else {
#pragma unroll
                for (int r = 0; r < 16; ++r) *(LAS bf16*)(Gl + crow(r, h) * LDX + (32 + l32) * 2) = (bf16)0;
            }
        } else {
            yacc = mm_tile<false, false>(yacc, Cl, LDB, 32 * ti, Hl, LDB, 32 * tq, 8, lane);
#pragma unroll
            for (int r = 0; r < 16; ++r) yacc[r] *= __expf(acs[32 * ti + crow(r, h)]);
        }
        LDS_BARRIER();
        if (w < 4) {
            yacc = mm_tile<false, true>(yacc, Gl, LDX, 32 * ti, XDl, LDX, 32 * tq, 4, lane);
#pragma unroll
            for (int r = 0; r < 16; ++r) *(LAS float*)(Yl + (32 * ti + crow(r, h)) * LDY + (32 * tq + l32) * 4) = yacc[r];
        }
        {
            const float el = __expf(alast);
#pragma unroll
            for (int r = 0; r < 16; ++r) hst[r] *= el;
            hst = mm_tile<true, true>(hst, Bl, LDB, 32 * nb, XWl, LDX, 32 * pb, 4, lane);
        }
        LDS_BARRIER();
#pragma unroll
        for (int q = 0; q < 4; ++q) {
            f32x4 v = {hst[4 * q], hst[4 * q + 1], hst[4 * q + 2], hst[4 * q + 3]};
            *(LAS u32x2*)(Hl + (32 * pb + l32) * LDB + (32 * nb + 8 * q + 4 * h) * 2) = pk4(v);
        }
        if (w == 7 && n < 63) { dtL[(cur ^ 1) * 64 + lane] = ldg<float>(P.DT, sc0 + (unsigned)((t0 + 64 + lane) * 256)); acsL[(cur ^ 1) * 64 + lane] = ldg<float>(P.ACS, sc0 + (unsigned)((t0 + 64 + lane) * 256)); }
        {
            const int i = tid >> 3, part = tid & 7;
            const f32x4 ya = *(LAS const f32x4*)(Yl + i * LDY + (8 * part) * 4), yb = *(LAS const f32x4*)(Yl + i * LDY + (8 * part + 4) * 4);
            const u32x4 xv = *(LAS const u32x4*)(Xl + i * LDX + part * 16);
            u32x4 o;
            o.x = pk2(ya[0] + dsk * bflo(xv[0]), ya[1] + dsk * bfhi(xv[0])); o.y = pk2(ya[2] + dsk * bflo(xv[1]), ya[3] + dsk * bfhi(xv[1]));
            o.z = pk2(yb[0] + dsk * bflo(xv[2]), yb[1] + dsk * bfhi(xv[2])); o.w = pk2(yb[2] + dsk * bflo(xv[3]), yb[3] + dsk * bfhi(xv[3]));
            stg<u32x4>(P.YC, (unsigned)((((b * TP + t0 + i) * 4096) + hd * 64 + 8 * part) * 2), o);
        }
        LDS_BARRIER();
    }
    {
        float* sp = P.ssm_p + (((size_t)b * 64 + hd) * 64 + 32 * pb + l32) * 128 + 32 * nb + 4 * h;
#pragma unroll
        for (int q = 0; q < 4; ++q) { f32x4 v = {hst[4 * q], hst[4 * q + 1], hst[4 * q + 2], hst[4 * q + 3]}; *(f32x4*)(sp + 8 * q) = v; }
    }
    __syncthreads();
}

DI void csample_unit(const Frame& F, int su, const CPtrs& P) {
    const int b = su >> 3, g = su & 7;
    const int tid = F.tid, lane = F.lane, w = F.wave, hd = g * 8 + w;
    LAS float* xs = (LAS float*)F.lds;
    LAS float* Bs = xs + 2048; LAS float* Cs = Bs + 512;
    LAS float* ys = Cs + 512;
    for (int c = tid; c < 768; c += 512) {
        const int cc = c < 512 ? g * 512 + c : c < 640 ? 4096 + g * 128 + (c - 512) : 5120 + g * 128 + (c - 640);
        float full[7];
#pragma unroll
        for (int r = 0; r < 3; ++r) full[r] = P.conv0[((size_t)b * 3 + r) * 6144 + cc];
#pragma unroll
        for (int t = 0; t < 4; ++t) full[3 + t] = P.PCS[(size_t)(b * 4 + t) * CIN + 4096 + cc];
        const float w0 = P.conv_w[cc], w1 = P.conv_w[6144 + cc], w2 = P.conv_w[2 * 6144 + cc], w3 = P.conv_w[3 * 6144 + cc], cb = P.conv_b[cc];
#pragma unroll
        for (int t = 0; t < 4; ++t) {
            const float v = silu_f(full[t] * w0 + full[t + 1] * w1 + full[t + 2] * w2 + full[t + 3] * w3 + cb);
            if (c < 512) xs[t * 512 + c]= v; else if (c < 640) Bs[t * 128 + (c - 512)] = v; else Cs[t * 128 + (c - 640)] = v;
        }
#pragma unroll
        for (int r = 0; r < 3; ++r) P.conv_s[((size_t)b * 3 + r) * 6144 + cc] = full[4 + r];
    }
    __syncthreads();
    float dt[4], dA[4];
    {
        const float a = -__expf(P.a_log[hd]), db = P.dt_bias[hd];
#pragma unroll
        for (int t = 0; t < 4; ++t) { dt[t] = softplus_f(P.PCS[(size_t)(b * 4 + t) * CIN + 10240 + hd] + db); dA[t] = __expf(dt[t] * a); }
    }
    const float dsk = P.dskip[hd];
#pragma unroll 1
    for (int ph = 0; ph < 2; ++ph) {
        float hs[32][2];
        const float* h0 = P.ssm0 + (((size_t)b * 64 + hd) * 64 + 32 * ph) * 128 + lane;
#pragma unroll
        for (int pi = 0; pi < 32; ++pi) { hs[pi][0] = h0[pi * 128]; hs[pi][1] = h0[pi * 128 + 64]; }
#pragma unroll 1
        for (int t = 0; t < 4; ++t) {
            const float b0 = Bs[t * 128 + lane], b1 = Bs[t * 128 + 64 + lane], c0 = Cs[t * 128 + lane], c1 = Cs[t * 128 + 64 + lane];
#pragma unroll
            for (int pi = 0; pi < 32; ++pi) {
                const float x = xs[t * 512 + w * 64 + 32 * ph + pi], dx = dt[t] * x;
                hs[pi][0] = hs[pi][0] * dA[t] + dx * b0; hs[pi][1] = hs[pi][1] * dA[t] + dx * b1;
                const float yv = wave_sum(hs[pi][0] * c0 + hs[pi][1] * c1);
                if (lane == 0) ys[t * 512 + w * 64 + 32 * ph + pi] = yv + dsk * x;
            }
        }
        float* ho = P.ssm_s + (((size_t)b * 64 + hd) * 64 + 32 * ph) * 128 + lane;
#pragma unroll
        for (int pi = 0; pi < 32; ++pi) { ho[pi * 128] = hs[pi][0]; ho[pi * 128 + 64] = hs[pi][1]; }
    }
    __syncthreads();
    if (w < 4) {
        const int t = w;
        const float* zp = P.PCS + (size_t)(b * 4 + t) * CIN + g * 512 + 8 * lane;
        float y[8]; float ss = 0.f;
#pragma unroll
        for (int e = 0; e < 8; ++e) { y[e] = ys[t * 512 + 8 * lane + e] * silu_f(zp[e]); ss += y[e] * y[e]; }
        const float rstd = rsqrtf(wave_sum(ss) * (1.f / 512.f) + RMS_EPS);
        const float* nw = P.norm_w + g * 512 + 8 * lane;
        u32x4 o; o.x = pk2(y[0] * rstd * nw[0], y[1] * rstd * nw[1]); o.y = pk2(y[2] * rstd * nw[2], y[3] * rstd * nw[3]);
        o.z = pk2(y[4] * rstd * nw[4], y[5] * rstd * nw[5]); o.w = pk2(y[6] * rstd * nw[6], y[7] * rstd * nw[7]);
        *(u32x4*)(P.YC + (size_t)(MP + b * 4 + t) * 4096 + g * 512 + 8 * lane) = o;
    }
    __syncthreads();
}
DI void cnorm_phase(const Frame& F, const CPtrs& P) {
    for (int row = F.gw; row < MP; row += F.NGW) {
#pragma unroll
        for (int k = 0; k < 8; ++k) {
            const int ch = 8 * (F.lane + 64 * k);
            const u32x4 v = ldg<u32x4>(P.YC, (unsigned)((row * 4096 + ch) * 2)), z = ldg<u32x4>(P.PC, (unsigned)((row * CINM + ch) * 2));
            const f32x4 n0 = ldg<f32x4>(P.norm_w, (unsigned)(ch * 4)), n1 = ldg<f32x4>(P.norm_w, (unsigned)((ch + 4) * 4));
            float y[8]; float ss = 0.f;
#pragma unroll
            for (int e = 0; e < 4; ++e) { y[2 * e] = bflo(v[e]) * silu_f(bflo(z[e])); y[2 * e + 1] = bfhi(v[e]) * silu_f(bfhi(z[e])); ss += y[2 * e] * y[2 * e] + y[2 * e + 1] * y[2 * e + 1]; }
            const float rstd = rsqrtf(wave_sum(ss) * (1.f / 512.f) + RMS_EPS);
            u32x4 o; o.x = pk2(y[0] * rstd * n0[0], y[1] * rstd * n0[1]); o.y = pk2(y[2] * rstd * n0[2], y[3] * rstd * n0[3]);
            o.z = pk2(y[4] * rstd * n1[0], y[5] * rstd * n1[1]); o.w = pk2(y[6] * rstd * n1[2], y[7] * rstd * n1[3]);
            stg<u32x4>(P.YC, (unsigned)((row * 4096 + ch) * 2), o);
        }
    }
}
template <class Fn>
DI void run_gemm(const Frame& F, const bf16* A, const bf16* Bt, int N, int K, const Fn& f) {
    pg8::Gemm g{A, Bt, MP, N, K, K}; pg8::StaticOrder S; S.init(MP, N, F.G, F.bid);
    EpiWrap<Fn> E{f};
    pg8::gemm_phase<EpiWrap<Fn>, pg8::StaticOrder, true, true>(F.lds, g, S, E, F.tid);
}
template <class Fn>
DI void run_gemm_split(const Frame& F, const Args& args, const bf16* A, const bf16* Bt, int N, int K, const Fn& f, int inst) {
    const int nwg = (MP / 256) * (N / 256), full = (nwg / F.G) * F.G, rem = nwg - full;
    if (F.G != 256 || rem * 2 != F.G) { run_gemm(F, A, Bt, N, K, f); return; }
    {
        pg8::Gemm g{A, Bt, MP, N, K, K}; CappedOrder S; S.S.init(MP, N, F.G, F.bid); S.cap = full;
        EpiWrap<Fn> E{f};
        pg8::gemm_phase<EpiWrap<Fn>, CappedOrder, true, true>(F.lds, g, S, E, F.tid);
    }
    {
        const int half = F.bid >= rem ? 1 : 0, c = F.bid - half * rem;
        pg8::StaticOrder S0; S0.init(MP, N, F.G, c); pg8::Unit u; S0.next(full / F.G, u);
        OneUnit S; S.pm = u.pm; S.pn = u.pn; S.valid = true;
        pg8::Gemm g{A + half * (K / 2), Bt + half * (K / 2), MP, N, K / 2, K};
        float* slab = (float*)(args.ws + WS_SLAB) + (size_t)c * 65536;
        unsigned* cnt = (unsigned*)(args.ws + CTL_SPLIT) + ((size_t)inst * 128 + c) * 64;
        if (half) { EpiSplitPartner E{slab, cnt}; pg8::gemm_phase<EpiSplitPartner, OneUnit, true, true>(F.lds, g, S, E, F.tid); }
        else { EpiSplitOwner<Fn> E{f, slab, cnt}; pg8::gemm_phase<EpiSplitOwner<Fn>, OneUnit, true, true>(F.lds, g, S, E, F.tid); }
    }
}
#define SKINNY_LOOP(u, count) for (int u = (F.G - 1 - F.bid); u < (count); u += F.G)
#define SIDE_LOOP(u, count, nres) for (int _ns = (F.G > (nres) ? F.G - (nres) : F.G), u = ((F.G - 1 - F.bid) < _ns ? (F.G - 1 - F.bid) : (count)); u < (count); u += _ns)

enum { PH_PRO = 0, PH_GU, PH_DN, PH_LN, PH_AQKV, PH_ATT, PH_AO, PH_BIN, PH_BPREP, PH_BCHAIN, PH_BOUT, PH_CIN, PH_CCHAIN, PH_CNORM, PH_COUT, PH_CPRE, PH_BO, PH_AMRG, PH_N };

DI void fill_b(BPtrs& P, const Args& args) {
    uchar* ws = args.ws;
    P.PB = (const bf16*)(ws + MB_PB); P.EB = (const float*)(ws + MB_EB); P.PBS = (const float*)(ws + MB_PBS);
    P.WG = (bf16*)(ws + MB_WG); P.UG = (bf16*)(ws + MB_UG); P.QG = (bf16*)(ws + MB_QG); P.KG = (bf16*)(ws + MB_KG); P.QKG = (bf16*)(ws + MB_QKG);
    P.GCG = (float*)(ws + MB_GCG); P.YB = (bf16*)(ws + MB_YB); P.SG = (bf16*)(ws + MB_SG); P.VNG = (bf16*)(ws + MB_VNG);
    P.conv_w = args.in[18]; P.a_log = args.in[19]; P.dt_bias = args.in[20]; P.norm_w = args.in[21]; P.ssm0 = args.in[5]; P.conv0 = args.in[6];
    P.ssm_p = args.out + O_BSSMP; P.ssm_s = args.out + O_BSSMS; P.conv_p = args.out + O_BCONVP; P.conv_s = args.out + O_BCONVS;
}
DI void fill_c(CPtrs& P, const Args& args) {
    uchar* ws = args.ws;
    P.PC = (const bf16*)(ws + MC_PC); P.EC = (const float*)(ws + MC_EC); P.PCS = (const float*)(ws + MC_PCS); P.DT = (float*)(ws + MC_SS); P.ACS = (float*)(ws + MC_ACS); P.XBC = (bf16*)(ws + MC_XBC); P.YC = (bf16*)(ws + MC_YC);
    P.conv_w = args.in[24]; P.conv_b = args.in[25]; P.dt_bias = args.in[26]; P.a_log = args.in[27]; P.dskip = args.in[28]; P.norm_w = args.in[29];
    P.ssm0 = args.in[7]; P.conv0 = args.in[8];
    P.ssm_p = args.out + O_CSSMP; P.ssm_s = args.out + O_CSSMS; P.conv_p = args.out + O_CCONVP; P.conv_s = args.out + O_CCONVS;
}
template <int PH>
DI void phase_body(const Frame& F, const Args& args, int hl, int zsi, int j, bool isdup = false) {
    uchar* ws = args.ws;
    float* X = args.out; bf16* XB = (bf16*)(ws + WS_XB); float* ZP = (float*)(ws + WS_ZP); bf16* HB = (bf16*)(ws + WS_H);
    float* ZS = (float*)(ws + WS_ZS + (size_t)zsi * ZS_ONE);
    if constexpr (PH == PH_PRO) prologue(F, args);
    if constexpr (PH == PH_GU) {
        const bf16* Wgu = (const bf16*)(ws + WS_W + (size_t)hl * FFN_BYTES);
        FSwiglu f{HB}; run_gemm(F, XB, Wgu, NGU, DM, f);
        SIDE_LOOP(u, NGU / 64, 128) skinny_unit<2>(F, XB, DM, MP, Wgu, DM, 64 * u, 0, DM, f);
        { const int sid = hl == 0 ? 1 : hl == 1 ? 4 : hl == 2 ? 5 : hl == 3 ? 7 : hl == 4 ? 8 : hl == 5 ? 10 : hl == 6 ? 11 : 14; bg_slot(F, args, sid, 128); }
    }
    if constexpr (PH == PH_DN) {
        const bf16* Wdn = (const bf16*)(ws + WS_W + (size_t)hl * FFN_BYTES + GU_BYTES);
        FResid f{XB, ZP, 0, 0.5f, 0, 1}; run_gemm(F, HB, Wdn, DM, DFF, f);
        if (!isdup) SKINNY_LOOP(u, 256) { const int ft = u >> 2, ks = u & 3; FResid fs{XB, ZS, MP, 0.5f, 1, ks == 0}; skinny_unit<1>(F, HB, DFF, MP, Wdn, DFF, 32 * ft, ks * (DFF / 4), DFF / 4, fs); }
    }
    if constexpr (PH == PH_LN) ln_phase(F, ZP, ZS, args.in[9] + (size_t)zsi * DM, args.in[10] + (size_t)zsi * DM, zsi == 11 ? X : (float*)nullptr, XB);
    if constexpr (PH == PH_AQKV || PH == PH_ATT || PH == PH_AO || PH == PH_AMRG) {
        const bf16* Wq = (const bf16*)(ws + WS_WA + (size_t)j * A_BYTES); const bf16* Wo = (const bf16*)(ws + WS_WA + (size_t)j * A_BYTES + AQ_BYTES);
        bf16* QKV = (bf16*)(ws + MA_QKV); float* QKVS = (float*)(ws + MA_QKVS); bf16* OG = (bf16*)(ws + MA_OG); float* LSE = (float*)(ws + MA_LSE); bf16* OA = (bf16*)(ws + MA_O);
        if constexpr (PH == PH_AQKV) {
            FQkv f; f.QKV = QKV; f.QKVS = QKVS; f.rope = (const float*)(ws + WS_ROPE); f.j = j;
            f.out = args.out;
            run_gemm(F, XB, Wq, AQKV, DM, f);
            SIDE_LOOP(u, AQKV / 64, 128) skinny_unit<2>(F, XB, DM, MP, Wq, DM, 64 * u, 0, DM, f);
            bg_slot(F, args, j == 0 ? 2 : 12, 128);
        }
        if constexpr (PH == PH_ATT) {
#ifndef DUP_SUB
#define DUP_SUB 0
#endif
            if (!isdup || DUP_SUB == 0 || DUP_SUB == 1) attn_coop_phase(F, QKV, OG, LSE);
            __syncthreads();
            if (!isdup || DUP_SUB == 0 || DUP_SUB == 2) for (int u = F.bid; u < 256; u += F.G) attn_sample_unit(F, u, QKVS, args.in[2], args.in[3], args.in[4], j, OA);
            if (!isdup || DUP_SUB == 0 || DUP_SUB == 3) bg_slot(F, args, j == 0 ? 3 : 13, 0);
        }
        if constexpr (PH == PH_AMRG) attn_merge_phase(F, OG, LSE, OA);
        if constexpr (PH == PH_AO) {
            FResid f{XB, ZP, 0, 1.f, 0, 1}; run_gemm(F, OA, Wo, DM, 1024, f);
            if (!isdup) SKINNY_LOOP(u, 256) { const int ft = u >> 2, ks = u & 3; FResid fs{XB, ZS, MP, 1.f, 1, ks == 0}; skinny_unit<1>(F, OA, 1024, MP, Wo, 1024, 32 * ft, ks * 256, 256, fs); }
        }
    }
    if constexpr (PH == PH_BIN || PH == PH_BPREP || PH == PH_BCHAIN || PH == PH_BOUT || PH == PH_BO) {
        const bf16* Wi = (const bf16*)(ws + WS_WB); const bf16* Wo = (const bf16*)(ws + WS_WB + BI_BYTES);
        BPtrs P; fill_b(P, args);
        if constexpr (PH == PH_BIN) {
            FBf16 f{(bf16*)(ws + MB_PB), BINM}; run_gemm(F, XB, Wi, BINM, DM, f);
            FF32 fe{(float*)(ws + MB_EB), 64, 0, BINM};
            SKINNY_LOOP(u, 256) skinny_unit<2>(F, XB, DM, 32 * u, Wi, DM, BINM, 0, DM, fe);
            FF32 fs{(float*)(ws + MB_PBS), BIN, MP, 0};
            SKINNY_LOOP(u, BIN / 64) skinny_unit<2>(F, XB, DM, MP, Wi, DM, 64 * u, 0, DM, fs);
        }
        if constexpr (PH == PH_BPREP) {
            for (int u = F.bid; u < 2048; u += F.G) bprep_unit(F, u, P);
            for (int i = F.gw * 64 + F.lane; i < 2 * 3 * 8192; i += F.NGW * 64) { const int b = i / 24576, r = (i / 8192) % 3, c = i & 8191; P.conv_p[i] = bf2f(P.PB[((size_t)b * TP + TP - 3 + r) * BINM + c]); }
        }
        if constexpr (PH == PH_BCHAIN) {
            for (int u = F.bid; u < 64; u += F.G) bchain_unit(F, u, P);
            SIDE_LOOP(u, 256, 64) bsample_unit(F, u, P);
            bg_slot(F, args, 6, 64);
        }
        if constexpr (PH == PH_BO) { for (int u = F.bid; u < 4096; u += F.G) bout_unit(F, u, P); }
        if constexpr (PH == PH_BOUT) {
            FResid f{XB, ZP, 0, 1.f, 0, 1}; run_gemm(F, P.YB, Wo, DM, 4096, f);
            if (!isdup) SKINNY_LOOP(u, 256) { const int ft = u >> 2, ks = u & 3; FResid fs{XB, ZS, MP, 1.f, 1, ks == 0}; skinny_unit<1>(F, P.YB, 4096, MP, Wo, 4096, 32 * ft, ks * 1024, 1024, fs); }
        }
    }
    if constexpr (PH == PH_CIN || PH == PH_CCHAIN || PH == PH_CNORM || PH == PH_COUT || PH == PH_CPRE) {
        const bf16* Wi = (const bf16*)(ws + WS_WC); const bf16* Wo = (const bf16*)(ws + WS_WC + CI_BYTES);
        CPtrs P; fill_c(P, args);
        if constexpr (PH == PH_CIN) {
            FBf16 f{(bf16*)(ws + MC_PC), CINM}; run_gemm(F, XB, Wi, CINM, DM, f);
            FF32 fe{(float*)(ws + MC_EC), 64, 0, CINM};
            SKINNY_LOOP(u, 256) skinny_unit<2>(F, XB, DM, 32 * u, Wi, DM, CINM, 0, DM, fe);
            FF32 fs{(float*)(ws + MC_PCS), CIN, MP, 0};
            SKINNY_LOOP(u, CIN / 64) skinny_unit<2>(F, XB, DM, MP, Wi, DM, 64 * u, 0, DM, fs);
        }
        if constexpr (PH == PH_CCHAIN) {
            for (int u = F.bid; u < 128; u += F.G) cchain_unit(F, u, P);
            SIDE_LOOP(u, 64, 128) csample_unit(F, u, P);
            bg_slot(F, args, 9, 128);
            for (int i = F.gw * 64 + F.lane; i < 2 * 3 * 6144; i += F.NGW * 64) { const int b = i / 18432, r = (i / 6144) % 3, c = i % 6144; P.conv_p[i] = bf2f(P.PC[((size_t)b * TP + TP - 3 + r) * CINM + 4096 + c]); }
        }
        if constexpr (PH == PH_CPRE) cpre_phase(F, P);
        if constexpr (PH == PH_CNORM) cnorm_phase(F, P);
        if constexpr (PH == PH_COUT) {
            FResid f{XB, ZP, 0, 1.f, 0, 1}; run_gemm(F, P.YC, Wo, DM, 4096, f);
            if (!isdup) SKINNY_LOOP(u, 256) { const int ft = u >> 2, ks = u & 3; FResid fs{XB, ZS, MP, 1.f, 1, ks == 0}; skinny_unit<1>(F, P.YC, 4096, MP, Wo, 4096, 32 * ft, ks * 1024, 1024, fs); }
        }
    }
}
DI void make_frame(Frame& F, unsigned char* lds_raw) {
    F.lds = (LAS uchar*)lds_raw;
    F.tid = threadIdx.x; F.lane = F.tid & 63; F.wave = __builtin_amdgcn_readfirstlane(F.tid >> 6);
    F.G = gridDim.x; F.bid = blockIdx.x; F.gw = F.bid * NWAVES + F.wave; F.NGW = F.G * NWAVES;
}
#if MK_MULTI
template <int PH>
__global__ void __launch_bounds__(NWAVES * 64, 2) mk_phase(Args args, int hl, int zsi, int j) {
    extern __shared__ __attribute__((aligned(16))) unsigned char lds_raw[];
    Frame F; make_frame(F, lds_raw);
    phase_body<PH>(F, args, hl, zsi, j);
}
#endif

static void fill_args(Args& a, void* const* d_in, void* d_out, void* d_ws) {
    for (int i = 0; i < 31; ++i) a.in[i] = (const float*)d_in[i];
    a.out = (float*)d_out; a.ws = (unsigned char*)d_ws;
}
#if MK_MULTI
template <int PH> static void launch_phase(const Args& a, int grid, hipStream_t stream, int hl, int zsi, int j) {
    static bool attr = false;
    if (!attr) { (void)hipFuncSetAttribute((const void*)mk_phase<PH>, hipFuncAttributeMaxDynamicSharedMemorySize, LDS_BYTES); attr = true; }
    hipLaunchKernelGGL(mk_phase<PH>, dim3(grid), dim3(NWAVES * 64), LDS_BYTES, stream, a, hl, zsi, j);
}
extern "C" void kernel_launch(void* const* d_in, const int* in_sizes, int n_in, void* d_out, int out_size, void* d_ws, size_t ws_size, hipStream_t stream) {
    static int grid = 0;
    if (grid == 0) {
        if (n_in != 31 || (size_t)out_size != O_END || ws_size < WS_END) {
            fprintf(stderr, "kernel_launch: expected 31 inputs, out %zu floats, ws >= %zu bytes; got n_in %d out %d ws %zu; nothing launched\n", (size_t)O_END, (size_t)WS_END, n_in, out_size, ws_size);
            grid = -1; return;
        }
        int dev = 0, cus = 0;
        if (hipGetDevice(&dev) != hipSuccess || hipDeviceGetAttribute(&cus, hipDeviceAttributeMultiprocessorCount, dev) != hipSuccess) { grid = -1; return; }
        grid = cus;
    }
    if (grid < 0) return;
    Args a{}; fill_args(a, d_in, d_out, d_ws);
    launch_phase<PH_PRO>(a, grid, stream, 0, 0, 0);
    for (int hl = 0; hl < 8; ++hl) {
        const int layer = hl >> 1, which = hl & 1, zf = 3 * layer + 2 * which, zm = 3 * layer + 1;
        launch_phase<PH_GU>(a, grid, stream, hl, zf, 0);
        launch_phase<PH_DN>(a, grid, stream, hl, zf, 0);
        launch_phase<PH_LN>(a, grid, stream, hl, zf, 0);
        if (which == 1) continue;
        if (layer == 0 || layer == 3) {
            const int j = layer == 0 ? 0 : 1;
            launch_phase<PH_AQKV>(a, grid, stream, hl, zm, j); launch_phase<PH_ATT>(a, grid, stream, hl, zm, j); launch_phase<PH_AMRG>(a, grid, stream, hl, zm, j); launch_phase<PH_AO>(a, grid, stream, hl, zm, j);
        } else if (layer == 1) {
            launch_phase<PH_BIN>(a, grid, stream, hl, zm, 0); launch_phase<PH_BPREP>(a, grid, stream, hl, zm, 0); launch_phase<PH_BCHAIN>(a, grid, stream, hl, zm, 0); launch_phase<PH_BO>(a, grid, stream, hl, zm, 0); launch_phase<PH_BOUT>(a, grid, stream, hl, zm, 0);
        } else {
            launch_phase<PH_CIN>(a, grid, stream, hl, zm, 0); launch_phase<PH_CPRE>(a, grid, stream, hl, zm, 0); launch_phase<PH_CCHAIN>(a, grid, stream, hl, zm, 0); launch_phase<PH_CNORM>(a, grid, stream, hl, zm, 0); launch_phase<PH_COUT>(a, grid, stream, hl, zm, 0);
        }
        launch_phase<PH_LN>(a, grid, stream, hl, zm, 0);
    }
    const hipError_t le = hipPeekAtLastError();
    if (le != hipSuccess) fprintf(stderr, "kernel_launch: launch failed: %s\n", hipGetErrorName(le));
}
#endif
#if !MK_MULTI
DI void launder_frame(Frame& F) {
    int t_ = F.tid, l_ = F.lane, w_ = F.wave, g_ = F.G, b_ = F.bid; unsigned la_ = (unsigned)(size_t)F.lds;
    asm volatile("" : "+v"(t_), "+v"(l_)); asm volatile("" : "+s"(w_), "+s"(g_), "+s"(b_), "+s"(la_));
    F.tid = t_; F.lane = l_; F.wave = w_; F.G = g_; F.bid = b_; F.gw = b_ * NWAVES + w_; F.NGW = g_ * NWAVES; F.lds = (LAS uchar*)(size_t)la_;
}
__global__ void __launch_bounds__(NWAVES * 64, 2) mk_fwd(Args args) {
    extern __shared__ __attribute__((aligned(16))) unsigned char lds_raw[];
    Frame F; make_frame(F, lds_raw);
    volatile LAS unsigned* MISC = (volatile LAS unsigned*)(F.lds + MISC_OFF);
    for (int u = F.tid; u < (LDS_BYTES - MISC_OFF) / 4; u += NWAVES * 64) ((LAS unsigned*)(F.lds + MISC_OFF))[u] = 0u;
    __syncthreads();
    XcdBarrier bar = xcd_barrier_post((unsigned*)(args.ws + WS_CTL) + CW_BAR, MISC + 8);
#ifndef DUP_PH
#define DUP_PH -1
#endif
#define RUN1(PH, hl, zsi, j) do { asm volatile("; MARK_PHASE %0 %1" :: "i"(PH), "i"(zsi)); launder_frame(F); phase_body<PH>(F, args, hl, zsi, j); xcd_barrier(bar); } while (0)
#define RUN(PH, hl, zsi, j) do { RUN1(PH, hl, zsi, j); if (PH == DUP_PH) { launder_frame(F); phase_body<PH>(F, args, hl, zsi, j, true); xcd_barrier(bar); } } while (0)
#define FFN(hl, zsi) RUN(PH_GU, hl, zsi, 0); RUN(PH_DN, hl, zsi, 0); RUN(PH_LN, hl, zsi, 0)
#define MIXA(zsi, j) RUN(PH_AQKV, 0, zsi, j); RUN(PH_ATT, 0, zsi, j); RUN(PH_AMRG, 0, zsi, j); RUN(PH_AO, 0, zsi, j); RUN(PH_LN, 0, zsi, 0)
#define MIXB(zsi) RUN(PH_BIN, 0, zsi, 0); RUN(PH_BPREP, 0, zsi, 0); RUN(PH_BCHAIN, 0, zsi, 0); RUN(PH_BO, 0, zsi, 0); RUN(PH_BOUT, 0, zsi, 0); RUN(PH_LN, 0, zsi, 0)
#define MIXC(zsi) RUN(PH_CIN, 0, zsi, 0); RUN(PH_CPRE, 0, zsi, 0); RUN(PH_CCHAIN, 0, zsi, 0); RUN(PH_CNORM, 0, zsi, 0); RUN(PH_COUT, 0, zsi, 0); RUN(PH_LN, 0, zsi, 0)
    RUN(PH_PRO, 0, 0, 0);
    FFN(0, 0); MIXA(1, 0); FFN(1, 2);
    FFN(2, 3); MIXB(4);    FFN(3, 5);
    FFN(4, 6); MIXC(7);    FFN(5, 8);
    FFN(6, 9); MIXA(10, 1); FFN(7, 11);
}
extern "C" void kernel_launch(void* const* d_in, const int* in_sizes, int n_in, void* d_out, int out_size, void* d_ws, size_t ws_size, hipStream_t stream) {
    static int grid = 0;
    if (grid == 0) {
        if (n_in != 31 || (size_t)out_size != O_END || ws_size < WS_END) {
            fprintf(stderr, "kernel_launch: expected 31 inputs, out %zu floats, ws >= %zu bytes; got n_in %d out %d ws %zu; nothing launched\n", (size_t)O_END, (size_t)WS_END, n_in, out_size, ws_size);
            grid = -1; return;
        }
        int dev = 0, cus = 0, per_cu = 0;
        if (hipGetDevice(&dev) != hipSuccess || hipDeviceGetAttribute(&cus, hipDeviceAttributeMultiprocessorCount, dev) != hipSuccess) { grid = -1; return; }
        if (hipFuncSetAttribute((const void*)mk_fwd, hipFuncAttributeMaxDynamicSharedMemorySize, LDS_BYTES) != hipSuccess) { fprintf(stderr, "kernel_launch: hipFuncSetAttribute failed\n"); grid = -1; return; }
        if (hipOccupancyMaxActiveBlocksPerMultiprocessor(&per_cu, (const void*)mk_fwd, NWAVES * 64, LDS_BYTES) != hipSuccess || per_cu < 1)
            fprintf(stderr, "kernel_launch: note: occupancy query reports %d workgroups per CU\n", per_cu);
        (void)hipGetLastError();
        grid = cus;
    }
    if (grid < 0) return;
    if (hipMemsetAsync((char*)d_ws + WS_CTL, 0, CTL_ZERO_BYTES, stream) != hipSuccess) { fprintf(stderr, "kernel_launch: memset failed\n"); return; }
    Args a{}; fill_args(a, d_in, d_out, d_ws);
    hipLaunchKernelGGL(mk_fwd, dim3(grid), dim3(NWAVES * 64), LDS_BYTES, stream, a);
    const hipError_t le = hipPeekAtLastError();
    if (le != hipSuccess) fprintf(stderr, "kernel_launch: launch failed: %s\n", hipGetErrorName(le));
}
#endif
```
